# Optimizing an MI355X kernel written in HIP

```python
import jax, jax.numpy as jnp
from jax import lax
import numpy as np

D_MODEL = 1024
BATCH = 32
SEQ = 256
DEPTH = 4
DEC_BATCH = 8
DEC_SEQ = 2048
PAST_LEN = 256

GRID_W = 64
HEAD_DIM = 64
CONV_CH = D_MODEL // 4
CONV_K = 31
ATTN_W = (D_MODEL - CONV_CH) // 2
GQA_HEADS = ATTN_W // HEAD_DIM
GQA_KV_HEADS = GQA_HEADS // 3
GQA_GROUP = GQA_HEADS // GQA_KV_HEADS
NA_HEADS = ATTN_W // HEAD_DIM
D_FF = 4 * D_MODEL
NA_WIN_R = 8
NA_WIN_C = 16
NA_CB = 16
NA_KC = NA_CB + NA_WIN_C
Q_BLOCK = 128
ROPE_THETA = 10000.0
EPS = 1e-6
NEG_INF = -1e30

kernel_name = 'hybrid_conv_gqa_natten_prefix_dit'


def _rms(x, g):
    xf = x.astype(jnp.float32)
    y = xf * lax.rsqrt(jnp.mean(xf * xf, axis=-1, keepdims=True) + EPS)
    return (y * g.astype(jnp.float32)).astype(x.dtype)


def _layer_norm(x, g, b):
    xf = x.astype(jnp.float32)
    mu = jnp.mean(xf, axis=-1, keepdims=True)
    var = jnp.mean(jnp.square(xf - mu), axis=-1, keepdims=True)
    y = (xf - mu) * lax.rsqrt(var + EPS)
    return (y * g.astype(jnp.float32) + b.astype(jnp.float32)).astype(x.dtype)


def _modulation(cvec, w, b):
    m = (jax.nn.silu(cvec) @ w + b)[:, None, :]
    return jnp.split(m, 6, axis=-1)


def _axial_rope(x):
    n = x.shape[1]
    t = jnp.arange(n)
    positions = ((t // GRID_W).astype(jnp.float32), (t % GRID_W).astype(jnp.float32))
    half = HEAD_DIM // 2
    quarter = half // 2
    inv = 1.0 / (ROPE_THETA ** (jnp.arange(quarter, dtype=jnp.float32) * 2.0 / half))
    xf = x.astype(jnp.float32)
    parts = []
    for axis_i, p in enumerate(positions):
        seg = xf[..., axis_i * half:(axis_i + 1) * half]
        ang = p[:, None] * inv[None, :]
        cos = jnp.cos(ang)[None, :, None, :]
        sin = jnp.sin(ang)[None, :, None, :]
        s1, s2 = seg[..., :quarter], seg[..., quarter:]
        parts.append(s1 * cos - s2 * sin)
        parts.append(s2 * cos + s1 * sin)
    return jnp.concatenate(parts, axis=-1).astype(x.dtype)


def _blocked_attention(q, k, v):
    B, Lq, Hkv, G, Dh = q.shape
    nb = Lq // Q_BLOCK
    qb = jnp.moveaxis(q.reshape(B, nb, Q_BLOCK, Hkv, G, Dh), 1, 0)
    scale = Dh ** -0.5

    def one(qblk):
        s = jnp.einsum('bqhgd,bkhd->bhgqk', qblk, k, preferred_element_type=jnp.float32) * scale
        p = jax.nn.softmax(s, axis=-1).astype(v.dtype)
        return jnp.einsum('bhgqk,bkhd->bqhgd', p, v)

    out = lax.map(one, qb)
    return jnp.moveaxis(out, 0, 1).reshape(B, Lq, Hkv * G * Dh)


def _neighborhood_attention(q, k, v, kc, vc, rpb):
    B, S, H, Dh = q.shape
    rows = S // GRID_W
    wr = min(NA_WIN_R, rows)
    ncb = GRID_W // NA_CB
    qg = q.reshape(B, rows, ncb, NA_CB, H, Dh)
    kg = k.reshape(B, rows, GRID_W, H, Dh)
    vg = v.reshape(B, rows, GRID_W, H, Dh)
    m = np.arange(ncb)
    qcols = m[:, None] * NA_CB + np.arange(NA_CB)[None, :]
    kb = np.clip(m * NA_CB - NA_WIN_C // 2, 0, GRID_W - NA_KC)
    kcols = kb[:, None] + np.arange(NA_KC)[None, :]
    cs = np.clip(qcols - NA_WIN_C // 2, 0, GRID_W - NA_WIN_C)
    col_mask = (kcols[:, None, :] >= cs[..., None]) & (kcols[:, None, :] < cs[..., None] + NA_WIN_C)
    col_off = np.clip(kcols[:, None, :] - qcols[..., None] + NA_WIN_C - 1, 0, 2 * NA_WIN_C - 2)
    col_bias = rpb.astype(jnp.float32)[:, :, col_off]
    scale = Dh ** -0.5

    def one_row(r):
        rs = jnp.clip(r - wr // 2, 0, rows - wr)
        kr = lax.dynamic_slice_in_dim(kg, rs, wr, axis=1)[:, :, kcols]
        vr = lax.dynamic_slice_in_dim(vg, rs, wr, axis=1)[:, :, kcols]
        qr = lax.dynamic_index_in_dim(qg, r, axis=1, keepdims=False)
        row_off = rs + jnp.arange(wr) - r + NA_WIN_R - 1
        bias = jnp.take(col_bias, row_off, axis=1).transpose(0, 2, 3, 1, 4)
        s_loc = jnp.einsum('bmqhd,bamkhd->bhmqak', qr, kr, preferred_element_type=jnp.float32) * scale + bias[None]
        s_loc = jnp.where(col_mask[None, None, :, :, None, :], s_loc, NEG_INF)
        s_loc = s_loc.reshape(B, H, ncb, NA_CB, wr * NA_KC)
        s_ctx = jnp.einsum('bmqhd,bkhd->bhmqk', qr, kc, preferred_element_type=jnp.float32) * scale
        p = jax.nn.softmax(jnp.concatenate([s_loc, s_ctx], axis=-1), axis=-1).astype(v.dtype)
        p_loc = p[..., :wr * NA_KC].reshape(B, H, ncb, NA_CB, wr, NA_KC)
        p_ctx = p[..., wr * NA_KC:]
        return (jnp.einsum('bhmqak,bamkhd->bmqhd', p_loc, vr)
                + jnp.einsum('bhmqk,bkhd->bmqhd', p_ctx, vc))

    out = lax.map(one_row, jnp.arange(rows))
    return jnp.moveaxis(out, 0, 1).reshape(B, S, H * Dh)


def _conv_module(u, dw_w, dw_b, ln_g, ln_b):
    a, g = jnp.split(u, 2, axis=-1)
    h = a * jax.nn.sigmoid(g)
    h = lax.conv_general_dilated(h, dw_w[:, None, :], window_strides=(1,),
                                 padding=[(CONV_K // 2, CONV_K // 2)],
                                 dimension_numbers=('NWC', 'WIO', 'NWC'),
                                 feature_group_count=CONV_CH) + dw_b
    return jax.nn.silu(_layer_norm(h, ln_g, ln_b))


def _layer(x, mod, lw, ctx):
    (n1, n2, w_in, dw_w, dw_b, ln_g, ln_b, aqg, akg, nqg, nkg, rpb, w_out, w1, w2) = lw
    sh1, sc1, g1, sh2, sc2, g2 = mod
    B, L, _ = x.shape
    h = _rms(x, n1) * (1 + sc1) + sh1
    sizes = [2 * CONV_CH, GQA_HEADS * HEAD_DIM, GQA_KV_HEADS * HEAD_DIM, GQA_KV_HEADS * HEAD_DIM,
             NA_HEADS * HEAD_DIM, NA_HEADS * HEAD_DIM, NA_HEADS * HEAD_DIM]
    idx = [int(s) for s in np.cumsum(sizes)[:-1]]
    u_conv, qa, ka, va, qn, kn, vn = jnp.split(h @ w_in, idx, axis=-1)
    a_out = _conv_module(u_conv, dw_w, dw_b, ln_g, ln_b)
    qa = _rms(qa.reshape(B, L, GQA_HEADS, HEAD_DIM), aqg)
    ka = _rms(ka.reshape(B, L, GQA_KV_HEADS, HEAD_DIM), akg)
    va = va.reshape(B, L, GQA_KV_HEADS, HEAD_DIM)
    qn = _rms(qn.reshape(B, L, NA_HEADS, HEAD_DIM), nqg)
    kn = _rms(kn.reshape(B, L, NA_HEADS, HEAD_DIM), nkg)
    vn = vn.reshape(B, L, NA_HEADS, HEAD_DIM)
    if ctx is None:
        b_out = _blocked_attention(qa.reshape(B, L, GQA_KV_HEADS, GQA_GROUP, HEAD_DIM), ka, va)
        c_out = _blocked_attention(qn[:, :, :, None, :], kn, vn)
        new_ctx = (ka, va, kn, vn)
    else:
        ck_a, cv_a, ck_n, cv_n = ctx
        qa = _axial_rope(qa)
        ka = _axial_rope(ka)
        b_out = _blocked_attention(qa.reshape(B, L, GQA_KV_HEADS, GQA_GROUP, HEAD_DIM),
                                   jnp.concatenate([ka, ck_a], axis=1),
                                   jnp.concatenate([va, cv_a], axis=1))
        c_out = _neighborhood_attention(qn, kn, vn, ck_n, cv_n, rpb)
        new_ctx = None
    x = x + g1 * (jnp.concatenate([a_out, b_out, c_out], axis=-1) @ w_out)
    h = _rms(x, n2) * (1 + sc2) + sh2
    x = x + g2 * (jnp.square(jax.nn.relu(h @ w1)) @ w2)
    return x, new_ctx


def setup_inputs(seed: int = 0) -> dict:
    key = jax.random.key(seed)
    ks = jax.random.split(key, 32)
    f32 = jnp.float32
    nrm = lambda k, shape, s: jax.random.normal(k, shape, f32) * s
    D = D_MODEL
    in_w = 2 * CONV_CH + (GQA_HEADS + 2 * GQA_KV_HEADS) * HEAD_DIM + 3 * NA_HEADS * HEAD_DIM
    return {
        'x_prompt': nrm(ks[0], (BATCH, SEQ, D), 1.0),
        'x_sample': nrm(ks[1], (DEC_BATCH, DEC_SEQ, D), 1.0),
        'cache_attn_k': nrm(ks[2], (DEC_BATCH, DEPTH, PAST_LEN, GQA_KV_HEADS, HEAD_DIM), 1.0),
        'cache_attn_v': nrm(ks[3], (DEC_BATCH, DEPTH, PAST_LEN, GQA_KV_HEADS, HEAD_DIM), 1.0),
        'cache_na_k': nrm(ks[4], (DEC_BATCH, DEPTH, PAST_LEN, NA_HEADS, HEAD_DIM), 1.0),
        'cache_na_v': nrm(ks[5], (DEC_BATCH, DEPTH, PAST_LEN, NA_HEADS, HEAD_DIM), 1.0),
        'c': nrm(ks[6], (DEC_BATCH, D), 1.0),
        'c_ctx': nrm(ks[7], (D,), 1.0),
        'ada_w': nrm(ks[8], (DEPTH, D, 6 * D), 0.5 * D ** -0.5),
        'ada_b': nrm(ks[9], (DEPTH, 6 * D), 0.02),
        'norm1_g': 1.0 + nrm(ks[10], (DEPTH, D), 0.05),
        'norm2_g': 1.0 + nrm(ks[11], (DEPTH, D), 0.05),
        'w_in': nrm(ks[12], (DEPTH, D, in_w), D ** -0.5),
        'conv_dw_w': nrm(ks[13], (DEPTH, CONV_K, CONV_CH), CONV_K ** -0.5),
        'conv_dw_b': nrm(ks[14], (DEPTH, CONV_CH), 0.02),
        'conv_ln_g': 1.0 + nrm(ks[15], (DEPTH, CONV_CH), 0.05),
        'conv_ln_b': nrm(ks[16], (DEPTH, CONV_CH), 0.02),
        'attn_q_g': 1.0 + nrm(ks[17], (DEPTH, HEAD_DIM), 0.05),
        'attn_k_g': 1.0 + nrm(ks[18], (DEPTH, HEAD_DIM), 0.05),
        'na_q_g': 1.0 + nrm(ks[19], (DEPTH, HEAD_DIM), 0.05),
        'na_k_g': 1.0 + nrm(ks[20], (DEPTH, HEAD_DIM), 0.05),
        'na_rpb': nrm(ks[21], (DEPTH, NA_HEADS, 2 * NA_WIN_R - 1, 2 * NA_WIN_C - 1), 0.5),
        'w_out': nrm(ks[22], (DEPTH, D, D), D ** -0.5),
        'mlp_w1': nrm(ks[23], (DEPTH, D, D_FF), D ** -0.5),
        'mlp_w2': nrm(ks[24], (DEPTH, D_FF, D), D_FF ** -0.5),
    }


def reference(x_prompt, x_sample, cache_attn_k, cache_attn_v, cache_na_k, cache_na_v, c, c_ctx,
              ada_w, ada_b, norm1_g, norm2_g, w_in, conv_dw_w, conv_dw_b, conv_ln_g, conv_ln_b,
              attn_q_g, attn_k_g, na_q_g, na_k_g, na_rpb, w_out, mlp_w1, mlp_w2):
    xp = x_prompt
    xs = x_sample
    ak, av, nk, nv = [], [], [], []
    for l in range(DEPTH):
        lw = (norm1_g[l], norm2_g[l], w_in[l], conv_dw_w[l], conv_dw_b[l], conv_ln_g[l], conv_ln_b[l],
              attn_q_g[l], attn_k_g[l], na_q_g[l], na_k_g[l], na_rpb[l], w_out[l], mlp_w1[l], mlp_w2[l])
        mod_ctx = _modulation(c_ctx[None, :], ada_w[l], ada_b[l])
        xp, (k_a, v_a, k_n, v_n) = _layer(xp, mod_ctx, lw, None)
        ak.append(k_a)
        av.append(v_a)
        nk.append(k_n)
        nv.append(v_n)
        mod_lat = _modulation(c, ada_w[l], ada_b[l])
        ctx = (cache_attn_k[:, l], cache_attn_v[:, l], cache_na_k[:, l], cache_na_v[:, l])
        xs, _ = _layer(xs, mod_lat, lw, ctx)
    new_attn_k = jnp.stack(ak, axis=1)
    new_attn_v = jnp.stack(av, axis=1)
    new_na_k = jnp.stack(nk, axis=1)
    new_na_v = jnp.stack(nv, axis=1)
    return (xp, xs, new_attn_k, new_attn_v, new_na_k, new_na_v)
```

```cpp
#include <hip/hip_runtime.h>
#include <hip/hip_cooperative_groups.h>
#include <cstdio>
#include <cstdint>
namespace cg = cooperative_groups;
namespace pg8 {
#define PG8_LAS __attribute__((address_space(3)))
typedef unsigned short bf16_t;
typedef short bf16x8 __attribute__((ext_vector_type(8)));
typedef float f32x4 __attribute__((ext_vector_type(4)));
typedef unsigned u32x4 __attribute__((ext_vector_type(4)));
constexpr int BM = 256, BK = 64, HALF = 128, HTB = HALF * BK * 2  , STAGE_BYTES = 8 * HTB, NXCD = 8, WGM = 8;

__host__ __device__ __forceinline__ int lds_byte(int r, int c) { const int st = (r >> 4) * 2 + (c >> 5), rr = r & 15, cc = c & 31, ob = rr * 64 + cc * 2; return st * 1024 + (ob ^ (((ob >> 9) & 1) << 5)); }
__host__ __device__ __forceinline__ void stage_rc(int b, int& R, int& C) { const int st = b / 1024, sb = b % 1024, swz = sb ^ (((sb >> 9) & 1) << 5); R = (st >> 1) * 16 + swz / 64; C = (st & 1) * 32 + (swz % 64) / 2; }
__host__ __device__ __forceinline__ int perm32(int rho) { const int n = rho >> 4, i = rho & 15; return 8 * (i >> 2) + 4 * n + (i & 3); }

struct Unit { int pm, pn; };
struct Gemm { const bf16_t* A; const bf16_t* Bt; int M, N, K; };

struct StaticOrder {
    int nM, nN, nwg, G, c;
    __host__ __device__ void init(int M, int N, int G_, int c_) { nM = M / BM; nN = N / BM; nwg = nM * nN; G = G_; c = c_; }
    __host__ __device__ bool next(int i, Unit& u) const {
        const long L = (long)i * G + c; if (L >= nwg) return false;
        int wgid = (int)L; { const int q = nwg / NXCD, r = nwg % NXCD, xcd = wgid % NXCD, off = wgid / NXCD; wgid = (xcd < r ? xcd * (q + 1) : r * (q + 1) + (xcd - r) * q) + off; }
        const int nig = WGM * nN, gid = wgid / nig, fm = gid * WGM, gsz = (nM - fm) < WGM ? (nM - fm) : WGM;
        u.pm = fm + ((wgid % nig) % gsz); u.pn = (wgid % nig) / gsz; return true;
    }
    __device__ __forceinline__ void a_ready(const Unit&) const {}
    __device__ __forceinline__ void done(const Unit&) const {}
};
__device__ __forceinline__ unsigned cvt_pk_bf16(float lo, float hi) { unsigned r; asm volatile("v_cvt_pk_bf16_f32 %0, %1, %2" : "=v"(r) : "v"(lo), "v"(hi)); return r; }
template <class Epi, class Sched, bool ALIGN_EPI = false, bool SP2 = false>
__device__ __forceinline__ void gemm_phase(PG8_LAS unsigned char* lds, const Gemm g, const Sched& S, const Epi& E) {
    int tid_ = threadIdx.x; asm volatile("" : "+v"(tid_));
    const int tid = tid_, wid = __builtin_amdgcn_readfirstlane(tid >> 6), lane = tid & 63, wr = wid >> 2, wc = wid & 3, fr = lane & 15, fq = lane >> 4;
    const int K = g.K, nt = K / BK;
    unsigned voffA[2], voffB[2];
#pragma unroll
    for (int i = 0; i < 2; ++i) { int R, C; stage_rc(tid * 16 + i * 8192, R, C); const int Rb = Epi::PERM ? ((R & ~31) + perm32(R & 31)) : R;
        voffA[i] = (unsigned)(R * K + C) * 2u; voffB[i] = (unsigned)(Rb * K + C) * 2u; }
    const size_t kstep = (size_t)(BK * 2);
    const size_t hstep = (size_t)HALF * K * 2;
    const size_t tstep = 2 * hstep;
    const unsigned ldsw = (unsigned)wid * 1024u;
    const int aoff = lds_byte(wr * 64 + fr, fq * 8), boff = lds_byte(wc * 32 + fr, fq * 8);
#define PG8_SA(b, h) (((b) * 2 + (h)) * HTB)
#define PG8_SB(b, h) ((4 + (b) * 2 + (h)) * HTB)
#define PG8_STAGE(bufoff, gbase, voff) do { _Pragma("unroll") for (int _i = 0; _i < 2; ++_i) \
        __builtin_amdgcn_global_load_lds((const unsigned*)((const char*)(gbase) + (voff)[_i]), (PG8_LAS unsigned*)(lds + (bufoff) + ldsw + _i * 8192), 16, 0, 0); } while (0)
#define PG8_LDA(dst, b, h) do { _Pragma("unroll") for (int m = 0; m < 4; ++m) _Pragma("unroll") for (int k = 0; k < 2; ++k) dst[m][k] = *(const PG8_LAS bf16x8*)(lds + PG8_SA(b, h) + aoff + m * 2048 + k * 1024); } while (0)
#define PG8_LDB(dst, b, h) do { _Pragma("unroll") for (int n = 0; n < 2; ++n) _Pragma("unroll") for (int k = 0; k < 2; ++k) dst[n][k] = *(const PG8_LAS bf16x8*)(lds + PG8_SB(b, h) + boff + n * 2048 + k * 1024); } while (0)
#define PG8_MMA(ai, bj, At, Bt) do { __builtin_amdgcn_s_setprio(1); _Pragma("unroll") for (int m = 0; m < 4; ++m) _Pragma("unroll") for (int n = 0; n < 2; ++n) _Pragma("unroll") for (int k = 0; k < 2; ++k) \
        acc[ai][bj][m][n] = __builtin_amdgcn_mfma_f32_16x16x32_bf16(Bt[n][k], At[m][k], acc[ai][bj][m][n], 0, 0, 0); __builtin_amdgcn_s_setprio(0); } while (0)
#define PG8_WAIT_V(n) asm volatile("s_waitcnt vmcnt(" #n ")" ::: "memory")
#define PG8_WAIT_L(n) asm volatile("s_waitcnt lgkmcnt(" #n ")" ::: "memory")
#define PG8_BAR __builtin_amdgcn_s_barrier()
#define PG8_SCHED __builtin_amdgcn_sched_barrier(0)
    Unit cur, nxt; int ui = 0;
    if (!S.next(0, cur)) return;
    f32x4 acc[2][2][4][2];
#pragma unroll
    for (int a = 0; a < 2; ++a)
#pragma unroll
        for (int b = 0; b < 2; ++b)
#pragma unroll
            for (int m = 0; m < 4; ++m)
#pragma unroll
                for (int n = 0; n < 2; ++n) acc[a][b][m][n] = (f32x4){0.f, 0.f, 0.f, 0.f};
    bf16x8 At[4][2], B0[2][2], B1[2][2];
    const char* cA = (const char*)g.A + (size_t)cur.pm * tstep; const char* cB = (const char*)g.Bt + (size_t)cur.pn * tstep;
    S.a_ready(cur);
    if constexpr (SP2) {
        PG8_STAGE(PG8_SB(0, 0), cB, voffB); PG8_STAGE(PG8_SB(0, 1), cB + hstep, voffB); PG8_STAGE(PG8_SA(0, 0), cA, voffA); PG8_STAGE(PG8_SA(0, 1), cA + hstep, voffA);
        if (wr == 1) PG8_BAR;
        PG8_WAIT_V(2); PG8_BAR;
        PG8_STAGE(PG8_SB(1, 0), cB + kstep, voffB); PG8_STAGE(PG8_SA(1, 0), cA + kstep, voffA); PG8_STAGE(PG8_SB(1, 1), cB + hstep + kstep, voffB);
        PG8_WAIT_V(6); PG8_BAR;
    } else {
        PG8_STAGE(PG8_SB(0, 0), cB, voffB); PG8_STAGE(PG8_SA(0, 0), cA, voffA); PG8_STAGE(PG8_SB(0, 1), cB + hstep, voffB); PG8_STAGE(PG8_SA(0, 1), cA + hstep, voffA);
        if (wr == 1) PG8_BAR;
        PG8_WAIT_V(4); PG8_BAR;
        PG8_STAGE(PG8_SB(1, 0), cB + kstep, voffB); PG8_STAGE(PG8_SA(1, 0), cA + kstep, voffA); PG8_STAGE(PG8_SB(1, 1), cB + hstep + kstep, voffB);
        PG8_WAIT_V(6); PG8_BAR;
    }
    for (;;) {
        const bool has_next = S.next(ui + 1, nxt);
        const char* nA = has_next ? (const char*)g.A + (size_t)nxt.pm * tstep : cA; const char* nB = has_next ? (const char*)g.Bt + (size_t)nxt.pn * tstep : cB;
        for (int t = 0; t < nt; t += 2) {
            const bool last = (t == nt - 2);
            const char* a1 = cA + (size_t)(t + 1) * kstep;
            const char* a2 = last ? nA : cA + (size_t)(t + 2) * kstep; const char* b2 = last ? nB : cB + (size_t)(t + 2) * kstep;
            const char* a3 = a2 + kstep; const char* b3 = b2 + kstep;
            if (last && has_next) S.a_ready(nxt);
            if constexpr (SP2) {
            PG8_LDB(B0, 0, 0); PG8_LDB(B1, 0, 1); PG8_SCHED; PG8_LDA(At, 0, 0); PG8_STAGE(PG8_SA(1, 1), a1 + hstep, voffA);
            PG8_WAIT_V(8); PG8_WAIT_L(0); PG8_BAR; PG8_MMA(0, 0, At, B0); PG8_MMA(0, 1, At, B1); PG8_BAR; PG8_SCHED;
            PG8_LDA(At, 0, 1); PG8_STAGE(PG8_SB(0, 0), b2, voffB); PG8_STAGE(PG8_SB(0, 1), b2 + hstep, voffB); PG8_STAGE(PG8_SA(0, 0), a2, voffA);
            PG8_WAIT_V(8); PG8_WAIT_L(0); PG8_BAR; PG8_MMA(1, 0, At, B0); PG8_MMA(1, 1, At, B1); PG8_BAR; PG8_SCHED;
            PG8_LDB(B0, 1, 0); PG8_LDB(B1, 1, 1); PG8_SCHED; PG8_LDA(At, 1, 0); PG8_STAGE(PG8_SA(0, 1), a2 + hstep, voffA);
            PG8_WAIT_V(8); PG8_WAIT_L(0); PG8_BAR; PG8_MMA(0, 0, At, B0); PG8_MMA(0, 1, At, B1); PG8_BAR; PG8_SCHED;
            PG8_LDA(At, 1, 1); PG8_STAGE(PG8_SB(1, 0), b3, voffB); PG8_STAGE(PG8_SB(1, 1), b3 + hstep, voffB); PG8_STAGE(PG8_SA(1, 0), a3, voffA);
            PG8_WAIT_V(8); PG8_WAIT_L(0); PG8_BAR; PG8_MMA(1, 0, At, B0); PG8_MMA(1, 1, At, B1); PG8_BAR; PG8_SCHED;
            } else {
            PG8_LDB(B0, 0, 0); PG8_SCHED; PG8_LDA(At, 0, 0); PG8_STAGE(PG8_SA(1, 1), a1 + hstep, voffA);
            PG8_WAIT_L(8); PG8_BAR; PG8_WAIT_L(0); PG8_MMA(0, 0, At, B0); PG8_BAR; PG8_SCHED;
            PG8_LDB(B1, 0, 1); PG8_STAGE(PG8_SB(0, 0), b2, voffB);
            PG8_BAR; PG8_WAIT_L(0); PG8_MMA(0, 1, At, B1); PG8_BAR;
            PG8_LDA(At, 0, 1); PG8_STAGE(PG8_SA(0, 0), a2, voffA);
            PG8_BAR; PG8_WAIT_L(0); PG8_MMA(1, 0, At, B0); PG8_BAR; PG8_SCHED;
            PG8_STAGE(PG8_SB(0, 1), b2 + hstep, voffB);
            PG8_WAIT_V(6); PG8_BAR; PG8_MMA(1, 1, At, B1); PG8_BAR;
            PG8_LDB(B0, 1, 0); PG8_SCHED; PG8_LDA(At, 1, 0); PG8_STAGE(PG8_SA(0, 1), a2 + hstep, voffA);
            PG8_WAIT_L(8); PG8_BAR; PG8_WAIT_L(0); PG8_MMA(0, 0, At, B0); PG8_BAR; PG8_SCHED;
            PG8_LDB(B1, 1, 1); PG8_STAGE(PG8_SB(1, 0), b3, voffB);
            PG8_BAR; PG8_WAIT_L(0); PG8_MMA(0, 1, At, B1); PG8_BAR;
            PG8_LDA(At, 1, 1); PG8_STAGE(PG8_SA(1, 0), a3, voffA);
            PG8_BAR; PG8_WAIT_L(0); PG8_MMA(1, 0, At, B0); PG8_BAR; PG8_SCHED;
            PG8_STAGE(PG8_SB(1, 1), b3 + hstep, voffB);
            PG8_WAIT_V(6); PG8_BAR; PG8_MMA(1, 1, At, B1); PG8_BAR;
            }
        }
        if constexpr (ALIGN_EPI) { if (wr == 0) PG8_BAR; }
        if constexpr (!Epi::AFTER_DRAIN) { E(acc, cur, wr, wc, fr, fq); S.done(cur); }
        if (!has_next) break;
#pragma unroll
        for (int a = 0; a < 2; ++a)
#pragma unroll
            for (int b = 0; b < 2; ++b)
#pragma unroll
                for (int m = 0; m < 4; ++m)
#pragma unroll
                    for (int n = 0; n < 2; ++n) acc[a][b][m][n] = (f32x4){0.f, 0.f, 0.f, 0.f};
        cur = nxt; cA = nA; cB = nB; ++ui;
        if constexpr (ALIGN_EPI) { if (wr == 1) PG8_BAR; }
    }
    PG8_WAIT_V(0);
    if constexpr (!ALIGN_EPI) { if (wr == 0) PG8_BAR; }
    PG8_BAR;
    if constexpr (Epi::AFTER_DRAIN) { E.fused(acc, cur, wr, wc, fr, fq, lds, wid, lane); S.done(cur); }
#undef PG8_SA
#undef PG8_SB
#undef PG8_STAGE
#undef PG8_LDA
#undef PG8_LDB
#undef PG8_MMA
#undef PG8_WAIT_V
#undef PG8_WAIT_L
#undef PG8_BAR
#undef PG8_SCHED
}
}

#define DI __device__ __forceinline__
#define LAS __attribute__((address_space(3)))
typedef unsigned short bf16_t;
typedef short bf16x8 __attribute__((ext_vector_type(8)));
typedef float f32x4 __attribute__((ext_vector_type(4)));
typedef float f32x16 __attribute__((ext_vector_type(16)));
typedef unsigned u32x4 __attribute__((ext_vector_type(4)));
typedef unsigned u32x2 __attribute__((ext_vector_type(2)));
typedef float f32x2_t __attribute__((ext_vector_type(2)));
typedef __bf16 bf16x2_t __attribute__((ext_vector_type(2)));

#ifndef MK_SINGLE
#define MK_SINGLE 1
#endif

constexpr int D = 1024, MP = 8192, MS = 16384, M = MP + MS, DEPTH = 4, NMOD = 9, INW = 2304, FF = 4096;
constexpr int NPH = 2 + 6 * DEPTH;
constexpr float QSCALE = 0.125f * 1.4426950408889634f, LOG2E = 1.4426950408889634f, EPS = 1e-6f;
constexpr size_t OFF_AK = 25165824, OFF_AV = 29360128, OFF_NK = 33554432, OFF_NV = 46137344;
constexpr size_t MiB = 1u << 20;
constexpr size_t WS_MOD = 1 * MiB, WS_BIAS1 = 2 * MiB, WS_BIAS2 = 3 * MiB, WS_SSQ = 4 * MiB;
constexpr size_t WS_KCA = 6 * MiB, WS_VCA = 8 * MiB, WS_KCN = 10 * MiB, WS_VCN = 16 * MiB;
constexpr size_t WS_WIN = 22 * MiB, WS_WOUT = 40 * MiB, WS_W1 = 48 * MiB, WS_W2 = 80 * MiB;
constexpr size_t WS_XG = 112 * MiB, WS_H1 = 160 * MiB, WS_RAW = 160 * MiB, WS_Q = 268 * MiB, WS_K = 304 * MiB, WS_VT = 328 * MiB, WS_ATT = 352 * MiB, WS_END = 400 * MiB;
constexpr int LDS_BYTES = 147456;

DI unsigned pk2(float lo, float hi) { f32x2_t v = {lo, hi}; bf16x2_t b = __builtin_convertvector(v, bf16x2_t); return __builtin_bit_cast(unsigned, b); }
DI float bflo(unsigned w) { return __uint_as_float(w << 16); }
DI float bfhi(unsigned w) { return __uint_as_float(w & 0xffff0000u); }
DI void unpack8(const u32x4 w, float (&v)[8]) { v[0] = bflo(w.x); v[1] = bfhi(w.x); v[2] = bflo(w.y); v[3] = bfhi(w.y); v[4] = bflo(w.z); v[5] = bfhi(w.z); v[6] = bflo(w.w); v[7] = bfhi(w.w); }
DI int modidx(int row) { return row < MP ? 0 : 1 + ((row - MP) >> 11); }
DI float wave_sum(float v) {
#pragma unroll
    for (int o = 1; o < 64; o <<= 1) v += __shfl_xor(v, o);
    return v;
}
DI float sigmoidf_(float x) { return 1.f / (1.f + __expf(-x)); }
DI int crow(int i, int hi) { return (i & 3) + 8 * (i >> 2) + 4 * hi; }
DI int permkey(int p) { const int s = p >> 4, hh = (p >> 3) & 1, jj = p & 7; return 16 * s + 8 * (jj >> 2) + 4 * hh + (jj & 3); }

template <int ACT> struct EpiLin {
    static constexpr bool PERM = true, AFTER_DRAIN = false;
    bf16_t* O; int ldc; const float* bias; int ldb; const float* ssq;
    DI void operator()(const f32x4 (&acc)[2][2][4][2], const pg8::Unit& u, int wr, int wc, int fr, int fq) const {
        const int row0 = u.pm * 256 + wr * 64 + fr, col0 = u.pn * 256 + wc * 32 + 8 * fq;
        const float* bp = bias + (size_t)modidx(u.pm * 256) * ldb + col0;
        f32x4 bv[2][2];
#pragma unroll
        for (int bj = 0; bj < 2; ++bj)
#pragma unroll
            for (int n = 0; n < 2; ++n) bv[bj][n] = *(const f32x4*)(bp + bj * 128 + 4 * n);
#pragma unroll
        for (int ai = 0; ai < 2; ++ai)
#pragma unroll
            for (int m = 0; m < 4; ++m) {
                const int row = row0 + ai * 128 + m * 16;
                const f32x4 s4 = *(const f32x4*)(ssq + (size_t)row * 16 + 4 * fq);
                float s = (s4.x + s4.y) + (s4.z + s4.w); s += __shfl_xor(s, 16); s += __shfl_xor(s, 32);
                const float rstd = rsqrtf(s * (1.f / 1024.f) + EPS);
                bf16_t* rowp = O + (size_t)row * ldc + col0;
#pragma unroll
                for (int bj = 0; bj < 2; ++bj) {
                    f32x4 v0 = acc[ai][bj][m][0] * rstd + bv[bj][0], v1 = acc[ai][bj][m][1] * rstd + bv[bj][1];
                    if (ACT == 1) {
#pragma unroll
                        for (int e = 0; e < 4; ++e) { const float a = fmaxf(v0[e], 0.f), b = fmaxf(v1[e], 0.f); v0[e] = a * a; v1[e] = b * b; }
                    }
                    u32x4 w; w.x = pk2(v0[0], v0[1]); w.y = pk2(v0[2], v0[3]); w.z = pk2(v1[0], v1[1]); w.w = pk2(v1[2], v1[3]);
                    *(u32x4*)(rowp + bj * 128) = w;
                }
            }
    }
};
struct EpiRes {
    static constexpr bool PERM = false, AFTER_DRAIN = false;
    const float* baseP; const float* baseS; float* out; const float* gate; const float* nw; const float* sc; bf16_t* xg; float* ssq; int has_next;
    DI void operator()(const f32x4 (&acc)[2][2][4][2], const pg8::Unit& u, int wr, int wc, int fr, int fq) const {
        const int col0 = u.pn * 256 + wc * 32 + 4 * fq, j = modidx(u.pm * 256);
        const float* gp = gate + (size_t)j * 6144 + col0;
        f32x4 gv[2][2], gn[2][2];
#pragma unroll
        for (int bj = 0; bj < 2; ++bj)
#pragma unroll
            for (int n = 0; n < 2; ++n) {
                gv[bj][n] = *(const f32x4*)(gp + bj * 128 + n * 16);
                if (has_next) gn[bj][n] = *(const f32x4*)(nw + col0 + bj * 128 + n * 16) * (*(const f32x4*)(sc + (size_t)j * 6144 + col0 + bj * 128 + n * 16) + 1.0f);
                else gn[bj][n] = (f32x4){0.f, 0.f, 0.f, 0.f};
            }
#pragma unroll
        for (int ai = 0; ai < 2; ++ai)
#pragma unroll
            for (int m = 0; m < 4; ++m) {
                const int row = u.pm * 256 + ai * 128 + wr * 64 + m * 16 + fr;
                const float* b = (row < MP) ? baseP + (size_t)row * D : baseS + (size_t)(row - MP) * D;
                float q = 0.f;
#pragma unroll
                for (int bj = 0; bj < 2; ++bj)
#pragma unroll
                    for (int n = 0; n < 2; ++n) {
                        const int c = col0 + bj * 128 + n * 16;
                        const f32x4 x = *(const f32x4*)(b + c) + gv[bj][n] * acc[ai][bj][m][n];
                        *(f32x4*)(out + (size_t)row * D + c) = x;
                        q += (x.x * x.x + x.y * x.y) + (x.z * x.z + x.w * x.w);
                        if (has_next) { const f32x4 y = x * gn[bj][n]; u32x2 w; w.x = pk2(y.x, y.y); w.y = pk2(y.z, y.w); *(u32x2*)(xg + (size_t)row * D + c) = w; }
                    }
                q += __shfl_xor(q, 16); q += __shfl_xor(q, 32);
                if (fq == 0 && has_next) ssq[(size_t)row * 16 + u.pn * 4 + wc] = q;
            }
    }
};

DI void transpose_item(const float* W, int K, int N, bf16_t* WT, LAS float* scr, int item, int lane) {
    const int nblk = N / 32, kb = item / nblk, nb = item % nblk, k0 = 64 * kb, n0 = 32 * nb;
#pragma unroll 8
    for (int i = 0; i < 32; ++i) { const int kk = 2 * i + (lane >> 5); scr[kk * 33 + (lane & 31)] = W[(size_t)(k0 + kk) * N + n0 + (lane & 31)]; }
    asm volatile("s_waitcnt lgkmcnt(0)" ::: "memory");
    const int c = lane & 7;
#pragma unroll
    for (int j = 0; j < 4; ++j) { const int n = (lane >> 3) + 8 * j; const LAS float* s = scr + (8 * c) * 33 + n;
        u32x4 o; o.x = pk2(s[0 * 33], s[1 * 33]); o.y = pk2(s[2 * 33], s[3 * 33]); o.z = pk2(s[4 * 33], s[5 * 33]); o.w = pk2(s[6 * 33], s[7 * 33]);
        *(u32x4*)(WT + (size_t)(n0 + n) * K + k0 + 8 * c) = o; }
    asm volatile("s_waitcnt lgkmcnt(0)" ::: "memory");
}
DI void gemv9_unit(const float* W, int N, int n0, const float* v0, const float* v1, int vs, bool do_silu, const float* badd, float* out, int ostride, float* scr, int tid) {
    const int wave = __builtin_amdgcn_readfirstlane(tid >> 6), lane = tid & 63;
    float acc[NMOD];
#pragma unroll
    for (int j = 0; j < NMOD; ++j) acc[j] = 0.f;
    const float* wp = W + (size_t)(wave * 128) * N + n0 + lane;
#pragma unroll 4
    for (int k = 0; k < 128; ++k) {
        const float w = wp[(size_t)k * N];
        const int kk = wave * 128 + k;
#pragma unroll
        for (int j = 0; j < NMOD; ++j) {
            float v = (j == 0) ? v0[kk] : v1[(size_t)(j - 1) * vs + kk];
            if (do_silu) v = v * sigmoidf_(v);
            acc[j] += v * w;
        }
    }
#pragma unroll
    for (int j = 0; j < NMOD; ++j) scr[(wave * NMOD + j) * 64 + lane] = acc[j];
    __syncthreads();
    for (int idx = tid; idx < NMOD * 64; idx += 512) {
        const int j = idx >> 6, ln = idx & 63; float s = 0.f;
#pragma unroll
        for (int w = 0; w < 8; ++w) s += scr[(w * NMOD + j) * 64 + ln];
        if (badd) s += badd[n0 + ln];
        out[(size_t)j * ostride + n0 + ln] = s;
    }
    __syncthreads();
}

DI void conv_unit(int ct, int l, const bf16_t* RAW, bf16_t* ATT, const float* dw_w, const float* dw_b, const float* ln_g, const float* ln_b, float* lds, int tid) {
    const int row0 = ct * 64;
    int seq0, L;
    if (row0 < MP) { seq0 = row0 & ~255; L = 256; } else { seq0 = MP + ((row0 - MP) & ~2047); L = 2048; }
    const int t0 = row0 - seq0;
    for (int it = tid; it < 94 * 32; it += 512) {
        const int rr = it >> 5, c8 = it & 31, t = t0 - 15 + rr;
        float hv[8];
        if (t >= 0 && t < L) {
            const bf16_t* p = RAW + (size_t)(seq0 + t) * INW + c8 * 8;
            const u32x4 wa = *(const u32x4*)p, wg = *(const u32x4*)(p + 256);
            float a[8], g[8]; unpack8(wa, a); unpack8(wg, g);
#pragma unroll
            for (int e = 0; e < 8; ++e) hv[e] = a[e] * sigmoidf_(g[e]);
        } else {
#pragma unroll
            for (int e = 0; e < 8; ++e) hv[e] = 0.f;
        }
        float* d = lds + rr * 256 + c8 * 8;
        *(f32x4*)d = (f32x4){hv[0], hv[1], hv[2], hv[3]}; *(f32x4*)(d + 4) = (f32x4){hv[4], hv[5], hv[6], hv[7]};
    }
    __syncthreads();
    const int c = tid & 255, th = tid >> 8;
    float w[31];
#pragma unroll
    for (int k = 0; k < 31; ++k) w[k] = dw_w[(size_t)(l * 31 + k) * 256 + c];
    const float bias = dw_b[l * 256 + c];
    float outv[32];
#pragma unroll
    for (int ch = 0; ch < 2; ++ch) {
        float hv[46];
#pragma unroll
        for (int i = 0; i < 46; ++i) hv[i] = lds[(th * 32 + ch * 16 + i) * 256 + c];
#pragma unroll
        for (int o = 0; o < 16; ++o) {
            float s = bias;
#pragma unroll
            for (int k = 0; k < 31; ++k) s += hv[o + k] * w[k];
            outv[ch * 16 + o] = s;
        }
    }
    __syncthreads();
#pragma unroll
    for (int o = 0; o < 32; ++o) lds[(th * 32 + o) * 256 + c] = outv[o];
    __syncthreads();
    const int wave = tid >> 6, lane = tid & 63;
    const f32x4 g4 = *(const f32x4*)(ln_g + l * 256 + 4 * lane), b4 = *(const f32x4*)(ln_b + l * 256 + 4 * lane);
#pragma unroll
    for (int i = 0; i < 8; ++i) {
        const int tk = wave * 8 + i;
        const f32x4 v = *(const f32x4*)(lds + tk * 256 + 4 * lane);
        const float mean = wave_sum((v.x + v.y) + (v.z + v.w)) * (1.f / 256.f);
        const f32x4 dv = v - mean;
        const float var = wave_sum((dv.x * dv.x + dv.y * dv.y) + (dv.z * dv.z + dv.w * dv.w)) * (1.f / 256.f);
        const float rstd = rsqrtf(var + EPS);
        f32x4 y = dv * rstd * g4 + b4;
        y.x *= sigmoidf_(y.x); y.y *= sigmoidf_(y.y); y.z *= sigmoidf_(y.z); y.w *= sigmoidf_(y.w);
        u32x2 o; o.x = pk2(y.x, y.y); o.y = pk2(y.z, y.w);
        *(u32x2*)(ATT + (size_t)(row0 + tk) * D + 4 * lane) = o;
    }
    __syncthreads();
}

struct PrepP { const bf16_t* RAW; bf16_t* Q; bf16_t* K; bf16_t* VT; float* out; const float *aqg, *akg, *nqg, *nkg; };
DI void qkv_unit(int ct, int l, const PrepP& P, bf16_t* ldsv, int tid) {
    const int row0 = ct * 64;
    const bool prompt = row0 < MP;
    int seq0, L, sb;
    if (prompt) { seq0 = row0 & ~255; L = 256; sb = row0 >> 8; } else { seq0 = MP + ((row0 - MP) & ~2047); L = 2048; sb = (row0 - MP) >> 11; }
    const int t0 = row0 - seq0;
    for (int it = tid; it < 64 * 20 * 8; it += 512) {
        const int c8 = it & 7, hr = it >> 3, tok = hr / 20, hd = hr - tok * 20;
        const int row = row0 + tok, t = t0 + tok;
        int rcol; const float* gw; bool isq;
        if (hd < 6) { rcol = 512 + 64 * hd; gw = P.aqg; isq = true; }
        else if (hd < 8) { rcol = 896 + 64 * (hd - 6); gw = P.akg; isq = false; }
        else if (hd < 14) { rcol = 1152 + 64 * (hd - 8); gw = P.nqg; isq = true; }
        else { rcol = 1536 + 64 * (hd - 14); gw = P.nkg; isq = false; }
        const u32x4 wv = *(const u32x4*)(P.RAW + (size_t)row * INW + rcol + 8 * c8);
        float v[8]; unpack8(wv, v);
        float ss = 0.f;
#pragma unroll
        for (int e = 0; e < 8; ++e) ss += v[e] * v[e];
        ss += __shfl_xor(ss, 1); ss += __shfl_xor(ss, 2); ss += __shfl_xor(ss, 4);
        const float rstd = rsqrtf(ss * (1.f / 64.f) + EPS);
        const f32x4 g0 = *(const f32x4*)(gw + l * 64 + 8 * c8), g1 = *(const f32x4*)(gw + l * 64 + 8 * c8 + 4);
        v[0] *= rstd * g0.x; v[1] *= rstd * g0.y; v[2] *= rstd * g0.z; v[3] *= rstd * g0.w;
        v[4] *= rstd * g1.x; v[5] *= rstd * g1.y; v[6] *= rstd * g1.z; v[7] *= rstd * g1.w;
        const bool rope = (!prompt) && (hd < 8);
        const float pos = (float)((c8 >> 2) ? (t & 63) : (t >> 6));
        const bool first = (c8 & 2) == 0;
#pragma unroll
        for (int e = 0; e < 8; ++e) {
            const float pv = __shfl_xor(v[e], 2);
            const int jj = 8 * (c8 & 1) + e;
            const float inv = exp2f(-(float)jj * 0.8304820237218406f);
            const float ang = pos * inv;
            float sn, cs; __sincosf(ang, &sn, &cs);
            const float r = first ? (v[e] * cs - pv * sn) : (v[e] * cs + pv * sn);
            v[e] = rope ? r : v[e];
        }
        if (isq) {
            const int qcol = (hd < 6) ? 64 * hd : 384 + 64 * (hd - 8);
            u32x4 o; o.x = pk2(v[0] * QSCALE, v[1] * QSCALE); o.y = pk2(v[2] * QSCALE, v[3] * QSCALE); o.z = pk2(v[4] * QSCALE, v[5] * QSCALE); o.w = pk2(v[6] * QSCALE, v[7] * QSCALE);
            *(u32x4*)(P.Q + (size_t)row * 768 + qcol + 8 * c8) = o;
        } else {
            const int kcol = (hd < 8) ? 64 * (hd - 6) : 128 + 64 * (hd - 14);
            u32x4 o; o.x = pk2(v[0], v[1]); o.y = pk2(v[2], v[3]); o.z = pk2(v[4], v[5]); o.w = pk2(v[6], v[7]);
            *(u32x4*)(P.K + (size_t)row * 512 + kcol + 8 * c8) = o;
            if (prompt) {
                float* op;
                if (hd < 8) op = P.out + OFF_AK + ((((size_t)sb * 4 + l) * 256 + t) * 2 + (hd - 6)) * 64 + 8 * c8;
                else        op = P.out + OFF_NK + ((((size_t)sb * 4 + l) * 256 + t) * 6 + (hd - 14)) * 64 + 8 * c8;
                *(f32x4*)op = (f32x4){v[0], v[1], v[2], v[3]}; *(f32x4*)(op + 4) = (f32x4){v[4], v[5], v[6], v[7]};
            }
        }
    }
    for (int it = tid; it < 64 * 64; it += 512) {
        const int tok = it >> 6, ch = it & 63;
        const int cc = ch * 8, rcol = (cc < 128) ? 1024 + cc : 1920 + (cc - 128);
        const u32x4 wv = *(const u32x4*)(P.RAW + (size_t)(row0 + tok) * INW + rcol);
        *(u32x4*)(ldsv + tok * 512 + cc) = wv;
        if (prompt) {
            float v[8]; unpack8(wv, v);
            const int t = t0 + tok; float* op;
            if (cc < 128) op = P.out + OFF_AV + (((size_t)sb * 4 + l) * 256 + t) * 128 + cc;
            else          op = P.out + OFF_NV + (((size_t)sb * 4 + l) * 256 + t) * 384 + (cc - 128);
            *(f32x4*)op = (f32x4){v[0], v[1], v[2], v[3]}; *(f32x4*)(op + 4) = (f32x4){v[4], v[5], v[6], v[7]};
        }
    }
    __syncthreads();
    for (int it = tid; it < 512 * 8; it += 512) {
        const int hd_d = it & 511, g = it >> 9;
        unsigned short e[8];
#pragma unroll
        for (int jj = 0; jj < 8; ++jj) { const int p = 8 * g + jj; const int key = (p & ~31) + permkey(p & 31); e[jj] = ldsv[key * 512 + hd_d]; }
        u32x4 o; o.x = e[0] | ((unsigned)e[1] << 16); o.y = e[2] | ((unsigned)e[3] << 16); o.z = e[4] | ((unsigned)e[5] << 16); o.w = e[6] | ((unsigned)e[7] << 16);
        const size_t base = prompt ? ((size_t)sb * 512 + hd_d) * 256 : (size_t)MP * 512 + ((size_t)sb * 512 + hd_d) * 2048;
        *(u32x4*)(P.VT + base + t0 + 8 * g) = o;
    }
    __syncthreads();
}

struct Seg { const bf16_t* k; int kp; const bf16_t* v; int vp; int nt; };
#define MFMA32(a, b, c) __builtin_amdgcn_mfma_f32_32x32x16_bf16((a), (b), (c), 0, 0, 0)
DI void ld_k(const Seg& A, const Seg& B, int t, int r32, int hi, bf16x8 (&kf)[4]) {
    const bf16_t* kp; int kpi;
    if (t < A.nt) { kp = A.k + (size_t)(32 * t) * A.kp; kpi = A.kp; }
    else { const int tb = t - A.nt; kp = B.k + (size_t)(32 * tb) * B.kp; kpi = B.kp; }
#pragma unroll
    for (int kk = 0; kk < 4; ++kk) kf[kk] = *(const bf16x8*)(kp + (size_t)r32 * kpi + 16 * kk + 8 * hi);
}
DI void ld_v(const Seg& A, const Seg& B, int t, int r32, int hi, bf16x8 (&vf)[2][2]) {
    const bf16_t* vp; int vpi;
    if (t < A.nt) { vp = A.v + 32 * t; vpi = A.vp; }
    else { const int tb = t - A.nt; vp = B.v + 32 * tb; vpi = B.vp; }
#pragma unroll
    for (int db = 0; db < 2; ++db)
#pragma unroll
        for (int s = 0; s < 2; ++s) vf[db][s] = *(const bf16x8*)(vp + (size_t)(32 * db + r32) * vpi + 16 * s + 8 * hi);
}
template <bool NA> DI void attn_wave(const bf16_t* Qp, const Seg A, const Seg B, bf16_t* Op, const float* rpbh, int r, int rs, int lane_) {
    int lane = lane_; asm volatile("" : "+v"(lane));
    const int r32 = lane & 31, hi = lane >> 5;
    bf16x8 qf[2][4];
#pragma unroll
    for (int qb = 0; qb < 2; ++qb)
#pragma unroll
        for (int kk = 0; kk < 4; ++kk) qf[qb][kk] = *(const bf16x8*)(Qp + (size_t)(32 * qb + r32) * 768 + 16 * kk + 8 * hi);
    f32x16 o[2][2];
#pragma unroll
    for (int a = 0; a < 2; ++a)
#pragma unroll
        for (int b = 0; b < 2; ++b)
#pragma unroll
            for (int i = 0; i < 16; ++i) o[a][b][i] = 0.f;
    float mrun[2] = {-1e30f, -1e30f}, lrun[2] = {0.f, 0.f};
    const int nt = A.nt + B.nt;
    bf16x8 kf[4], vf[2][2], kn[4];
    ld_k(A, B, 0, r32, hi, kf);
    for (int t = 0; t < nt; ++t) {
        const int tn = (t + 1 < nt) ? t + 1 : t;
        ld_v(A, B, t, r32, hi, vf);
        ld_k(A, B, tn, r32, hi, kn);
#pragma unroll
        for (int qb = 0; qb < 2; ++qb) {
            f32x16 s;
#pragma unroll
            for (int i = 0; i < 16; ++i) s[i] = 0.f;
#pragma unroll
            for (int kk = 0; kk < 4; ++kk) s = MFMA32(kf[kk], qf[qb][kk], s);
            if (NA) {
                if (t < A.nt) {
                    const int a = t >> 1, half = t & 1;
                    const float* bp = rpbh + (rs + a - r + 7) * 31;
                    const int qc = 32 * qb + r32; const int cs = min(max(qc - 8, 0), 48);
#pragma unroll
                    for (int i = 0; i < 16; ++i) {
                        const int kc = 32 * half + crow(i, hi);
                        const bool valid = (kc >= cs) && (kc < cs + 16);
                        const int co = min(max(kc - qc + 15, 0), 30);
                        const float bia = bp[co] * LOG2E;
                        s[i] = valid ? s[i] + bia : -1e30f;
                    }
                }
            }
            float mx = s[0];
#pragma unroll
            for (int i = 1; i < 16; ++i) mx = fmaxf(mx, s[i]);
            mx = fmaxf(mx, __shfl_xor(mx, 32));
            const float mn = fmaxf(mrun[qb], mx);
            const float alpha = __builtin_amdgcn_exp2f(mrun[qb] - mn);
            mrun[qb] = mn;
            float ps = 0.f;
#pragma unroll
            for (int i = 0; i < 16; ++i) { const float p = __builtin_amdgcn_exp2f(s[i] - mn); s[i] = p; ps += p; }
            lrun[qb] = lrun[qb] * alpha + ps;
#pragma unroll
            for (int i = 0; i < 16; ++i) { o[qb][0][i] *= alpha; o[qb][1][i] *= alpha; }
            u32x4 p0, p1;
            p0.x = pk2(s[0], s[1]); p0.y = pk2(s[2], s[3]); p0.z = pk2(s[4], s[5]); p0.w = pk2(s[6], s[7]);
            p1.x = pk2(s[8], s[9]); p1.y = pk2(s[10], s[11]); p1.z = pk2(s[12], s[13]); p1.w = pk2(s[14], s[15]);
            const bf16x8 P0 = __builtin_bit_cast(bf16x8, p0), P1 = __builtin_bit_cast(bf16x8, p1);
#pragma unroll
            for (int db = 0; db < 2; ++db) { o[qb][db] = MFMA32(vf[db][0], P0, o[qb][db]); o[qb][db] = MFMA32(vf[db][1], P1, o[qb][db]); }
        }
#pragma unroll
        for (int kk = 0; kk < 4; ++kk) kf[kk] = kn[kk];
    }
#pragma unroll
    for (int qb = 0; qb < 2; ++qb) {
        const float lt = lrun[qb] + __shfl_xor(lrun[qb], 32);
        const float inv = 1.f / lt;
        bf16_t* orow = Op + (size_t)(32 * qb + r32) * D;
#pragma unroll
        for (int db = 0; db < 2; ++db)
#pragma unroll
            for (int g = 0; g < 4; ++g) {
                u32x2 w; w.x = pk2(o[qb][db][4 * g] * inv, o[qb][db][4 * g + 1] * inv); w.y = pk2(o[qb][db][4 * g + 2] * inv, o[qb][db][4 * g + 3] * inv);
                *(u32x2*)(orow + 32 * db + 8 * g + 4 * hi) = w;
            }
    }
}

struct AttnP { const bf16_t *Q, *K, *VT, *KCA, *VCA, *KCN, *VCN; bf16_t* ATT; const float* rpb; };
DI void attn_run_unit(int uid, int l, const AttnP& P, int lane) {
    const Seg none{nullptr, 0, nullptr, 0, 0};
    if (uid < 1536) {
        const int qc = uid & 31, bh = uid >> 5, b = bh / 6, h = bh - 6 * b, kvh = h / 3;
        const int row0 = MP + b * 2048;
        Seg A{P.K + (size_t)row0 * 512 + kvh * 64, 512, P.VT + (size_t)MP * 512 + ((size_t)b * 512 + kvh * 64) * 2048, 2048, 64};
        Seg B{P.KCA + ((size_t)((b * 4 + l) * 2 + kvh) * 256) * 64, 64, P.VCA + ((size_t)((b * 4 + l) * 2 + kvh) * 64) * 256, 256, 8};
        attn_wave<false>(P.Q + (size_t)(row0 + qc * 64) * 768 + h * 64, A, B, P.ATT + (size_t)(row0 + qc * 64) * D + 256 + h * 64, nullptr, 0, 0, lane);
    } else if (uid < 3072) {
        const int u = uid - 1536, r = u & 31, bh = u >> 5, b = bh / 6, h = bh - 6 * b;
        const int row0 = MP + b * 2048, rs = min(max(r - 4, 0), 24);
        Seg A{P.K + (size_t)(row0 + rs * 64) * 512 + 128 + h * 64, 512, P.VT + (size_t)MP * 512 + ((size_t)b * 512 + 128 + h * 64) * 2048 + rs * 64, 2048, 16};
        Seg B{P.KCN + ((size_t)((b * 4 + l) * 6 + h) * 256) * 64, 64, P.VCN + ((size_t)((b * 4 + l) * 6 + h) * 64) * 256, 256, 8};
        attn_wave<true>(P.Q + (size_t)(row0 + r * 64) * 768 + 384 + h * 64, A, B, P.ATT + (size_t)(row0 + r * 64) * D + 640 + h * 64, P.rpb + (size_t)(l * 6 + h) * 15 * 31, r, rs, lane);
    } else if (uid < 3840) {
        const int u = uid - 3072, qc = u & 3, bh = u >> 2, b = bh / 6, h = bh - 6 * b, kvh = h / 3;
        const int row0 = b * 256;
        Seg A{P.K + (size_t)row0 * 512 + kvh * 64, 512, P.VT + ((size_t)b * 512 + kvh * 64) * 256, 256, 8};
        attn_wave<false>(P.Q + (size_t)(row0 + qc * 64) * 768 + h * 64, A, none, P.ATT + (size_t)(row0 + qc * 64) * D + 256 + h * 64, nullptr, 0, 0, lane);
    } else {
        const int u = uid - 3840, qc = u & 3, bh = u >> 2, b = bh / 6, h = bh - 6 * b;
        const int row0 = b * 256;
        Seg A{P.K + (size_t)row0 * 512 + 128 + h * 64, 512, P.VT + ((size_t)b * 512 + 128 + h * 64) * 256, 256, 8};
        attn_wave<false>(P.Q + (size_t)(row0 + qc * 64) * 768 + 384 + h * 64, A, none, P.ATT + (size_t)(row0 + qc * 64) * D + 640 + h * 64, nullptr, 0, 0, lane);
    }
}

struct Args {
    const float* in[25]; float* out; unsigned char* ws; int ph_lo, ph_hi;
};
typedef const __attribute__((address_space(4))) char* kargp_t;
DI const float* ldin(int i) { kargp_t kp = (kargp_t)__builtin_amdgcn_kernarg_segment_ptr(); asm volatile("" : "+s"(kp)); return (const float*)(*(const __attribute__((address_space(4))) unsigned long long*)(kp + 8 * i)); }
DI float* ldout() { return (float*)ldin(25); }
DI unsigned char* ldws() { return (unsigned char*)ldin(26); }
DI int opq_tid() { int t = threadIdx.x; asm volatile("" : "+v"(t)); return t; }

__global__ void __launch_bounds__(512, 2) fwd_kernel(Args a) {
    extern __shared__ __attribute__((aligned(16))) unsigned char lds[];
    cg::grid_group grid = cg::this_grid();
    const int G = gridDim.x, bx = blockIdx.x, NGW = G * 8;
    const int lo = a.ph_lo, hi = a.ph_hi;
#define IN(k) (lo <= (k) && (k) < hi)
#define SEAM(k) do { if ((k) + 1 < hi) grid.sync(); } while (0)
#define WSP(T, off) ((T*)(ws + (off)))

    if (IN(0)) {
        const int tid = opq_tid(), lane = tid & 63, wave = __builtin_amdgcn_readfirstlane(tid >> 6), gw = bx * 8 + wave;
        unsigned char* ws = ldws();
        {
            const float *cvec = ldin(6), *c_ctx = ldin(7), *ada_w = ldin(8), *ada_b = ldin(9);
            float* mod = WSP(float, WS_MOD);
            for (int u = bx; u < DEPTH * 96; u += G) {
                const int l = u / 96, nb = u - l * 96;
                gemv9_unit(ada_w + (size_t)l * D * 6144, 6144, nb * 64, c_ctx, cvec, D, true, ada_b + l * 6144, mod + (size_t)l * NMOD * 6144, 6144, (float*)lds, tid);
            }
        }
        {
            const float *w_in = ldin(12), *w_out = ldin(22), *w1 = ldin(23), *w2 = ldin(24);
            bf16_t *WIN = WSP(bf16_t, WS_WIN), *WOUT = WSP(bf16_t, WS_WOUT), *W1T = WSP(bf16_t, WS_W1), *W2T = WSP(bf16_t, WS_W2);
            LAS float* scr = (LAS float*)((LAS unsigned char*)lds + wave * 16384);
            constexpr int I_IN = 16 * 72, I_OUT = 16 * 32, I_1 = 16 * 128, I_2 = 64 * 32, I_L = I_IN + I_OUT + I_1 + I_2;
            for (int it = gw; it < DEPTH * I_L; it += NGW) {
                const int l = it / I_L; int r = it - l * I_L;
                if (r < I_IN) { transpose_item(w_in + (size_t)l * D * INW, D, INW, WIN + (size_t)l * INW * D, scr, r, lane); continue; } r -= I_IN;
                if (r < I_OUT) { transpose_item(w_out + (size_t)l * D * D, D, D, WOUT + (size_t)l * D * D, scr, r, lane); continue; } r -= I_OUT;
                if (r < I_1) { transpose_item(w1 + (size_t)l * D * FF, D, FF, W1T + (size_t)l * FF * D, scr, r, lane); continue; } r -= I_1;
                transpose_item(w2 + (size_t)l * FF * D, FF, D, W2T + (size_t)l * D * FF, scr, r, lane);
            }
        }
        {
            const float *cache_ak = ldin(2), *cache_av = ldin(3), *cache_nk = ldin(4), *cache_nv = ldin(5);
            bf16_t *KCA = WSP(bf16_t, WS_KCA), *VCA = WSP(bf16_t, WS_VCA), *KCN = WSP(bf16_t, WS_KCN), *VCN = WSP(bf16_t, WS_VCN);
            const int gt = bx * 512 + tid, NGT = G * 512;
            for (int e = gt; e < 8 * 4 * 256 * 8 * 8; e += NGT) {
                const int c8 = e & 7, hh = (e >> 3) & 7, key = (e >> 6) & 255, bl = e >> 14;
                const float* src; bf16_t* dst;
                if (hh < 2) { src = cache_ak + (((size_t)bl * 256 + key) * 2 + hh) * 64 + 8 * c8; dst = KCA + (((size_t)bl * 2 + hh) * 256 + key) * 64 + 8 * c8; }
                else { src = cache_nk + (((size_t)bl * 256 + key) * 6 + (hh - 2)) * 64 + 8 * c8; dst = KCN + (((size_t)bl * 6 + (hh - 2)) * 256 + key) * 64 + 8 * c8; }
                const f32x4 v0 = *(const f32x4*)src, v1 = *(const f32x4*)(src + 4);
                u32x4 o; o.x = pk2(v0.x, v0.y); o.y = pk2(v0.z, v0.w); o.z = pk2(v1.x, v1.y); o.w = pk2(v1.z, v1.w);
                *(u32x4*)dst = o;
            }
            for (int e = gt; e < 8 * 4 * 8 * 32 * 64; e += NGT) {
                const int d = e & 63, g = (e >> 6) & 31, hh = (e >> 11) & 7, bl = e >> 14;
                unsigned short q[8];
#pragma unroll
                for (int jj = 0; jj < 8; ++jj) {
                    const int p = 8 * g + jj, key = (p & ~31) + permkey(p & 31);
                    const float v = (hh < 2) ? cache_av[(((size_t)bl * 256 + key) * 2 + hh) * 64 + d] : cache_nv[(((size_t)bl * 256 + key) * 6 + (hh - 2)) * 64 + d];
                    q[jj] = (unsigned short)(pk2(v, 0.f) & 0xffffu);
                }
                u32x4 o; o.x = q[0] | ((unsigned)q[1] << 16); o.y = q[2] | ((unsigned)q[3] << 16); o.z = q[4] | ((unsigned)q[5] << 16); o.w = q[6] | ((unsigned)q[7] << 16);
                bf16_t* dst = (hh < 2) ? VCA + (((size_t)bl * 2 + hh) * 64 + d) * 256 + 8 * g : VCN + (((size_t)bl * 6 + (hh - 2)) * 64 + d) * 256 + 8 * g;
                *(u32x4*)dst = o;
            }
        }
        SEAM(0);
    }
    if (IN(1)) {
        const int tid = opq_tid(), lane = tid & 63, wave = __builtin_amdgcn_readfirstlane(tid >> 6), gw = bx * 8 + wave;
        unsigned char* ws = ldws();
        float* mod = WSP(float, WS_MOD);
        {
            const float *w_in = ldin(12), *w1 = ldin(23);
            float *bias1 = WSP(float, WS_BIAS1), *bias2 = WSP(float, WS_BIAS2);
            for (int u = bx; u < DEPTH * 100; u += G) {
                const int l = u / 100; int r = u - l * 100;
                const float* ml = mod + (size_t)l * NMOD * 6144;
                if (r < 36) gemv9_unit(w_in + (size_t)l * D * INW, INW, r * 64, ml, ml + 6144, 6144, false, nullptr, bias1 + (size_t)l * NMOD * INW, INW, (float*)lds, tid);
                else { r -= 36; gemv9_unit(w1 + (size_t)l * D * FF, FF, r * 64, ml + 3072, ml + 6144 + 3072, 6144, false, nullptr, bias2 + (size_t)l * NMOD * FF, FF, (float*)lds, tid); }
            }
        }
        {
            const float *x_prompt = ldin(0), *x_sample = ldin(1), *norm1_g = ldin(10);
            bf16_t* XG = WSP(bf16_t, WS_XG); float* ssq = WSP(float, WS_SSQ);
            for (int row = gw; row < M; row += NGW) {
                const float* xr = (row < MP) ? x_prompt + (size_t)row * D : x_sample + (size_t)(row - MP) * D;
                const float* scp = mod + (size_t)modidx(row) * 6144 + 1024;
                float s = 0.f;
#pragma unroll
                for (int j = 0; j < 4; ++j) {
                    const int c = 256 * j + 4 * lane;
                    const f32x4 v = *(const f32x4*)(xr + c);
                    s += (v.x * v.x + v.y * v.y) + (v.z * v.z + v.w * v.w);
                    const f32x4 y = v * (*(const f32x4*)(norm1_g + c)) * (*(const f32x4*)(scp + c) + 1.0f);
                    u32x2 w; w.x = pk2(y.x, y.y); w.y = pk2(y.z, y.w);
                    *(u32x2*)(XG + (size_t)row * D + c) = w;
                }
                s = wave_sum(s);
                if (lane < 16) ssq[(size_t)row * 16 + lane] = (lane == 0) ? s : 0.f;
            }
        }
        SEAM(1);
    }
#pragma nounroll
    for (int l_ = 0; l_ < DEPTH; ++l_) {
        int l = l_; asm volatile("" : "+s"(l));
        const int p0 = 2 + 6 * l;
        if (IN(p0)) {
            unsigned char* ws = ldws();
            pg8::Gemm g{WSP(bf16_t, WS_XG), WSP(bf16_t, WS_WIN) + (size_t)l * INW * D, M, INW, D}; pg8::StaticOrder S; S.init(M, INW, G, bx);
            EpiLin<0> E{WSP(bf16_t, WS_RAW), INW, WSP(float, WS_BIAS1) + (size_t)l * NMOD * INW, INW, WSP(float, WS_SSQ)};
            pg8::gemm_phase<EpiLin<0>, pg8::StaticOrder, true, true>((LAS unsigned char*)lds, g, S, E);
            SEAM(p0);
        }
        if (IN(p0 + 1)) {
            const int tid = opq_tid();
            unsigned char* ws = ldws();
            for (int u = bx; u < 768; u += G) {
                if (u < 384) conv_unit(u, l, WSP(bf16_t, WS_RAW), WSP(bf16_t, WS_ATT), ldin(13), ldin(14), ldin(15), ldin(16), (float*)lds, tid);
                else { PrepP P{WSP(bf16_t, WS_RAW), WSP(bf16_t, WS_Q), WSP(bf16_t, WS_K), WSP(bf16_t, WS_VT), ldout(), ldin(17), ldin(18), ldin(19), ldin(20)}; qkv_unit(u - 384, l, P, (bf16_t*)lds, tid); }
            }
            SEAM(p0 + 1);
        }
        if (IN(p0 + 2)) {
            const int tid = opq_tid(), lane = tid & 63, wave = __builtin_amdgcn_readfirstlane(tid >> 6), gw = bx * 8 + wave;
            unsigned char* ws = ldws();
            AttnP P{WSP(bf16_t, WS_Q), WSP(bf16_t, WS_K), WSP(bf16_t, WS_VT), WSP(bf16_t, WS_KCA), WSP(bf16_t, WS_VCA), WSP(bf16_t, WS_KCN), WSP(bf16_t, WS_VCN), WSP(bf16_t, WS_ATT), ldin(21)};
            const bool bal = (NGW == 2048);
            const int nu = bal ? (gw < 1536 ? 2 : 3) : (4608 - gw + NGW - 1) / NGW;
            for (int k = 0; k < nu; ++k) {
                const int uid = bal ? (gw < 1536 ? (k == 0 ? gw : 3072 + gw) : 1536 + 3 * (gw - 1536) + k) : gw + k * NGW;
                attn_run_unit(uid, l, P, lane);
            }
            SEAM(p0 + 2);
        }
        if (IN(p0 + 3)) {
            unsigned char* ws = ldws(); float* X = ldout();
            const float* ml = WSP(float, WS_MOD) + (size_t)l * NMOD * 6144;
            pg8::Gemm g{WSP(bf16_t, WS_ATT), WSP(bf16_t, WS_WOUT) + (size_t)l * D * D, M, D, D}; pg8::StaticOrder S; S.init(M, D, G, bx);
            EpiRes E{l == 0 ? ldin(0) : X, l == 0 ? ldin(1) : X + (size_t)MP * D, X, ml + 2048, ldin(11) + l * D, ml + 4096, WSP(bf16_t, WS_XG), WSP(float, WS_SSQ), 1};
            pg8::gemm_phase<EpiRes, pg8::StaticOrder, true, true>((LAS unsigned char*)lds, g, S, E);
            SEAM(p0 + 3);
        }
        if (IN(p0 + 4)) {
            unsigned char* ws = ldws();
            pg8::Gemm g{WSP(bf16_t, WS_XG), WSP(bf16_t, WS_W1) + (size_t)l * FF * D, M, FF, D}; pg8::StaticOrder S; S.init(M, FF, G, bx);
            EpiLin<1> E{WSP(bf16_t, WS_H1), FF, WSP(float, WS_BIAS2) + (size_t)l * NMOD * FF, FF, WSP(float, WS_SSQ)};
            pg8::gemm_phase<EpiLin<1>, pg8::StaticOrder, true, true>((LAS unsigned char*)lds, g, S, E);
            SEAM(p0 + 4);
        }
        if (IN(p0 + 5)) {
            unsigned char* ws = ldws(); float* X = ldout();
            const float* ml = WSP(float, WS_MOD) + (size_t)l * NMOD * 6144;
            pg8::Gemm g{WSP(bf16_t, WS_H1), WSP(bf16_t, WS_W2) + (size_t)l * D * FF, M, D, FF}; pg8::StaticOrder S; S.init(M, D, G, bx);
            const int nx = (l + 1 < DEPTH) ? 1 : 0; const int ln = nx ? l + 1 : l;
            EpiRes E{X, X + (size_t)MP * D, X, ml + 5120, ldin(10) + ln * D, WSP(float, WS_MOD) + (size_t)ln * NMOD * 6144 + 1024, WSP(bf16_t, WS_XG), WSP(float, WS_SSQ), nx};
            pg8::gemm_phase<EpiRes, pg8::StaticOrder, true, true>((LAS unsigned char*)lds, g, S, E);
            SEAM(p0 + 5);
        }
    }
#undef IN
#undef SEAM
#undef WSP
}

extern "C" void kernel_launch(void* const* d_in, const int* in_sizes, int n_in, void* d_out, int out_size, void* d_ws, size_t ws_size, hipStream_t stream) {
    static int grid = 0;
    if (grid == 0) {
        if (n_in != 25 || ws_size < WS_END) { fprintf(stderr, "kernel_launch: need 25 inputs and >= %zu bytes of workspace; got %d, %zu\n", (size_t)WS_END, n_in, ws_size); grid = -1; return; }
        int dev = 0, cus = 0, per_cu = 0;
        hipGetDevice(&dev);
        hipDeviceGetAttribute(&cus, hipDeviceAttributeMultiprocessorCount, dev);
        if (hipFuncSetAttribute((const void*)fwd_kernel, hipFuncAttributeMaxDynamicSharedMemorySize, LDS_BYTES) != hipSuccess) { fprintf(stderr, "kernel_launch: hipFuncSetAttribute failed\n"); grid = -1; return; }
        if (hipOccupancyMaxActiveBlocksPerMultiprocessor(&per_cu, (const void*)fwd_kernel, 512, LDS_BYTES) != hipSuccess || per_cu < 1) { fprintf(stderr, "kernel_launch: occupancy query says %d\n", per_cu); per_cu = 1; }
        (void)hipGetLastError();
        grid = cus * per_cu;
    }
    if (grid < 0) return;
    Args a{};
    for (int i = 0; i < 25; ++i) a.in[i] = (const float*)d_in[i];
    a.out = (float*)d_out; a.ws = (unsigned char*)d_ws;
#if MK_SINGLE
    a.ph_lo = 0; a.ph_hi = NPH;
    void* args[] = {&a};
    hipError_t e = hipLaunchCooperativeKernel((const void*)fwd_kernel, dim3(grid), dim3(512), args, LDS_BYTES, stream);
    if (e != hipSuccess) fprintf(stderr, "cooperative launch failed: %s (grid %d)\n", hipGetErrorString(e), grid);
#else
    for (int ph = 0; ph < NPH; ++ph) {
        a.ph_lo = ph; a.ph_hi = ph + 1;
        hipLaunchKernelGGL(fwd_kernel, dim3(grid), dim3(512), LDS_BYTES, stream, a);
    }
#endif
}
```

```cpp
#include <hip/hip_runtime.h>
#include <hip/hip_cooperative_groups.h>
#include <cstdio>
#include <cstdint>
namespace cg = cooperative_groups;
namespace pg8 {
#define PG8_LAS __attribute__((address_space(3)))
typedef unsigned short bf16_t;
typedef short bf16x8 __attribute__((ext_vector_type(8)));
typedef float f32x4 __attribute__((ext_vector_type(4)));
typedef unsigned u32x4 __attribute__((ext_vector_type(4)));
constexpr int BM = 256, BK = 64, HALF = 128, HTB = HALF * BK * 2  , STAGE_BYTES = 8 * HTB, NXCD = 8, WGM = 8;

__host__ __device__ __forceinline__ int lds_byte(int r, int c) { const int st = (r >> 4) * 2 + (c >> 5), rr = r & 15, cc = c & 31, ob = rr * 64 + cc * 2; return st * 1024 + (ob ^ (((ob >> 9) & 1) << 5)); }
__host__ __device__ __forceinline__ void stage_rc(int b, int& R, int& C) { const int st = b / 1024, sb = b % 1024, swz = sb ^ (((sb >> 9) & 1) << 5); R = (st >> 1) * 16 + swz / 64; C = (st & 1) * 32 + (swz % 64) / 2; }
__host__ __device__ __forceinline__ int perm32(int rho) { const int n = rho >> 4, i = rho & 15; return 8 * (i >> 2) + 4 * n + (i & 3); }

struct Unit { int pm, pn; };
struct Gemm { const bf16_t* A; const bf16_t* Bt; int M, N, K; };

struct StaticOrder {
    int nM, nN, nwg, G, c;
    __host__ __device__ void init(int M, int N, int G_, int c_) { nM = M / BM; nN = N / BM; nwg = nM * nN; G = G_; c = c_; }
    __host__ __device__ bool next(int i, Unit& u) const {
        const long L = (long)i * G + c; if (L >= nwg) return false;
        int wgid = (int)L; { const int q = nwg / NXCD, r = nwg % NXCD, xcd = wgid % NXCD, off = wgid / NXCD; wgid = (xcd < r ? xcd * (q + 1) : r * (q + 1) + (xcd - r) * q) + off; }
        const int nig = WGM * nN, gid = wgid / nig, fm = gid * WGM, gsz = (nM - fm) < WGM ? (nM - fm) : WGM;
        u.pm = fm + ((wgid % nig) % gsz); u.pn = (wgid % nig) / gsz; return true;
    }
    __device__ __forceinline__ void a_ready(const Unit&) const {}
    __device__ __forceinline__ void done(const Unit&) const {}
};
__device__ __forceinline__ unsigned cvt_pk_bf16(float lo, float hi) { unsigned r; asm volatile("v_cvt_pk_bf16_f32 %0, %1, %2" : "=v"(r) : "v"(lo), "v"(hi)); return r; }
template <class Epi, class Sched, bool ALIGN_EPI = false, bool SP2 = false>
__device__ __forceinline__ void gemm_phase(PG8_LAS unsigned char* lds, const Gemm g, const Sched& S, const Epi& E) {
    int tid_ = threadIdx.x; asm volatile("" : "+v"(tid_));
    const int tid = tid_, wid = __builtin_amdgcn_readfirstlane(tid >> 6), lane = tid & 63, wr = wid >> 2, wc = wid & 3, fr = lane & 15, fq = lane >> 4;
    const int K = g.K, nt = K / BK;
    unsigned voffA[2], voffB[2];
#pragma unroll
    for (int i = 0; i < 2; ++i) { int R, C; stage_rc(tid * 16 + i * 8192, R, C); const int Rb = Epi::PERM ? ((R & ~31) + perm32(R & 31)) : R;
        voffA[i] = (unsigned)(R * K + C) * 2u; voffB[i] = (unsigned)(Rb * K + C) * 2u; }
    const size_t kstep = (size_t)(BK * 2);
    const size_t hstep = (size_t)HALF * K * 2;
    const size_t tstep = 2 * hstep;
    const unsigned ldsw = (unsigned)wid * 1024u;
    const int aoff = lds_byte(wr * 64 + fr, fq * 8), boff = lds_byte(wc * 32 + fr, fq * 8);
#define PG8_SA(b, h) (((b) * 2 + (h)) * HTB)
#define PG8_SB(b, h) ((4 + (b) * 2 + (h)) * HTB)
#define PG8_STAGE(bufoff, gbase, voff) do { _Pragma("unroll") for (int _i = 0; _i < 2; ++_i) \
        __builtin_amdgcn_global_load_lds((const unsigned*)((const char*)(gbase) + (voff)[_i]), (PG8_LAS unsigned*)(lds + (bufoff) + ldsw + _i * 8192), 16, 0, 0); } while (0)
#define PG8_LDA(dst, b, h) do { _Pragma("unroll") for (int m = 0; m < 4; ++m) _Pragma("unroll") for (int k = 0; k < 2; ++k) dst[m][k] = *(const PG8_LAS bf16x8*)(lds + PG8_SA(b, h) + aoff + m * 2048 + k * 1024); } while (0)
#define PG8_LDB(dst, b, h) do { _Pragma("unroll") for (int n = 0; n < 2; ++n) _Pragma("unroll") for (int k = 0; k < 2; ++k) dst[n][k] = *(const PG8_LAS bf16x8*)(lds + PG8_SB(b, h) + boff + n * 2048 + k * 1024); } while (0)
#define PG8_MMA(ai, bj, At, Bt) do { __builtin_amdgcn_s_setprio(1); _Pragma("unroll") for (int m = 0; m < 4; ++m) _Pragma("unroll") for (int n = 0; n < 2; ++n) _Pragma("unroll") for (int k = 0; k < 2; ++k) \
        acc[ai][bj][m][n] = __builtin_amdgcn_mfma_f32_16x16x32_bf16(Bt[n][k], At[m][k], acc[ai][bj][m][n], 0, 0, 0); __builtin_amdgcn_s_setprio(0); } while (0)
#define PG8_WAIT_V(n) asm volatile("s_waitcnt vmcnt(" #n ")" ::: "memory")
#define PG8_WAIT_L(n) asm volatile("s_waitcnt lgkmcnt(" #n ")" ::: "memory")
#define PG8_BAR __builtin_amdgcn_s_barrier()
#define PG8_SCHED __builtin_amdgcn_sched_barrier(0)
    Unit cur, nxt; int ui = 0;
    if (!S.next(0, cur)) return;
    f32x4 acc[2][2][4][2];
#pragma unroll
    for (int a = 0; a < 2; ++a)
#pragma unroll
        for (int b = 0; b < 2; ++b)
#pragma unroll
            for (int m = 0; m < 4; ++m)
#pragma unroll
                for (int n = 0; n < 2; ++n) acc[a][b][m][n] = (f32x4){0.f, 0.f, 0.f, 0.f};
    bf16x8 At[4][2], B0[2][2], B1[2][2];
    const char* cA = (const char*)g.A + (size_t)cur.pm * tstep; const char* cB = (const char*)g.Bt + (size_t)cur.pn * tstep;
    S.a_ready(cur);
    if constexpr (SP2) {
        PG8_STAGE(PG8_SB(0, 0), cB, voffB); PG8_STAGE(PG8_SB(0, 1), cB + hstep, voffB); PG8_STAGE(PG8_SA(0, 0), cA, voffA); PG8_STAGE(PG8_SA(0, 1), cA + hstep, voffA);
        if (wr == 1) PG8_BAR;
        PG8_WAIT_V(2); PG8_BAR;
        PG8_STAGE(PG8_SB(1, 0), cB + kstep, voffB); PG8_STAGE(PG8_SA(1, 0), cA + kstep, voffA); PG8_STAGE(PG8_SB(1, 1), cB + hstep + kstep, voffB);
        PG8_WAIT_V(6); PG8_BAR;
    } else {
        PG8_STAGE(PG8_SB(0, 0), cB, voffB); PG8_STAGE(PG8_SA(0, 0), cA, voffA); PG8_STAGE(PG8_SB(0, 1), cB + hstep, voffB); PG8_STAGE(PG8_SA(0, 1), cA + hstep, voffA);
        if (wr == 1) PG8_BAR;
        PG8_WAIT_V(4); PG8_BAR;
        PG8_STAGE(PG8_SB(1, 0), cB + kstep, voffB); PG8_STAGE(PG8_SA(1, 0), cA + kstep, voffA); PG8_STAGE(PG8_SB(1, 1), cB + hstep + kstep, voffB);
        PG8_WAIT_V(6); PG8_BAR;
    }
    for (;;) {
        const bool has_next = S.next(ui + 1, nxt);
        const char* nA = has_next ? (const char*)g.A + (size_t)nxt.pm * tstep : cA; const char* nB = has_next ? (const char*)g.Bt + (size_t)nxt.pn * tstep : cB;
        for (int t = 0; t < nt; t += 2) {
            const bool last = (t == nt - 2);
            const char* a1 = cA + (size_t)(t + 1) * kstep;
            const char* a2 = last ? nA : cA + (size_t)(t + 2) * kstep; const char* b2 = last ? nB : cB + (size_t)(t + 2) * kstep;
            const char* a3 = a2 + kstep; const char* b3 = b2 + kstep;
            if (last && has_next) S.a_ready(nxt);
            if constexpr (SP2) {
            PG8_LDB(B0, 0, 0); PG8_LDB(B1, 0, 1); PG8_SCHED; PG8_LDA(At, 0, 0); PG8_STAGE(PG8_SA(1, 1), a1 + hstep, voffA);
            PG8_WAIT_V(8); PG8_WAIT_L(0); PG8_BAR; PG8_MMA(0, 0, At, B0); PG8_MMA(0, 1, At, B1); PG8_BAR; PG8_SCHED;
            PG8_LDA(At, 0, 1); PG8_STAGE(PG8_SB(0, 0), b2, voffB); PG8_STAGE(PG8_SB(0, 1), b2 + hstep, voffB); PG8_STAGE(PG8_SA(0, 0), a2, voffA);
            PG8_WAIT_V(8); PG8_WAIT_L(0); PG8_BAR; PG8_MMA(1, 0, At, B0); PG8_MMA(1, 1, At, B1); PG8_BAR; PG8_SCHED;
            PG8_LDB(B0, 1, 0); PG8_LDB(B1, 1, 1); PG8_SCHED; PG8_LDA(At, 1, 0); PG8_STAGE(PG8_SA(0, 1), a2 + hstep, voffA);
            PG8_WAIT_V(8); PG8_WAIT_L(0); PG8_BAR; PG8_MMA(0, 0, At, B0); PG8_MMA(0, 1, At, B1); PG8_BAR; PG8_SCHED;
            PG8_LDA(At, 1, 1); PG8_STAGE(PG8_SB(1, 0), b3, voffB); PG8_STAGE(PG8_SB(1, 1), b3 + hstep, voffB); PG8_STAGE(PG8_SA(1, 0), a3, voffA);
            PG8_WAIT_V(8); PG8_WAIT_L(0); PG8_BAR; PG8_MMA(1, 0, At, B0); PG8_MMA(1, 1, At, B1); PG8_BAR; PG8_SCHED;
            } else {
            PG8_LDB(B0, 0, 0); PG8_SCHED; PG8_LDA(At, 0, 0); PG8_STAGE(PG8_SA(1, 1), a1 + hstep, voffA);
            PG8_WAIT_L(8); PG8_BAR; PG8_WAIT_L(0); PG8_MMA(0, 0, At, B0); PG8_BAR; PG8_SCHED;
            PG8_LDB(B1, 0, 1); PG8_STAGE(PG8_SB(0, 0), b2, voffB);
            PG8_BAR; PG8_WAIT_L(0); PG8_MMA(0, 1, At, B1); PG8_BAR;
            PG8_LDA(At, 0, 1); PG8_STAGE(PG8_SA(0, 0), a2, voffA);
            PG8_BAR; PG8_WAIT_L(0); PG8_MMA(1, 0, At, B0); PG8_BAR; PG8_SCHED;
            PG8_STAGE(PG8_SB(0, 1), b2 + hstep, voffB);
            PG8_WAIT_V(6); PG8_BAR; PG8_MMA(1, 1, At, B1); PG8_BAR;
            PG8_LDB(B0, 1, 0); PG8_SCHED; PG8_LDA(At, 1, 0); PG8_STAGE(PG8_SA(0, 1), a2 + hstep, voffA);
            PG8_WAIT_L(8); PG8_BAR; PG8_WAIT_L(0); PG8_MMA(0, 0, At, B0); PG8_BAR; PG8_SCHED;
            PG8_LDB(B1, 1, 1); PG8_STAGE(PG8_SB(1, 0), b3, voffB);
            PG8_BAR; PG8_WAIT_L(0); PG8_MMA(0, 1, At, B1); PG8_BAR;
            PG8_LDA(At, 1, 1); PG8_STAGE(PG8_SA(1, 0), a3, voffA);
            PG8_BAR; PG8_WAIT_L(0); PG8_MMA(1, 0, At, B0); PG8_BAR; PG8_SCHED;
            PG8_STAGE(PG8_SB(1, 1), b3 + hstep, voffB);
            PG8_WAIT_V(6); PG8_BAR; PG8_MMA(1, 1, At, B1); PG8_BAR;
            }
        }
        if constexpr (ALIGN_EPI) { if (wr == 0) PG8_BAR; }
        if constexpr (!Epi::AFTER_DRAIN) { E(acc, cur, wr, wc, fr, fq); S.done(cur); }
        if (!has_next) break;
#pragma unroll
        for (int a = 0; a < 2; ++a)
#pragma unroll
            for (int b = 0; b < 2; ++b)
#pragma unroll
                for (int m = 0; m < 4; ++m)
#pragma unroll
                    for (int n = 0; n < 2; ++n) acc[a][b][m][n] = (f32x4){0.f, 0.f, 0.f, 0.f};
        cur = nxt; cA = nA; cB = nB; ++ui;
        if constexpr (ALIGN_EPI) { if (wr == 1) PG8_BAR; }
    }
    PG8_WAIT_V(0);
    if constexpr (!ALIGN_EPI) { if (wr == 0) PG8_BAR; }
    PG8_BAR;
    if constexpr (Epi::AFTER_DRAIN) { E.fused(acc, cur, wr, wc, fr, fq, lds, wid, lane); S.done(cur); }
#undef PG8_SA
#undef PG8_SB
#undef PG8_STAGE
#undef PG8_LDA
#undef PG8_LDB
#undef PG8_MMA
#undef PG8_WAIT_V
#undef PG8_WAIT_L
#undef PG8_BAR
#undef PG8_SCHED
}
}

#define DI __device__ __forceinline__
#define LAS __attribute__((address_space(3)))
typedef unsigned short bf16_t;
typedef short bf16x8 __attribute__((ext_vector_type(8)));
typedef float f32x4 __attribute__((ext_vector_type(4)));
typedef float f32x16 __attribute__((ext_vector_type(16)));
typedef unsigned u32x4 __attribute__((ext_vector_type(4)));
typedef unsigned u32x2 __attribute__((ext_vector_type(2)));
typedef float f32x2_t __attribute__((ext_vector_type(2)));
typedef __bf16 bf16x2_t __attribute__((ext_vector_type(2)));

#ifndef REP_P
#define REP_P 1
#endif
#ifndef REP_G1
#define REP_G1 1
#endif
#ifndef REP_PREP
#define REP_PREP 1
#endif
#ifndef REP_ATTN
#define REP_ATTN 1
#endif
#ifndef REP_G3
#define REP_G3 1
#endif
#ifndef SYNCX
#define SYNCX 0
#endif
#ifndef MK_SINGLE
#define MK_SINGLE 1
#endif

constexpr int D = 1024, MP = 8192, MS = 16384, M = MP + MS, DEPTH = 4, NMOD = 9, INW = 2304, FF = 4096;
constexpr int NPH = 2 + 6 * DEPTH;
constexpr float QSCALE = 0.125f * 1.4426950408889634f, LOG2E = 1.4426950408889634f, EPS = 1e-6f;
constexpr size_t OFF_AK = 25165824, OFF_AV = 29360128, OFF_NK = 33554432, OFF_NV = 46137344;
constexpr size_t MiB = 1u << 20;
constexpr size_t WS_MOD = 1 * MiB, WS_BIAS1 = 2 * MiB, WS_BIAS2 = 3 * MiB, WS_SSQ = 4 * MiB;
constexpr size_t WS_KCA = 6 * MiB, WS_VCA = 8 * MiB, WS_KCN = 10 * MiB, WS_VCN = 16 * MiB;
constexpr size_t WS_WIN = 22 * MiB, WS_WOUT = 40 * MiB, WS_W1 = 48 * MiB, WS_W2 = 80 * MiB;
constexpr size_t WS_XG = 112 * MiB, WS_H1 = 160 * MiB, WS_RAW = 160 * MiB, WS_Q = 268 * MiB, WS_K = 304 * MiB, WS_VT = 328 * MiB, WS_ATT = 352 * MiB, WS_END = 400 * MiB;
constexpr int LDS_BYTES = 147456;

DI unsigned pk2(float lo, float hi) { f32x2_t v = {lo, hi}; bf16x2_t b = __builtin_convertvector(v, bf16x2_t); return __builtin_bit_cast(unsigned, b); }
DI float bflo(unsigned w) { return __uint_as_float(w << 16); }
DI float bfhi(unsigned w) { return __uint_as_float(w & 0xffff0000u); }
DI void unpack8(const u32x4 w, float (&v)[8]) { v[0] = bflo(w.x); v[1] = bfhi(w.x); v[2] = bflo(w.y); v[3] = bfhi(w.y); v[4] = bflo(w.z); v[5] = bfhi(w.z); v[6] = bflo(w.w); v[7] = bfhi(w.w); }
DI int modidx(int row) { return row < MP ? 0 : 1 + ((row - MP) >> 11); }
DI float wave_sum(float v) {
#pragma unroll
    for (int o = 1; o < 64; o <<= 1) v += __shfl_xor(v, o);
    return v;
}
DI float sigmoidf_(float x) { return 1.f / (1.f + __expf(-x)); }
DI int crow(int i, int hi) { return (i & 3) + 8 * (i >> 2) + 4 * hi; }
DI int permkey(int p) { const int s = p >> 4, hh = (p >> 3) & 1, jj = p & 7; return 16 * s + 8 * (jj >> 2) + 4 * hh + (jj & 3); }

template <int ACT> struct EpiLin {
    static constexpr bool PERM = true, AFTER_DRAIN = false;
    bf16_t* O; int ldc; const float* bias; int ldb; const float* ssq;
    DI void operator()(const f32x4 (&acc)[2][2][4][2], const pg8::Unit& u, int wr, int wc, int fr, int fq) const {
        const int row0 = u.pm * 256 + wr * 64 + fr, col0 = u.pn * 256 + wc * 32 + 8 * fq;
        const float* bp = bias + (size_t)modidx(u.pm * 256) * ldb + col0;
        f32x4 bv[2][2];
#pragma unroll
        for (int bj = 0; bj < 2; ++bj)
#pragma unroll
            for (int n = 0; n < 2; ++n) bv[bj][n] = *(const f32x4*)(bp + bj * 128 + 4 * n);
#pragma unroll
        for (int ai = 0; ai < 2; ++ai)
#pragma unroll
            for (int m = 0; m < 4; ++m) {
                const int row = row0 + ai * 128 + m * 16;
                const f32x4 s4 = *(const f32x4*)(ssq + (size_t)row * 16 + 4 * fq);
                float s = (s4.x + s4.y) + (s4.z + s4.w); s += __shfl_xor(s, 16); s += __shfl_xor(s, 32);
                const float rstd = rsqrtf(s * (1.f / 1024.f) + EPS);
                bf16_t* rowp = O + (size_t)row * ldc + col0;
#pragma unroll
                for (int bj = 0; bj < 2; ++bj) {
                    f32x4 v0 = acc[ai][bj][m][0] * rstd + bv[bj][0], v1 = acc[ai][bj][m][1] * rstd + bv[bj][1];
                    if (ACT == 1) {
#pragma unroll
                        for (int e = 0; e < 4; ++e) { const float a = fmaxf(v0[e], 0.f), b = fmaxf(v1[e], 0.f); v0[e] = a * a; v1[e] = b * b; }
                    }
                    u32x4 w; w.x = pk2(v0[0], v0[1]); w.y = pk2(v0[2], v0[3]); w.z = pk2(v1[0], v1[1]); w.w = pk2(v1[2], v1[3]);
                    *(u32x4*)(rowp + bj * 128) = w;
                }
            }
    }
};
struct EpiRes {
    static constexpr bool PERM = false, AFTER_DRAIN = false;
    const float* baseP; const float* baseS; float* out; const float* gate; const float* nw; const float* sc; bf16_t* xg; float* ssq; int has_next;
    DI void operator()(const f32x4 (&acc)[2][2][4][2], const pg8::Unit& u, int wr, int wc, int fr, int fq) const {
        const int col0 = u.pn * 256 + wc * 32 + 4 * fq, j = modidx(u.pm * 256);
        const float* gp = gate + (size_t)j * 6144 + col0;
        f32x4 gv[2][2], gn[2][2];
#pragma unroll
        for (int bj = 0; bj < 2; ++bj)
#pragma unroll
            for (int n = 0; n < 2; ++n) {
                gv[bj][n] = *(const f32x4*)(gp + bj * 128 + n * 16);
                if (has_next) gn[bj][n] = *(const f32x4*)(nw + col0 + bj * 128 + n * 16) * (*(const f32x4*)(sc + (size_t)j * 6144 + col0 + bj * 128 + n * 16) + 1.0f);
                else gn[bj][n] = (f32x4){0.f, 0.f, 0.f, 0.f};
            }
#pragma unroll
        for (int ai = 0; ai < 2; ++ai)
#pragma unroll
            for (int m = 0; m < 4; ++m) {
                const int row = u.pm * 256 + ai * 128 + wr * 64 + m * 16 + fr;
                const float* b = (row < MP) ? baseP + (size_t)row * D : baseS + (size_t)(row - MP) * D;
                float q = 0.f;
#pragma unroll
                for (int bj = 0; bj < 2; ++bj)
#pragma unroll
                    for (int n = 0; n < 2; ++n) {
                        const int c = col0 + bj * 128 + n * 16;
                        const f32x4 x = *(const f32x4*)(b + c) + gv[bj][n] * acc[ai][bj][m][n];
                        *(f32x4*)(out + (size_t)row * D + c) = x;
                        q += (x.x * x.x + x.y * x.y) + (x.z * x.z + x.w * x.w);
                        if (has_next) { const f32x4 y = x * gn[bj][n]; u32x2 w; w.x = pk2(y.x, y.y); w.y = pk2(y.z, y.w); *(u32x2*)(xg + (size_t)row * D + c) = w; }
                    }
                q += __shfl_xor(q, 16); q += __shfl_xor(q, 32);
                if (fq == 0 && has_next) ssq[(size_t)row * 16 + u.pn * 4 + wc] = q;
            }
    }
};

DI void transpose_item(const float* W, int K, int N, bf16_t* WT, LAS float* scr, int item, int lane) {
    const int nblk = N / 32, kb = item / nblk, nb = item % nblk, k0 = 64 * kb, n0 = 32 * nb;
#pragma unroll 8
    for (int i = 0; i < 32; ++i) { const int kk = 2 * i + (lane >> 5); scr[kk * 33 + (lane & 31)] = W[(size_t)(k0 + kk) * N + n0 + (lane & 31)]; }
    asm volatile("s_waitcnt lgkmcnt(0)" ::: "memory");
    const int c = lane & 7;
#pragma unroll
    for (int j = 0; j < 4; ++j) { const int n = (lane >> 3) + 8 * j; const LAS float* s = scr + (8 * c) * 33 + n;
        u32x4 o; o.x = pk2(s[0 * 33], s[1 * 33]); o.y = pk2(s[2 * 33], s[3 * 33]); o.z = pk2(s[4 * 33], s[5 * 33]); o.w = pk2(s[6 * 33], s[7 * 33]);
        *(u32x4*)(WT + (size_t)(n0 + n) * K + k0 + 8 * c) = o; }
    asm volatile("s_waitcnt lgkmcnt(0)" ::: "memory");
}
DI void gemv9_unit(const float* W, int N, int n0, const float* v0, const float* v1, int vs, bool do_silu, const float* badd, float* out, int ostride, float* scr, int tid) {
    const int wave = __builtin_amdgcn_readfirstlane(tid >> 6), lane = tid & 63;
    float acc[NMOD];
#pragma unroll
    for (int j = 0; j < NMOD; ++j) acc[j] = 0.f;
    const float* wp = W + (size_t)(wave * 128) * N + n0 + lane;
#pragma unroll 4
    for (int k = 0; k < 128; ++k) {
        const float w = wp[(size_t)k * N];
        const int kk = wave * 128 + k;
#pragma unroll
        for (int j = 0; j < NMOD; ++j) {
            float v = (j == 0) ? v0[kk] : v1[(size_t)(j - 1) * vs + kk];
            if (do_silu) v = v * sigmoidf_(v);
            acc[j] += v * w;
        }
    }
#pragma unroll
    for (int j = 0; j < NMOD; ++j) scr[(wave * NMOD + j) * 64 + lane] = acc[j];
    __syncthreads();
    for (int idx = tid; idx < NMOD * 64; idx += 512) {
        const int j = idx >> 6, ln = idx & 63; float s = 0.f;
#pragma unroll
        for (int w = 0; w < 8; ++w) s += scr[(w * NMOD + j) * 64 + ln];
        if (badd) s += badd[n0 + ln];
        out[(size_t)j * ostride + n0 + ln] = s;
    }
    __syncthreads();
}

DI void conv_unit(int ct, int l, const bf16_t* RAW, bf16_t* ATT, const float* dw_w, const float* dw_b, const float* ln_g, const float* ln_b, float* lds, int tid) {
    const int row0 = ct * 64;
    int seq0, L;
    if (row0 < MP) { seq0 = row0 & ~255; L = 256; } else { seq0 = MP + ((row0 - MP) & ~2047); L = 2048; }
    const int t0 = row0 - seq0;
    for (int it = tid; it < 94 * 32; it += 512) {
        const int rr = it >> 5, c8 = it & 31, t = t0 - 15 + rr;
        float hv[8];
        if (t >= 0 && t < L) {
            const bf16_t* p = RAW + (size_t)(seq0 + t) * INW + c8 * 8;
            const u32x4 wa = *(const u32x4*)p, wg = *(const u32x4*)(p + 256);
            float a[8], g[8]; unpack8(wa, a); unpack8(wg, g);
#pragma unroll
            for (int e = 0; e < 8; ++e) hv[e] = a[e] * sigmoidf_(g[e]);
        } else {
#pragma unroll
            for (int e = 0; e < 8; ++e) hv[e] = 0.f;
        }
        float* d = lds + rr * 256 + c8 * 8;
        *(f32x4*)d = (f32x4){hv[0], hv[1], hv[2], hv[3]}; *(f32x4*)(d + 4) = (f32x4){hv[4], hv[5], hv[6], hv[7]};
    }
    __syncthreads();
    const int c = tid & 255, th = tid >> 8;
    float w[31];
#pragma unroll
    for (int k = 0; k < 31; ++k) w[k] = dw_w[(size_t)(l * 31 + k) * 256 + c];
    const float bias = dw_b[l * 256 + c];
    float outv[32];
#pragma unroll
    for (int ch = 0; ch < 2; ++ch) {
        float hv[46];
#pragma unroll
        for (int i = 0; i < 46; ++i) hv[i] = lds[(th * 32 + ch * 16 + i) * 256 + c];
#pragma unroll
        for (int o = 0; o < 16; ++o) {
            float s = bias;
#pragma unroll
            for (int k = 0; k < 31; ++k) s += hv[o + k] * w[k];
            outv[ch * 16 + o] = s;
        }
    }
    __syncthreads();
#pragma unroll
    for (int o = 0; o < 32; ++o) lds[(th * 32 + o) * 256 + c] = outv[o];
    __syncthreads();
    const int wave = tid >> 6, lane = tid & 63;
    const f32x4 g4 = *(const f32x4*)(ln_g + l * 256 + 4 * lane), b4 = *(const f32x4*)(ln_b + l * 256 + 4 * lane);
#pragma unroll
    for (int i = 0; i < 8; ++i) {
        const int tk = wave * 8 + i;
        const f32x4 v = *(const f32x4*)(lds + tk * 256 + 4 * lane);
        const float mean = wave_sum((v.x + v.y) + (v.z + v.w)) * (1.f / 256.f);
        const f32x4 dv = v - mean;
        const float var = wave_sum((dv.x * dv.x + dv.y * dv.y) + (dv.z * dv.z + dv.w * dv.w)) * (1.f / 256.f);
        const float rstd = rsqrtf(var + EPS);
        f32x4 y = dv * rstd * g4 + b4;
        y.x *= sigmoidf_(y.x); y.y *= sigmoidf_(y.y); y.z *= sigmoidf_(y.z); y.w *= sigmoidf_(y.w);
        u32x2 o; o.x = pk2(y.x, y.y); o.y = pk2(y.z, y.w);
        *(u32x2*)(ATT + (size_t)(row0 + tk) * D + 4 * lane) = o;
    }
    __syncthreads();
}

struct PrepP { const bf16_t* RAW; bf16_t* Q; bf16_t* K; bf16_t* VT; float* out; const float *aqg, *akg, *nqg, *nkg; };
DI void qkv_unit(int ct, int l, const PrepP& P, bf16_t* ldsv, int tid) {
    const int row0 = ct * 64;
    const bool prompt = row0 < MP;
    int seq0, L, sb;
    if (prompt) { seq0 = row0 & ~255; L = 256; sb = row0 >> 8; } else { seq0 = MP + ((row0 - MP) & ~2047); L = 2048; sb = (row0 - MP) >> 11; }
    const int t0 = row0 - seq0;
    for (int it = tid; it < 64 * 20 * 8; it += 512) {
        const int c8 = it & 7, hr = it >> 3, tok = hr / 20, hd = hr - tok * 20;
        const int row = row0 + tok, t = t0 + tok;
        int rcol; const float* gw; bool isq;
        if (hd < 6) { rcol = 512 + 64 * hd; gw = P.aqg; isq = true; }
        else if (hd < 8) { rcol = 896 + 64 * (hd - 6); gw = P.akg; isq = false; }
        else if (hd < 14) { rcol = 1152 + 64 * (hd - 8); gw = P.nqg; isq = true; }
        else { rcol = 1536 + 64 * (hd - 14); gw = P.nkg; isq = false; }
        const u32x4 wv = *(const u32x4*)(P.RAW + (size_t)row * INW + rcol + 8 * c8);
        float v[8]; unpack8(wv, v);
        float ss = 0.f;
#pragma unroll
        for (int e = 0; e < 8; ++e) ss += v[e] * v[e];
        ss += __shfl_xor(ss, 1); ss += __shfl_xor(ss, 2); ss += __shfl_xor(ss, 4);
        const float rstd = rsqrtf(ss * (1.f / 64.f) + EPS);
        const f32x4 g0 = *(const f32x4*)(gw + l * 64 + 8 * c8), g1 = *(const f32x4*)(gw + l * 64 + 8 * c8 + 4);
        v[0] *= rstd * g0.x; v[1] *= rstd * g0.y; v[2] *= rstd * g0.z; v[3] *= rstd * g0.w;
        v[4] *= rstd * g1.x; v[5] *= rstd * g1.y; v[6] *= rstd * g1.z; v[7] *= rstd * g1.w;
        const bool rope = (!prompt) && (hd < 8);
        const float pos = (float)((c8 >> 2) ? (t & 63) : (t >> 6));
        const bool first = (c8 & 2) == 0;
#pragma unroll
        for (int e = 0; e < 8; ++e) {
            const float pv = __shfl_xor(v[e], 2);
            const int jj = 8 * (c8 & 1) + e;
            const float inv = exp2f(-(float)jj * 0.8304820237218406f);
            const float ang = pos * inv;
            float sn, cs; __sincosf(ang, &sn, &cs);
            const float r = first ? (v[e] * cs - pv * sn) : (v[e] * cs + pv * sn);
            v[e] = rope ? r : v[e];
        }
        if (isq) {
            const int qcol = (hd < 6) ? 64 * hd : 384 + 64 * (hd - 8);
            u32x4 o; o.x = pk2(v[0] * QSCALE, v[1] * QSCALE); o.y = pk2(v[2] * QSCALE, v[3] * QSCALE); o.z = pk2(v[4] * QSCALE, v[5] * QSCALE); o.w = pk2(v[6] * QSCALE, v[7] * QSCALE);
            *(u32x4*)(P.Q + (size_t)row * 768 + qcol + 8 * c8) = o;
        } else {
            const int kcol = (hd < 8) ? 64 * (hd - 6) : 128 + 64 * (hd - 14);
            u32x4 o; o.x = pk2(v[0], v[1]); o.y = pk2(v[2], v[3]); o.z = pk2(v[4], v[5]); o.w = pk2(v[6], v[7]);
            *(u32x4*)(P.K + (size_t)row * 512 + kcol + 8 * c8) = o;
            if (prompt) {
                float* op;
                if (hd < 8) op = P.out + OFF_AK + ((((size_t)sb * 4 + l) * 256 + t) * 2 + (hd - 6)) * 64 + 8 * c8;
                else        op = P.out + OFF_NK + ((((size_t)sb * 4 + l) * 256 + t) * 6 + (hd - 14)) * 64 + 8 * c8;
                *(f32x4*)op = (f32x4){v[0], v[1], v[2], v[3]}; *(f32x4*)(op + 4) = (f32x4){v[4], v[5], v[6], v[7]};
            }
        }
    }
    for (int it = tid; it < 64 * 64; it += 512) {
        const int tok = it >> 6, ch = it & 63;
        const int cc = ch * 8, rcol = (cc < 128) ? 1024 + cc : 1920 + (cc - 128);
        const u32x4 wv = *(const u32x4*)(P.RAW + (size_t)(row0 + tok) * INW + rcol);
        *(u32x4*)(ldsv + tok * 512 + cc) = wv;
        if (prompt) {
            float v[8]; unpack8(wv, v);
            const int t = t0 + tok; float* op;
            if (cc < 128) op = P.out + OFF_AV + (((size_t)sb * 4 + l) * 256 + t) * 128 + cc;
            else          op = P.out + OFF_NV + (((size_t)sb * 4 + l) * 256 + t) * 384 + (cc - 128);
            *(f32x4*)op = (f32x4){v[0], v[1], v[2], v[3]}; *(f32x4*)(op + 4) = (f32x4){v[4], v[5], v[6], v[7]};
        }
    }
    __syncthreads();
    for (int it = tid; it < 512 * 8; it += 512) {
        const int hd_d = it & 511, g = it >> 9;
        unsigned short e[8];
#pragma unroll
        for (int jj = 0; jj < 8; ++jj) { const int p = 8 * g + jj; const int key = (p & ~31) + permkey(p & 31); e[jj] = ldsv[key * 512 + hd_d]; }
        u32x4 o; o.x = e[0] | ((unsigned)e[1] << 16); o.y = e[2] | ((unsigned)e[3] << 16); o.z = e[4] | ((unsigned)e[5] << 16); o.w = e[6] | ((unsigned)e[7] << 16);
        const size_t base = prompt ? ((size_t)sb * 512 + hd_d) * 256 : (size_t)MP * 512 + ((size_t)sb * 512 + hd_d) * 2048;
        *(u32x4*)(P.VT + base + t0 + 8 * g) = o;
    }
    __syncthreads();
}

struct Seg { const bf16_t* k; int kp; const bf16_t* v; int vp; int nt; };
#define MFMA32(a, b, c) __builtin_amdgcn_mfma_f32_32x32x16_bf16((a), (b), (c), 0, 0, 0)
DI void ld_k(const Seg& A, const Seg& B, int t, int r32, int hi, bf16x8 (&kf)[4]) {
    const bf16_t* kp; int kpi;
    if (t < A.nt) { kp = A.k + (size_t)(32 * t) * A.kp; kpi = A.kp; }
    else { const int tb = t - A.nt; kp = B.k + (size_t)(32 * tb) * B.kp; kpi = B.kp; }
#pragma unroll
    for (int kk = 0; kk < 4; ++kk) kf[kk] = *(const bf16x8*)(kp + (size_t)r32 * kpi + 16 * kk + 8 * hi);
}
DI void ld_v(const Seg& A, const Seg& B, int t, int r32, int hi, bf16x8 (&vf)[2][2]) {
    const bf16_t* vp; int vpi;
    if (t < A.nt) { vp = A.v + 32 * t; vpi = A.vp; }
    else { const int tb = t - A.nt; vp = B.v + 32 * tb; vpi = B.vp; }
#pragma unroll
    for (int db = 0; db < 2; ++db)
#pragma unroll
        for (int s = 0; s < 2; ++s) vf[db][s] = *(const bf16x8*)(vp + (size_t)(32 * db + r32) * vpi + 16 * s + 8 * hi);
}
template <bool NA> DI void attn_wave(const bf16_t* Qp, const Seg A, const Seg B, bf16_t* Op, const float* rpbh, int r, int rs, int lane_) {
    int lane = lane_; asm volatile("" : "+v"(lane));
    const int r32 = lane & 31, hi = lane >> 5;
    bf16x8 qf[2][4];
#pragma unroll
    for (int qb = 0; qb < 2; ++qb)
#pragma unroll
        for (int kk = 0; kk < 4; ++kk) qf[qb][kk] = *(const bf16x8*)(Qp + (size_t)(32 * qb + r32) * 768 + 16 * kk + 8 * hi);
    f32x16 o[2][2];
#pragma unroll
    for (int a = 0; a < 2; ++a)
#pragma unroll
        for (int b = 0; b < 2; ++b)
#pragma unroll
            for (int i = 0; i < 16; ++i) o[a][b][i] = 0.f;
    float mrun[2] = {-1e30f, -1e30f}, lrun[2] = {0.f, 0.f};
    const int nt = A.nt + B.nt;
    bf16x8 kf[4], vf[2][2], kn[4];
    ld_k(A, B, 0, r32, hi, kf);
    for (int t = 0; t < nt; ++t) {
        const int tn = (t + 1 < nt) ? t + 1 : t;
        ld_v(A, B, t, r32, hi, vf);
        ld_k(A, B, tn, r32, hi, kn);
#pragma unroll
        for (int qb = 0; qb < 2; ++qb) {
            f32x16 s;
#pragma unroll
            for (int i = 0; i < 16; ++i) s[i] = 0.f;
#pragma unroll
            for (int kk = 0; kk < 4; ++kk) s = MFMA32(kf[kk], qf[qb][kk], s);
            if (NA) {
                if (t < A.nt) {
                    const int a = t >> 1, half = t & 1;
                    const float* bp = rpbh + (rs + a - r + 7) * 31;
                    const int qc = 32 * qb + r32; const int cs = min(max(qc - 8, 0), 48);
#pragma unroll
                    for (int i = 0; i < 16; ++i) {
                        const int kc = 32 * half + crow(i, hi);
                        const bool valid = (kc >= cs) && (kc < cs + 16);
                        const int co = min(max(kc - qc + 15, 0), 30);
                        const float bia = bp[co] * LOG2E;
                        s[i] = valid ? s[i] + bia : -1e30f;
                    }
                }
            }
            float mx = s[0];
#pragma unroll
            for (int i = 1; i < 16; ++i) mx = fmaxf(mx, s[i]);
            mx = fmaxf(mx, __shfl_xor(mx, 32));
            const float mn = fmaxf(mrun[qb], mx);
            const float alpha = __builtin_amdgcn_exp2f(mrun[qb] - mn);
            mrun[qb] = mn;
            float ps = 0.f;
#pragma unroll
            for (int i = 0; i < 16; ++i) { const float p = __builtin_amdgcn_exp2f(s[i] - mn); s[i] = p; ps += p; }
            lrun[qb] = lrun[qb] * alpha + ps;
#pragma unroll
            for (int i = 0; i < 16; ++i) { o[qb][0][i] *= alpha; o[qb][1][i] *= alpha; }
            u32x4 p0, p1;
            p0.x = pk2(s[0], s[1]); p0.y = pk2(s[2], s[3]); p0.z = pk2(s[4], s[5]); p0.w = pk2(s[6], s[7]);
            p1.x = pk2(s[8], s[9]); p1.y = pk2(s[10], s[11]); p1.z = pk2(s[12], s[13]); p1.w = pk2(s[14], s[15]);
            const bf16x8 P0 = __builtin_bit_cast(bf16x8, p0), P1 = __builtin_bit_cast(bf16x8, p1);
#pragma unroll
            for (int db = 0; db < 2; ++db) { o[qb][db] = MFMA32(vf[db][0], P0, o[qb][db]); o[qb][db] = MFMA32(vf[db][1], P1, o[qb][db]); }
        }
#pragma unroll
        for (int kk = 0; kk < 4; ++kk) kf[kk] = kn[kk];
    }
#pragma unroll
    for (int qb = 0; qb < 2; ++qb) {
        const float lt = lrun[qb] + __shfl_xor(lrun[qb], 32);
        const float inv = 1.f / lt;
        bf16_t* orow = Op + (size_t)(32 * qb + r32) * D;
#pragma unroll
        for (int db = 0; db < 2; ++db)
#pragma unroll
            for (int g = 0; g < 4; ++g) {
                u32x2 w; w.x = pk2(o[qb][db][4 * g] * inv, o[qb][db][4 * g + 1] * inv); w.y = pk2(o[qb][db][4 * g + 2] * inv, o[qb][db][4 * g + 3] * inv);
                *(u32x2*)(orow + 32 * db + 8 * g + 4 * hi) = w;
            }
    }
}

struct AttnP { const bf16_t *Q, *K, *VT, *KCA, *VCA, *KCN, *VCN; bf16_t* ATT; const float* rpb; };
DI void attn_run_unit(int uid, int l, const AttnP& P, int lane) {
    const Seg none{nullptr, 0, nullptr, 0, 0};
    if (uid < 1536) {
        const int qc = uid & 31, bh = uid >> 5, b = bh / 6, h = bh - 6 * b, kvh = h / 3;
        const int row0 = MP + b * 2048;
        Seg A{P.K + (size_t)row0 * 512 + kvh * 64, 512, P.VT + (size_t)MP * 512 + ((size_t)b * 512 + kvh * 64) * 2048, 2048, 64};
        Seg B{P.KCA + ((size_t)((b * 4 + l) * 2 + kvh) * 256) * 64, 64, P.VCA + ((size_t)((b * 4 + l) * 2 + kvh) * 64) * 256, 256, 8};
        attn_wave<false>(P.Q + (size_t)(row0 + qc * 64) * 768 + h * 64, A, B, P.ATT + (size_t)(row0 + qc * 64) * D + 256 + h * 64, nullptr, 0, 0, lane);
    } else if (uid < 3072) {
        const int u = uid - 1536, r = u & 31, bh = u >> 5, b = bh / 6, h = bh - 6 * b;
        const int row0 = MP + b * 2048, rs = min(max(r - 4, 0), 24);
        Seg A{P.K + (size_t)(row0 + rs * 64) * 512 + 128 + h * 64, 512, P.VT + (size_t)MP * 512 + ((size_t)b * 512 + 128 + h * 64) * 2048 + rs * 64, 2048, 16};
        Seg B{P.KCN + ((size_t)((b * 4 + l) * 6 + h) * 256) * 64, 64, P.VCN + ((size_t)((b * 4 + l) * 6 + h) * 64) * 256, 256, 8};
        attn_wave<true>(P.Q + (size_t)(row0 + r * 64) * 768 + 384 + h * 64, A, B, P.ATT + (size_t)(row0 + r * 64) * D + 640 + h * 64, P.rpb + (size_t)(l * 6 + h) * 15 * 31, r, rs, lane);
    } else if (uid < 3840) {
        const int u = uid - 3072, qc = u & 3, bh = u >> 2, b = bh / 6, h = bh - 6 * b, kvh = h / 3;
        const int row0 = b * 256;
        Seg A{P.K + (size_t)row0 * 512 + kvh * 64, 512, P.VT + ((size_t)b * 512 + kvh * 64) * 256, 256, 8};
        attn_wave<false>(P.Q + (size_t)(row0 + qc * 64) * 768 + h * 64, A, none, P.ATT + (size_t)(row0 + qc * 64) * D + 256 + h * 64, nullptr, 0, 0, lane);
    } else {
        const int u = uid - 3840, qc = u & 3, bh = u >> 2, b = bh / 6, h = bh - 6 * b;
        const int row0 = b * 256;
        Seg A{P.K + (size_t)row0 * 512 + 128 + h * 64, 512, P.VT + ((size_t)b * 512 + 128 + h * 64) * 256, 256, 8};
        attn_wave<false>(P.Q + (size_t)(row0 + qc * 64) * 768 + 384 + h * 64, A, none, P.ATT + (size_t)(row0 + qc * 64) * D + 640 + h * 64, nullptr, 0, 0, lane);
    }
}

struct Args {
    const float* in[25]; float* out; unsigned char* ws; int ph_lo, ph_hi;
};
#define XB_TMO      128
#define XB_XCNT(j)  (256  + 64 * (j))
#define XB_XSUB(j)  (1280 + 64 * (j))
#define XB_XGEN(j)  (2304 + 64 * (j))
#define XB_TOP      3328
#define XB_TOPGEN   3392
#define XCD_BAR_WORDS 3456
#define XB_SPIN_CAP (1u << 18)

__device__ __forceinline__ unsigned xb_ld(unsigned* p)              { return __hip_atomic_load(p, __ATOMIC_RELAXED, __HIP_MEMORY_SCOPE_AGENT); }
__device__ __forceinline__ unsigned xb_add(unsigned* p, unsigned v) { return __hip_atomic_fetch_add(p, v, __ATOMIC_RELAXED, __HIP_MEMORY_SCOPE_AGENT); }
__device__ __forceinline__ unsigned xb_xcc_id() { return (unsigned)__builtin_amdgcn_s_getreg((3 << 11) | 20) & 0xFu; }
#define XB_SPIN(cond, bar) do { unsigned _sp = 0; while (cond) { __builtin_amdgcn_s_sleep(1); \
    if ((++_sp & 255u) == 0u) { if (xb_ld(&(bar)[XB_TMO])) break; if (_sp > XB_SPIN_CAP) { atomicAdd(&(bar)[XB_TMO], 1u); break; } } } } while (0)

struct XcdBarrier {
    unsigned* bar; unsigned x;
    volatile LAS unsigned* st;
};

__device__ __forceinline__ XcdBarrier xcd_barrier_post(unsigned* bar, volatile LAS unsigned* st) {
    XcdBarrier b; b.bar = bar; b.x = xb_xcc_id(); b.st = st;
    if (threadIdx.x == 0) (void)xb_add(&bar[XB_XCNT(b.x)], 1u);
    return b;
}
__device__ __forceinline__ void xcd_barrier_complete(unsigned* bar, unsigned x, unsigned& nloc, unsigned& nx) {
    const unsigned G = gridDim.x * gridDim.y * gridDim.z;
    unsigned sum, cnt, mine, sp = 0u;
    for (;;) {
        sum = 0u; cnt = 0u; mine = 0u;
#pragma unroll
        for (unsigned j = 0; j < 16; ++j) { const unsigned c = xb_ld(&bar[XB_XCNT(j)]); sum += c; cnt += (c > 0u) ? 1u : 0u; mine = (j == x) ? c : mine; }
        if (sum == G) break;
        __builtin_amdgcn_s_sleep(1);
        if ((++sp & 255u) == 0u) { if (xb_ld(&bar[XB_TMO])) break; if (sp > XB_SPIN_CAP) { atomicAdd(&bar[XB_TMO], 1u); break; } }
    }
    nloc = mine > 0u ? mine : 1u; nx = cnt > 0u ? cnt : 1u;
}

__device__ __forceinline__ void xcd_barrier(const XcdBarrier& b) {
    asm volatile("s_waitcnt vmcnt(0)" ::: "memory");
    __syncthreads();
    if (threadIdx.x == 0) {
        unsigned* bar = b.bar;
        __builtin_amdgcn_s_waitcnt(0);
        unsigned nloc = b.st[0], nx = b.st[1];
        if (nloc == 0u) { xcd_barrier_complete(bar, b.x, nloc, nx); b.st[0] = nloc; b.st[1] = nx; }
        const unsigned old = xb_add(&bar[XB_XSUB(b.x)], 1u);
        const unsigned gen = old / nloc;
        if (old + 1u == (gen + 1u) * nloc) {
            __builtin_amdgcn_fence(__ATOMIC_RELEASE, "agent");
            asm volatile("s_waitcnt vmcnt(0)" ::: "memory");
            const unsigned og = xb_add(&bar[XB_TOP], 1u);
            const unsigned tg = og / nx;
            if (og + 1u == (tg + 1u) * nx) xb_add(&bar[XB_TOPGEN], 1u);
            else XB_SPIN(xb_ld(&bar[XB_TOPGEN]) == tg, bar);
            __builtin_amdgcn_fence(__ATOMIC_ACQUIRE, "agent");
            xb_add(&bar[XB_XGEN(b.x)], 1u);
            asm volatile("s_waitcnt vmcnt(0)" ::: "memory");
        } else {
            XB_SPIN(xb_ld(&bar[XB_XGEN(b.x)]) == gen, bar);
            __builtin_amdgcn_fence(__ATOMIC_ACQUIRE, "agent");
            asm volatile("s_waitcnt vmcnt(0)" ::: "memory");
        }
    }
    __syncthreads();
}

typedef const __attribute__((address_space(4))) char* kargp_t;
DI const float* ldin(int i) { kargp_t kp = (kargp_t)__builtin_amdgcn_kernarg_segment_ptr(); asm volatile("" : "+s"(kp)); return (const float*)(*(const __attribute__((address_space(4))) unsigned long long*)(kp + 8 * i)); }
DI float* ldout() { return (float*)ldin(25); }
DI unsigned char* ldws() { return (unsigned char*)ldin(26); }
DI int opq_tid() { int t = threadIdx.x; asm volatile("" : "+v"(t)); return t; }

__global__ void __launch_bounds__(512, 2) fwd_kernel(Args a) {
    extern __shared__ __attribute__((aligned(16))) unsigned char lds[];
    cg::grid_group grid = cg::this_grid();
    const int G = gridDim.x, bx = blockIdx.x, NGW = G * 8;
    const int lo = a.ph_lo, hi = a.ph_hi;
#define IN(k) (lo <= (k) && (k) < hi)
    volatile LAS unsigned* MISC = (volatile LAS unsigned*)((LAS unsigned char*)lds + 131072);
    if (threadIdx.x < 16) MISC[threadIdx.x] = 0u;
    __syncthreads();
    XcdBarrier xbar; xbar.bar = (unsigned*)ldws(); xbar.x = 0; xbar.st = nullptr;
    if (hi - lo > 1) xbar = xcd_barrier_post((unsigned*)ldws(), MISC + 8);
    if (hi < 0) grid.sync();
#define SEAM(k) do { if (IN(k) && (k) + 1 < hi) xcd_barrier(xbar); } while (0)
#define WSP(T, off) ((T*)(ws + (off)))

    for (int sx_ = 0; sx_ < SYNCX; ++sx_) xcd_barrier(xbar);
    if (IN(0)) for (int rep_ = 0; rep_ < REP_P; ++rep_) {
        if (rep_) xcd_barrier(xbar);
        const int tid = opq_tid(), lane = tid & 63, wave = __builtin_amdgcn_readfirstlane(tid >> 6), gw = bx * 8 + wave;
        unsigned char* ws = ldws();
        {
            const float *cvec = ldin(6), *c_ctx = ldin(7), *ada_w = ldin(8), *ada_b = ldin(9);
            float* mod = WSP(float, WS_MOD);
            for (int u = bx; u < DEPTH * 96; u += G) {
                const int l = u / 96, nb = u - l * 96;
                gemv9_unit(ada_w + (size_t)l * D * 6144, 6144, nb * 64, c_ctx, cvec, D, true, ada_b + l * 6144, mod + (size_t)l * NMOD * 6144, 6144, (float*)lds, tid);
            }
        }
        {
            const float *w_in = ldin(12), *w_out = ldin(22), *w1 = ldin(23), *w2 = ldin(24);
            bf16_t *WIN = WSP(bf16_t, WS_WIN), *WOUT = WSP(bf16_t, WS_WOUT), *W1T = WSP(bf16_t, WS_W1), *W2T = WSP(bf16_t, WS_W2);
            LAS float* scr = (LAS float*)((LAS unsigned char*)lds + wave * 16384);
            constexpr int I_IN = 16 * 72, I_OUT = 16 * 32, I_1 = 16 * 128, I_2 = 64 * 32, I_L = I_IN + I_OUT + I_1 + I_2;
            for (int it = gw; it < DEPTH * I_L; it += NGW) {
                const int l = it / I_L; int r = it - l * I_L;
                if (r < I_IN) { transpose_item(w_in + (size_t)l * D * INW, D, INW, WIN + (size_t)l * INW * D, scr, r, lane); continue; } r -= I_IN;
                if (r < I_OUT) { transpose_item(w_out + (size_t)l * D * D, D, D, WOUT + (size_t)l * D * D, scr, r, lane); continue; } r -= I_OUT;
                if (r < I_1) { transpose_item(w1 + (size_t)l * D * FF, D, FF, W1T + (size_t)l * FF * D, scr, r, lane); continue; } r -= I_1;
                transpose_item(w2 + (size_t)l * FF * D, FF, D, W2T + (size_t)l * D * FF, scr, r, lane);
            }
        }
        {
            const float *cache_ak = ldin(2), *cache_av = ldin(3), *cache_nk = ldin(4), *cache_nv = ldin(5);
            bf16_t *KCA = WSP(bf16_t, WS_KCA), *VCA = WSP(bf16_t, WS_VCA), *KCN = WSP(bf16_t, WS_KCN), *VCN = WSP(bf16_t, WS_VCN);
            const int gt = bx * 512 + tid, NGT = G * 512;
            for (int e = gt; e < 8 * 4 * 256 * 8 * 8; e += NGT) {
                const int c8 = e & 7, hh = (e >> 3) & 7, key = (e >> 6) & 255, bl = e >> 14;
                const float* src; bf16_t* dst;
                if (hh < 2) { src = cache_ak + (((size_t)bl * 256 + key) * 2 + hh) * 64 + 8 * c8; dst = KCA + (((size_t)bl * 2 + hh) * 256 + key) * 64 + 8 * c8; }
                else { src = cache_nk + (((size_t)bl * 256 + key) * 6 + (hh - 2)) * 64 + 8 * c8; dst = KCN + (((size_t)bl * 6 + (hh - 2)) * 256 + key) * 64 + 8 * c8; }
                const f32x4 v0 = *(const f32x4*)src, v1 = *(const f32x4*)(src + 4);
                u32x4 o; o.x = pk2(v0.x, v0.y); o.y = pk2(v0.z, v0.w); o.z = pk2(v1.x, v1.y); o.w = pk2(v1.z, v1.w);
                *(u32x4*)dst = o;
            }
            for (int e = gt; e < 8 * 4 * 8 * 32 * 64; e += NGT) {
                const int d = e & 63, g = (e >> 6) & 31, hh = (e >> 11) & 7, bl = e >> 14;
                unsigned short q[8];
#pragma unroll
                for (int jj = 0; jj < 8; ++jj) {
                    const int p = 8 * g + jj, key = (p & ~31) + permkey(p & 31);
                    const float v = (hh < 2) ? cache_av[(((size_t)bl * 256 + key) * 2 + hh) * 64 + d] : cache_nv[(((size_t)bl * 256 + key) * 6 + (hh - 2)) * 64 + d];
                    q[jj] = (unsigned short)(pk2(v, 0.f) & 0xffffu);
                }
                u32x4 o; o.x = q[0] | ((unsigned)q[1] << 16); o.y = q[2] | ((unsigned)q[3] << 16); o.z = q[4] | ((unsigned)q[5] << 16); o.w = q[6] | ((unsigned)q[7] << 16);
                bf16_t* dst = (hh < 2) ? VCA + (((size_t)bl * 2 + hh) * 64 + d) * 256 + 8 * g : VCN + (((size_t)bl * 6 + (hh - 2)) * 64 + d) * 256 + 8 * g;
                *(u32x4*)dst = o;
            }
        }
    }
    SEAM(0);
    if (IN(1)) for (int rep_ = 0; rep_ < REP_P; ++rep_) {
        if (rep_) xcd_barrier(xbar);
        const int tid = opq_tid(), lane = tid & 63, wave = __builtin_amdgcn_readfirstlane(tid >> 6), gw = bx * 8 + wave;
        unsigned char* ws = ldws();
        float* mod = WSP(float, WS_MOD);
        {
            const float *w_in = ldin(12), *w1 = ldin(23);
            float *bias1 = WSP(float, WS_BIAS1), *bias2 = WSP(float, WS_BIAS2);
            for (int u = bx; u < DEPTH * 100; u += G) {
                const int l = u / 100; int r = u - l * 100;
                const float* ml = mod + (size_t)l * NMOD * 6144;
                if (r < 36) gemv9_unit(w_in + (size_t)l * D * INW, INW, r * 64, ml, ml + 6144, 6144, false, nullptr, bias1 + (size_t)l * NMOD * INW, INW, (float*)lds, tid);
                else { r -= 36; gemv9_unit(w1 + (size_t)l * D * FF, FF, r * 64, ml + 3072, ml + 6144 + 3072, 6144, false, nullptr, bias2 + (size_t)l * NMOD * FF, FF, (float*)lds, tid); }
            }
        }
        {
            const float *x_prompt = ldin(0), *x_sample = ldin(1), *norm1_g = ldin(10);
            bf16_t* XG = WSP(bf16_t, WS_XG); float* ssq = WSP(float, WS_SSQ);
            for (int row = gw; row < M; row += NGW) {
                const float* xr = (row < MP) ? x_prompt + (size_t)row * D : x_sample + (size_t)(row - MP) * D;
                const float* scp = mod + (size_t)modidx(row) * 6144 + 1024;
                float s = 0.f;
#pragma unroll
                for (int j = 0; j < 4; ++j) {
                    const int c = 256 * j + 4 * lane;
                    const f32x4 v = *(const f32x4*)(xr + c);
                    s += (v.x * v.x + v.y * v.y) + (v.z * v.z + v.w * v.w);
                    const f32x4 y = v * (*(const f32x4*)(norm1_g + c)) * (*(const f32x4*)(scp + c) + 1.0f);
                    u32x2 w; w.x = pk2(y.x, y.y); w.y = pk2(y.z, y.w);
                    *(u32x2*)(XG + (size_t)row * D + c) = w;
                }
                s = wave_sum(s);
                if (lane < 16) ssq[(size_t)row * 16 + lane] = (lane == 0) ? s : 0.f;
            }
        }
    }
    SEAM(1);
#pragma nounroll
    for (int l_ = 0; l_ < DEPTH; ++l_) {
        int l = l_; asm volatile("" : "+s"(l));
        const int p0 = 2 + 6 * l;
        if (IN(p0)) for (int rep_ = 0; rep_ < REP_G1; ++rep_) {
            unsigned char* ws = ldws();
            pg8::Gemm g{WSP(bf16_t, WS_XG), WSP(bf16_t, WS_WIN) + (size_t)l * INW * D, M, INW, D}; pg8::StaticOrder S; S.init(M, INW, G, bx);
            EpiLin<0> E{WSP(bf16_t, WS_RAW), INW, WSP(float, WS_BIAS1) + (size_t)l * NMOD * INW, INW, WSP(float, WS_SSQ)};
            pg8::gemm_phase<EpiLin<0>, pg8::StaticOrder, true, true>((LAS unsigned char*)lds, g, S, E);
        }
        SEAM(p0);
        if (IN(p0 + 1)) for (int rep_ = 0; rep_ < REP_PREP; ++rep_) {
            const int tid = opq_tid();
            unsigned char* ws = ldws();
            for (int u = bx; u < 768; u += G) {
                if (u < 384) conv_unit(u, l, WSP(bf16_t, WS_RAW), WSP(bf16_t, WS_ATT), ldin(13), ldin(14), ldin(15), ldin(16), (float*)lds, tid);
                else { PrepP P{WSP(bf16_t, WS_RAW), WSP(bf16_t, WS_Q), WSP(bf16_t, WS_K), WSP(bf16_t, WS_VT), ldout(), ldin(17), ldin(18), ldin(19), ldin(20)}; qkv_unit(u - 384, l, P, (bf16_t*)lds, tid); }
            }
        }
        SEAM(p0 + 1);
        if (IN(p0 + 2)) for (int rep_ = 0; rep_ < REP_ATTN; ++rep_) {
            const int tid = opq_tid(), lane = tid & 63, wave = __builtin_amdgcn_readfirstlane(tid >> 6), gw = bx * 8 + wave;
            unsigned char* ws = ldws();
            AttnP P{WSP(bf16_t, WS_Q), WSP(bf16_t, WS_K), WSP(bf16_t, WS_VT), WSP(bf16_t, WS_KCA), WSP(bf16_t, WS_VCA), WSP(bf16_t, WS_KCN), WSP(bf16_t, WS_VCN), WSP(bf16_t, WS_ATT), ldin(21)};
            const bool bal = (NGW == 2048);
            const int nu = bal ? (gw < 1536 ? 2 : 3) : (4608 - gw + NGW - 1) / NGW;
            for (int k = 0; k < nu; ++k) {
                const int uid = bal ? (gw < 1536 ? (k == 0 ? gw : 3072 + gw) : 1536 + 3 * (gw - 1536) + k) : gw + k * NGW;
                attn_run_unit(uid, l, P, lane);
            }
        }
        SEAM(p0 + 2);
        if (IN(p0 + 3)) {
            unsigned char* ws = ldws(); float* X = ldout();
            const float* ml = WSP(float, WS_MOD) + (size_t)l * NMOD * 6144;
            pg8::Gemm g{WSP(bf16_t, WS_ATT), WSP(bf16_t, WS_WOUT) + (size_t)l * D * D, M, D, D}; pg8::StaticOrder S; S.init(M, D, G, bx);
            EpiRes E{l == 0 ? ldin(0) : X, l == 0 ? ldin(1) : X + (size_t)MP * D, X, ml + 2048, ldin(11) + l * D, ml + 4096, WSP(bf16_t, WS_XG), WSP(float, WS_SSQ), 1};
            pg8::gemm_phase<EpiRes, pg8::StaticOrder, true, true>((LAS unsigned char*)lds, g, S, E);
            SEAM(p0 + 3);
        }
        if (IN(p0 + 4)) for (int rep_ = 0; rep_ < REP_G3; ++rep_) {
            unsigned char* ws = ldws();
            pg8::Gemm g{WSP(bf16_t, WS_XG), WSP(bf16_t, WS_W1) + (size_t)l * FF * D, M, FF, D}; pg8::StaticOrder S; S.init(M, FF, G, bx);
            EpiLin<1> E{WSP(bf16_t, WS_H1), FF, WSP(float, WS_BIAS2) + (size_t)l * NMOD * FF, FF, WSP(float, WS_SSQ)};
            pg8::gemm_phase<EpiLin<1>, pg8::StaticOrder, true, true>((LAS unsigned char*)lds, g, S, E);
        }
        SEAM(p0 + 4);
        if (IN(p0 + 5)) {
            unsigned char* ws = ldws(); float* X = ldout();
            const float* ml = WSP(float, WS_MOD) + (size_t)l * NMOD * 6144;
            pg8::Gemm g{WSP(bf16_t, WS_H1), WSP(bf16_t, WS_W2) + (size_t)l * D * FF, M, D, FF}; pg8::StaticOrder S; S.init(M, D, G, bx);
            const int nx = (l + 1 < DEPTH) ? 1 : 0; const int ln = nx ? l + 1 : l;
            EpiRes E{X, X + (size_t)MP * D, X, ml + 5120, ldin(10) + ln * D, WSP(float, WS_MOD) + (size_t)ln * NMOD * 6144 + 1024, WSP(bf16_t, WS_XG), WSP(float, WS_SSQ), nx};
            pg8::gemm_phase<EpiRes, pg8::StaticOrder, true, true>((LAS unsigned char*)lds, g, S, E);
            SEAM(p0 + 5);
        }
    }
#undef IN
#undef SEAM
#undef WSP
}

extern "C" void kernel_launch(void* const* d_in, const int* in_sizes, int n_in, void* d_out, int out_size, void* d_ws, size_t ws_size, hipStream_t stream) {
    static int grid = 0;
    if (grid == 0) {
        if (n_in != 25 || ws_size < WS_END) { fprintf(stderr, "kernel_launch: need 25 inputs and >= %zu bytes of workspace; got %d, %zu\n", (size_t)WS_END, n_in, ws_size); grid = -1; return; }
        int dev = 0, cus = 0, per_cu = 0;
        hipGetDevice(&dev);
        hipDeviceGetAttribute(&cus, hipDeviceAttributeMultiprocessorCount, dev);
        if (hipFuncSetAttribute((const void*)fwd_kernel, hipFuncAttributeMaxDynamicSharedMemorySize, LDS_BYTES) != hipSuccess) { fprintf(stderr, "kernel_launch: hipFuncSetAttribute failed\n"); grid = -1; return; }
        if (hipOccupancyMaxActiveBlocksPerMultiprocessor(&per_cu, (const void*)fwd_kernel, 512, LDS_BYTES) != hipSuccess || per_cu < 1) { fprintf(stderr, "kernel_launch: occupancy query says %d\n", per_cu); per_cu = 1; }
        (void)hipGetLastError();
        grid = cus * per_cu;
    }
    if (grid < 0) return;
    if (hipMemsetAsync(d_ws, 0, 16384, stream) != hipSuccess) { fprintf(stderr, "kernel_launch: memset failed\n"); return; }
    Args a{};
    for (int i = 0; i < 25; ++i) a.in[i] = (const float*)d_in[i];
    a.out = (float*)d_out; a.ws = (unsigned char*)d_ws;
#if MK_SINGLE
    a.ph_lo = 0; a.ph_hi = NPH;
    void* args[] = {&a};
    hipError_t e = hipLaunchCooperativeKernel((const void*)fwd_kernel, dim3(grid), dim3(512), args, LDS_BYTES, stream);
    if (e != hipSuccess) fprintf(stderr, "cooperative launch failed: %s (grid %d)\n", hipGetErrorString(e), grid);
#else
    for (int ph = 0; ph < NPH; ++ph) {
        a.ph_lo = ph; a.ph_hi = ph + 1;
        hipLaunchKernelGGL(fwd_kernel, dim3(grid), dim3(512), LDS_BYTES, stream, a);
    }
#endif
}
```

```cpp
#include <hip/hip_runtime.h>
#include <hip/hip_cooperative_groups.h>
#include <cstdio>
#include <cstdint>
namespace cg = cooperative_groups;
namespace pg8 {
#define PG8_LAS __attribute__((address_space(3)))
typedef unsigned short bf16_t;
typedef short bf16x8 __attribute__((ext_vector_type(8)));
typedef float f32x4 __attribute__((ext_vector_type(4)));
typedef unsigned u32x4 __attribute__((ext_vector_type(4)));
constexpr int BM = 256, BK = 64, HALF = 128, HTB = HALF * BK * 2  , STAGE_BYTES = 8 * HTB, NXCD = 8, WGM = 8;

__host__ __device__ __forceinline__ int lds_byte(int r, int c) { const int st = (r >> 4) * 2 + (c >> 5), rr = r & 15, cc = c & 31, ob = rr * 64 + cc * 2; return st * 1024 + (ob ^ (((ob >> 9) & 1) << 5)); }
__host__ __device__ __forceinline__ void stage_rc(int b, int& R, int& C) { const int st = b / 1024, sb = b % 1024, swz = sb ^ (((sb >> 9) & 1) << 5); R = (st >> 1) * 16 + swz / 64; C = (st & 1) * 32 + (swz % 64) / 2; }
__host__ __device__ __forceinline__ int perm32(int rho) { const int n = rho >> 4, i = rho & 15; return 8 * (i >> 2) + 4 * n + (i & 3); }

struct Unit { int pm, pn; };
struct Gemm { const bf16_t* A; const bf16_t* Bt; int M, N, K; };

struct StaticOrder {
    int nM, nN, nwg, G, c;
    __host__ __device__ void init(int M, int N, int G_, int c_) { nM = M / BM; nN = N / BM; nwg = nM * nN; G = G_; c = c_; }
    __host__ __device__ bool next(int i, Unit& u) const {
        const long L = (long)i * G + c; if (L >= nwg) return false;
        int wgid = (int)L; { const int q = nwg / NXCD, r = nwg % NXCD, xcd = wgid % NXCD, off = wgid / NXCD; wgid = (xcd < r ? xcd * (q + 1) : r * (q + 1) + (xcd - r) * q) + off; }
        const int nig = WGM * nN, gid = wgid / nig, fm = gid * WGM, gsz = (nM - fm) < WGM ? (nM - fm) : WGM;
        u.pm = fm + ((wgid % nig) % gsz); u.pn = (wgid % nig) / gsz; return true;
    }
    __device__ __forceinline__ void a_ready(const Unit&) const {}
    __device__ __forceinline__ void done(const Unit&) const {}
};
__device__ __forceinline__ unsigned cvt_pk_bf16(float lo, float hi) { unsigned r; asm volatile("v_cvt_pk_bf16_f32 %0, %1, %2" : "=v"(r) : "v"(lo), "v"(hi)); return r; }
template <class Epi, class Sched, bool ALIGN_EPI = false, bool SP2 = false>
__device__ __forceinline__ void gemm_phase(PG8_LAS unsigned char* lds, const Gemm g, const Sched& S, const Epi& E) {
    int tid_ = threadIdx.x; asm volatile("" : "+v"(tid_));
    const int tid = tid_, wid = __builtin_amdgcn_readfirstlane(tid >> 6), lane = tid & 63, wr = wid >> 2, wc = wid & 3, fr = lane & 15, fq = lane >> 4;
    const int K = g.K, nt = K / BK;
    unsigned voffA[2], voffB[2];
#pragma unroll
    for (int i = 0; i < 2; ++i) { int R, C; stage_rc(tid * 16 + i * 8192, R, C); const int Rb = Epi::PERM ? ((R & ~31) + perm32(R & 31)) : R;
        voffA[i] = (unsigned)(R * K + C) * 2u; voffB[i] = (unsigned)(Rb * K + C) * 2u; }
    const size_t kstep = (size_t)(BK * 2);
    const size_t hstep = (size_t)HALF * K * 2;
    const size_t tstep = 2 * hstep;
    const unsigned ldsw = (unsigned)wid * 1024u;
    const int aoff = lds_byte(wr * 64 + fr, fq * 8), boff = lds_byte(wc * 32 + fr, fq * 8);
#define PG8_SA(b, h) (((b) * 2 + (h)) * HTB)
#define PG8_SB(b, h) ((4 + (b) * 2 + (h)) * HTB)
#define PG8_STAGE(bufoff, gbase, voff) do { _Pragma("unroll") for (int _i = 0; _i < 2; ++_i) \
        __builtin_amdgcn_global_load_lds((const unsigned*)((const char*)(gbase) + (voff)[_i]), (PG8_LAS unsigned*)(lds + (bufoff) + ldsw + _i * 8192), 16, 0, 0); } while (0)
#define PG8_LDA(dst, b, h) do { _Pragma("unroll") for (int m = 0; m < 4; ++m) _Pragma("unroll") for (int k = 0; k < 2; ++k) dst[m][k] = *(const PG8_LAS bf16x8*)(lds + PG8_SA(b, h) + aoff + m * 2048 + k * 1024); } while (0)
#define PG8_LDB(dst, b, h) do { _Pragma("unroll") for (int n = 0; n < 2; ++n) _Pragma("unroll") for (int k = 0; k < 2; ++k) dst[n][k] = *(const PG8_LAS bf16x8*)(lds + PG8_SB(b, h) + boff + n * 2048 + k * 1024); } while (0)
#define PG8_MMA(ai, bj, At, Bt) do { __builtin_amdgcn_s_setprio(1); _Pragma("unroll") for (int m = 0; m < 4; ++m) _Pragma("unroll") for (int n = 0; n < 2; ++n) _Pragma("unroll") for (int k = 0; k < 2; ++k) \
        acc[ai][bj][m][n] = __builtin_amdgcn_mfma_f32_16x16x32_bf16(Bt[n][k], At[m][k], acc[ai][bj][m][n], 0, 0, 0); __builtin_amdgcn_s_setprio(0); } while (0)
#define PG8_WAIT_V(n) asm volatile("s_waitcnt vmcnt(" #n ")" ::: "memory")
#define PG8_WAIT_L(n) asm volatile("s_waitcnt lgkmcnt(" #n ")" ::: "memory")
#define PG8_BAR __builtin_amdgcn_s_barrier()
#define PG8_SCHED __builtin_amdgcn_sched_barrier(0)
    Unit cur, nxt; int ui = 0;
    if (!S.next(0, cur)) return;
    f32x4 acc[2][2][4][2];
#pragma unroll
    for (int a = 0; a < 2; ++a)
#pragma unroll
        for (int b = 0; b < 2; ++b)
#pragma unroll
            for (int m = 0; m < 4; ++m)
#pragma unroll
                for (int n = 0; n < 2; ++n) acc[a][b][m][n] = (f32x4){0.f, 0.f, 0.f, 0.f};
    bf16x8 At[4][2], B0[2][2], B1[2][2];
    const char* cA = (const char*)g.A + (size_t)cur.pm * tstep; const char* cB = (const char*)g.Bt + (size_t)cur.pn * tstep;
    S.a_ready(cur);
    if constexpr (SP2) {
        PG8_STAGE(PG8_SB(0, 0), cB, voffB); PG8_STAGE(PG8_SB(0, 1), cB + hstep, voffB); PG8_STAGE(PG8_SA(0, 0), cA, voffA); PG8_STAGE(PG8_SA(0, 1), cA + hstep, voffA);
        if (wr == 1) PG8_BAR;
        PG8_WAIT_V(2); PG8_BAR;
        PG8_STAGE(PG8_SB(1, 0), cB + kstep, voffB); PG8_STAGE(PG8_SA(1, 0), cA + kstep, voffA); PG8_STAGE(PG8_SB(1, 1), cB + hstep + kstep, voffB);
        PG8_WAIT_V(6); PG8_BAR;
    } else {
        PG8_STAGE(PG8_SB(0, 0), cB, voffB); PG8_STAGE(PG8_SA(0, 0), cA, voffA); PG8_STAGE(PG8_SB(0, 1), cB + hstep, voffB); PG8_STAGE(PG8_SA(0, 1), cA + hstep, voffA);
        if (wr == 1) PG8_BAR;
        PG8_WAIT_V(4); PG8_BAR;
        PG8_STAGE(PG8_SB(1, 0), cB + kstep, voffB); PG8_STAGE(PG8_SA(1, 0), cA + kstep, voffA); PG8_STAGE(PG8_SB(1, 1), cB + hstep + kstep, voffB);
        PG8_WAIT_V(6); PG8_BAR;
    }
    for (;;) {
        const bool has_next = S.next(ui + 1, nxt);
        const char* nA = has_next ? (const char*)g.A + (size_t)nxt.pm * tstep : cA; const char* nB = has_next ? (const char*)g.Bt + (size_t)nxt.pn * tstep : cB;
        for (int t = 0; t < nt; t += 2) {
            const bool last = (t == nt - 2);
            const char* a1 = cA + (size_t)(t + 1) * kstep;
            const char* a2 = last ? nA : cA + (size_t)(t + 2) * kstep; const char* b2 = last ? nB : cB + (size_t)(t + 2) * kstep;
            const char* a3 = a2 + kstep; const char* b3 = b2 + kstep;
            if (last && has_next) S.a_ready(nxt);
            if constexpr (SP2) {
            PG8_LDB(B0, 0, 0); PG8_LDB(B1, 0, 1); PG8_SCHED; PG8_LDA(At, 0, 0); PG8_STAGE(PG8_SA(1, 1), a1 + hstep, voffA);
            PG8_WAIT_V(8); PG8_WAIT_L(0); PG8_BAR; PG8_MMA(0, 0, At, B0); PG8_MMA(0, 1, At, B1); PG8_BAR; PG8_SCHED;
            PG8_LDA(At, 0, 1); PG8_STAGE(PG8_SB(0, 0), b2, voffB); PG8_STAGE(PG8_SB(0, 1), b2 + hstep, voffB); PG8_STAGE(PG8_SA(0, 0), a2, voffA);
            PG8_WAIT_V(8); PG8_WAIT_L(0); PG8_BAR; PG8_MMA(1, 0, At, B0); PG8_MMA(1, 1, At, B1); PG8_BAR; PG8_SCHED;
            PG8_LDB(B0, 1, 0); PG8_LDB(B1, 1, 1); PG8_SCHED; PG8_LDA(At, 1, 0); PG8_STAGE(PG8_SA(0, 1), a2 + hstep, voffA);
            PG8_WAIT_V(8); PG8_WAIT_L(0); PG8_BAR; PG8_MMA(0, 0, At, B0); PG8_MMA(0, 1, At, B1); PG8_BAR; PG8_SCHED;
            PG8_LDA(At, 1, 1); PG8_STAGE(PG8_SB(1, 0), b3, voffB); PG8_STAGE(PG8_SB(1, 1), b3 + hstep, voffB); PG8_STAGE(PG8_SA(1, 0), a3, voffA);
            PG8_WAIT_V(8); PG8_WAIT_L(0); PG8_BAR; PG8_MMA(1, 0, At, B0); PG8_MMA(1, 1, At, B1); PG8_BAR; PG8_SCHED;
            } else {
            PG8_LDB(B0, 0, 0); PG8_SCHED; PG8_LDA(At, 0, 0); PG8_STAGE(PG8_SA(1, 1), a1 + hstep, voffA);
            PG8_WAIT_L(8); PG8_BAR; PG8_WAIT_L(0); PG8_MMA(0, 0, At, B0); PG8_BAR; PG8_SCHED;
            PG8_LDB(B1, 0, 1); PG8_STAGE(PG8_SB(0, 0), b2, voffB);
            PG8_BAR; PG8_WAIT_L(0); PG8_MMA(0, 1, At, B1); PG8_BAR;
            PG8_LDA(At, 0, 1); PG8_STAGE(PG8_SA(0, 0), a2, voffA);
            PG8_BAR; PG8_WAIT_L(0); PG8_MMA(1, 0, At, B0); PG8_BAR; PG8_SCHED;
            PG8_STAGE(PG8_SB(0, 1), b2 + hstep, voffB);
            PG8_WAIT_V(6); PG8_BAR; PG8_MMA(1, 1, At, B1); PG8_BAR;
            PG8_LDB(B0, 1, 0); PG8_SCHED; PG8_LDA(At, 1, 0); PG8_STAGE(PG8_SA(0, 1), a2 + hstep, voffA);
            PG8_WAIT_L(8); PG8_BAR; PG8_WAIT_L(0); PG8_MMA(0, 0, At, B0); PG8_BAR; PG8_SCHED;
            PG8_LDB(B1, 1, 1); PG8_STAGE(PG8_SB(1, 0), b3, voffB);
            PG8_BAR; PG8_WAIT_L(0); PG8_MMA(0, 1, At, B1); PG8_BAR;
            PG8_LDA(At, 1, 1); PG8_STAGE(PG8_SA(1, 0), a3, voffA);
            PG8_BAR; PG8_WAIT_L(0); PG8_MMA(1, 0, At, B0); PG8_BAR; PG8_SCHED;
            PG8_STAGE(PG8_SB(1, 1), b3 + hstep, voffB);
            PG8_WAIT_V(6); PG8_BAR; PG8_MMA(1, 1, At, B1); PG8_BAR;
            }
        }
        if constexpr (ALIGN_EPI) { if (wr == 0) PG8_BAR; }
        if constexpr (!Epi::AFTER_DRAIN) { E(acc, cur, wr, wc, fr, fq); S.done(cur); }
        if (!has_next) break;
#pragma unroll
        for (int a = 0; a < 2; ++a)
#pragma unroll
            for (int b = 0; b < 2; ++b)
#pragma unroll
                for (int m = 0; m < 4; ++m)
#pragma unroll
                    for (int n = 0; n < 2; ++n) acc[a][b][m][n] = (f32x4){0.f, 0.f, 0.f, 0.f};
        cur = nxt; cA = nA; cB = nB; ++ui;
        if constexpr (ALIGN_EPI) { if (wr == 1) PG8_BAR; }
    }
    PG8_WAIT_V(0);
    if constexpr (!ALIGN_EPI) { if (wr == 0) PG8_BAR; }
    PG8_BAR;
    if constexpr (Epi::AFTER_DRAIN) { E.fused(acc, cur, wr, wc, fr, fq, lds, wid, lane); S.done(cur); }
#undef PG8_SA
#undef PG8_SB
#undef PG8_STAGE
#undef PG8_LDA
#undef PG8_LDB
#undef PG8_MMA
#undef PG8_WAIT_V
#undef PG8_WAIT_L
#undef PG8_BAR
#undef PG8_SCHED
}
}

#define DI __device__ __forceinline__
#define LAS __attribute__((address_space(3)))
typedef unsigned short bf16_t;
typedef short bf16x8 __attribute__((ext_vector_type(8)));
typedef float f32x4 __attribute__((ext_vector_type(4)));
typedef float f32x16 __attribute__((ext_vector_type(16)));
typedef unsigned u32x4 __attribute__((ext_vector_type(4)));
typedef unsigned u32x2 __attribute__((ext_vector_type(2)));
typedef float f32x2_t __attribute__((ext_vector_type(2)));
typedef __bf16 bf16x2_t __attribute__((ext_vector_type(2)));

#ifndef REP_P
#define REP_P 1
#endif
#ifndef REP_G1
#define REP_G1 1
#endif
#ifndef REP_PREP
#define REP_PREP 1
#endif
#ifndef REP_ATTN
#define REP_ATTN 1
#endif
#ifndef REP_G3
#define REP_G3 1
#endif
#ifndef SYNCX
#define SYNCX 0
#endif
#ifndef MK_SINGLE
#define MK_SINGLE 1
#endif

constexpr int D = 1024, MP = 8192, MS = 16384, M = MP + MS, DEPTH = 4, NMOD = 9, INW = 2304, FF = 4096;
constexpr int NPH = 2 + 6 * DEPTH;
constexpr float QSCALE = 0.125f * 1.4426950408889634f, LOG2E = 1.4426950408889634f, EPS = 1e-6f;
constexpr size_t OFF_AK = 25165824, OFF_AV = 29360128, OFF_NK = 33554432, OFF_NV = 46137344;
constexpr size_t MiB = 1u << 20;
constexpr size_t WS_MOD = 1 * MiB, WS_BIAS1 = 2 * MiB, WS_BIAS2 = 3 * MiB, WS_SSQ = 4 * MiB;
constexpr size_t WS_KCA = 6 * MiB, WS_VCA = 8 * MiB, WS_KCN = 10 * MiB, WS_VCN = 16 * MiB;
constexpr size_t WS_WIN = 22 * MiB, WS_WOUT = 40 * MiB, WS_W1 = 48 * MiB, WS_W2 = 80 * MiB;
constexpr size_t WS_XG = 112 * MiB, WS_H1 = 160 * MiB, WS_RAW = 160 * MiB, WS_Q = 268 * MiB, WS_K = 304 * MiB, WS_VT = 328 * MiB, WS_ATT = 352 * MiB, WS_END = 400 * MiB;
constexpr int LDS_BYTES = 147456;

DI unsigned pk2(float lo, float hi) { f32x2_t v = {lo, hi}; bf16x2_t b = __builtin_convertvector(v, bf16x2_t); return __builtin_bit_cast(unsigned, b); }
DI float bflo(unsigned w) { return __uint_as_float(w << 16); }
DI float bfhi(unsigned w) { return __uint_as_float(w & 0xffff0000u); }
DI void unpack8(const u32x4 w, float (&v)[8]) { v[0] = bflo(w.x); v[1] = bfhi(w.x); v[2] = bflo(w.y); v[3] = bfhi(w.y); v[4] = bflo(w.z); v[5] = bfhi(w.z); v[6] = bflo(w.w); v[7] = bfhi(w.w); }
DI int modidx(int row) { return row < MP ? 0 : 1 + ((row - MP) >> 11); }
DI float wave_sum(float v) {
#pragma unroll
    for (int o = 1; o < 64; o <<= 1) v += __shfl_xor(v, o);
    return v;
}
DI float sigmoidf_(float x) { return 1.f / (1.f + __expf(-x)); }
DI int crow(int i, int hi) { return (i & 3) + 8 * (i >> 2) + 4 * hi; }
DI int permkey(int p) { const int s = p >> 4, hh = (p >> 3) & 1, jj = p & 7; return 16 * s + 8 * (jj >> 2) + 4 * hh + (jj & 3); }

template <int ACT> struct EpiLin {
    static constexpr bool PERM = true, AFTER_DRAIN = false;
    bf16_t* O; int ldc; const float* bias; int ldb; const float* ssq;
    DI void operator()(const f32x4 (&acc)[2][2][4][2], const pg8::Unit& u, int wr, int wc, int fr, int fq) const {
        const int row0 = u.pm * 256 + wr * 64 + fr, col0 = u.pn * 256 + wc * 32 + 8 * fq;
        const float* bp = bias + (size_t)modidx(u.pm * 256) * ldb + col0;
        f32x4 bv[2][2];
#pragma unroll
        for (int bj = 0; bj < 2; ++bj)
#pragma unroll
            for (int n = 0; n < 2; ++n) bv[bj][n] = *(const f32x4*)(bp + bj * 128 + 4 * n);
#pragma unroll
        for (int ai = 0; ai < 2; ++ai)
#pragma unroll
            for (int m = 0; m < 4; ++m) {
                const int row = row0 + ai * 128 + m * 16;
                const f32x4 s4 = *(const f32x4*)(ssq + (size_t)row * 16 + 4 * fq);
                float s = (s4.x + s4.y) + (s4.z + s4.w); s += __shfl_xor(s, 16); s += __shfl_xor(s, 32);
                const float rstd = rsqrtf(s * (1.f / 1024.f) + EPS);
                bf16_t* rowp = O + (size_t)row * ldc + col0;
#pragma unroll
                for (int bj = 0; bj < 2; ++bj) {
                    f32x4 v0 = acc[ai][bj][m][0] * rstd + bv[bj][0], v1 = acc[ai][bj][m][1] * rstd + bv[bj][1];
                    if (ACT == 1) {
#pragma unroll
                        for (int e = 0; e < 4; ++e) { const float a = fmaxf(v0[e], 0.f), b = fmaxf(v1[e], 0.f); v0[e] = a * a; v1[e] = b * b; }
                    }
                    u32x4 w; w.x = pk2(v0[0], v0[1]); w.y = pk2(v0[2], v0[3]); w.z = pk2(v1[0], v1[1]); w.w = pk2(v1[2], v1[3]);
                    *(u32x4*)(rowp + bj * 128) = w;
                }
            }
    }
};
struct EpiRes {
    static constexpr bool PERM = false, AFTER_DRAIN = false;
    const float* baseP; const float* baseS; float* out; const float* gate; const float* nw; const float* sc; bf16_t* xg; float* ssq; int has_next;
    DI void operator()(const f32x4 (&acc)[2][2][4][2], const pg8::Unit& u, int wr, int wc, int fr, int fq) const {
        const int col0 = u.pn * 256 + wc * 32 + 4 * fq, j = modidx(u.pm * 256);
        const float* gp = gate + (size_t)j * 6144 + col0;
        f32x4 gv[2][2], gn[2][2];
#pragma unroll
        for (int bj = 0; bj < 2; ++bj)
#pragma unroll
            for (int n = 0; n < 2; ++n) {
                gv[bj][n] = *(const f32x4*)(gp + bj * 128 + n * 16);
                if (has_next) gn[bj][n] = *(const f32x4*)(nw + col0 + bj * 128 + n * 16) * (*(const f32x4*)(sc + (size_t)j * 6144 + col0 + bj * 128 + n * 16) + 1.0f);
                else gn[bj][n] = (f32x4){0.f, 0.f, 0.f, 0.f};
            }
#pragma unroll
        for (int ai = 0; ai < 2; ++ai)
#pragma unroll
            for (int m = 0; m < 4; ++m) {
                const int row = u.pm * 256 + ai * 128 + wr * 64 + m * 16 + fr;
                const float* b = (row < MP) ? baseP + (size_t)row * D : baseS + (size_t)(row - MP) * D;
                float q = 0.f;
#pragma unroll
                for (int bj = 0; bj < 2; ++bj)
#pragma unroll
                    for (int n = 0; n < 2; ++n) {
                        const int c = col0 + bj * 128 + n * 16;
                        const f32x4 x = *(const f32x4*)(b + c) + gv[bj][n] * acc[ai][bj][m][n];
                        *(f32x4*)(out + (size_t)row * D + c) = x;
                        q += (x.x * x.x + x.y * x.y) + (x.z * x.z + x.w * x.w);
                        if (has_next) { const f32x4 y = x * gn[bj][n]; u32x2 w; w.x = pk2(y.x, y.y); w.y = pk2(y.z, y.w); *(u32x2*)(xg + (size_t)row * D + c) = w; }
                    }
                q += __shfl_xor(q, 16); q += __shfl_xor(q, 32);
                if (fq == 0 && has_next) ssq[(size_t)row * 16 + u.pn * 4 + wc] = q;
            }
    }
};

DI void transpose_item(const float* W, int K, int N, bf16_t* WT, LAS float* scr, int item, int lane) {
    const int nblk = N / 32, kb = item / nblk, nb = item % nblk, k0 = 64 * kb, n0 = 32 * nb;
#pragma unroll 8
    for (int i = 0; i < 32; ++i) { const int kk = 2 * i + (lane >> 5); scr[kk * 33 + (lane & 31)] = W[(size_t)(k0 + kk) * N + n0 + (lane & 31)]; }
    asm volatile("s_waitcnt lgkmcnt(0)" ::: "memory");
    const int c = lane & 7;
#pragma unroll
    for (int j = 0; j < 4; ++j) { const int n = (lane >> 3) + 8 * j; const LAS float* s = scr + (8 * c) * 33 + n;
        u32x4 o; o.x = pk2(s[0 * 33], s[1 * 33]); o.y = pk2(s[2 * 33], s[3 * 33]); o.z = pk2(s[4 * 33], s[5 * 33]); o.w = pk2(s[6 * 33], s[7 * 33]);
        *(u32x4*)(WT + (size_t)(n0 + n) * K + k0 + 8 * c) = o; }
    asm volatile("s_waitcnt lgkmcnt(0)" ::: "memory");
}
DI void gemv9_unit(const float* W, int N, int n0, const float* v0, const float* v1, int vs, bool do_silu, const float* badd, float* out, int ostride, float* scr, int tid) {
    const int wave = __builtin_amdgcn_readfirstlane(tid >> 6), lane = tid & 63;
    float acc[NMOD];
#pragma unroll
    for (int j = 0; j < NMOD; ++j) acc[j] = 0.f;
    const float* wp = W + (size_t)(wave * 128) * N + n0 + lane;
#pragma unroll 4
    for (int k = 0; k < 128; ++k) {
        const float w = wp[(size_t)k * N];
        const int kk = wave * 128 + k;
#pragma unroll
        for (int j = 0; j < NMOD; ++j) {
            float v = (j == 0) ? v0[kk] : v1[(size_t)(j - 1) * vs + kk];
            if (do_silu) v = v * sigmoidf_(v);
            acc[j] += v * w;
        }
    }
#pragma unroll
    for (int j = 0; j < NMOD; ++j) scr[(wave * NMOD + j) * 64 + lane] = acc[j];
    __syncthreads();
    for (int idx = tid; idx < NMOD * 64; idx += 512) {
        const int j = idx >> 6, ln = idx & 63; float s = 0.f;
#pragma unroll
        for (int w = 0; w < 8; ++w) s += scr[(w * NMOD + j) * 64 + ln];
        if (badd) s += badd[n0 + ln];
        out[(size_t)j * ostride + n0 + ln] = s;
    }
    __syncthreads();
}

DI void conv_unit(int ct, int l, const bf16_t* RAW, bf16_t* ATT, const float* dw_w, const float* dw_b, const float* ln_g, const float* ln_b, float* lds, int tid) {
    const int row0 = ct * 64;
    int seq0, L;
    if (row0 < MP) { seq0 = row0 & ~255; L = 256; } else { seq0 = MP + ((row0 - MP) & ~2047); L = 2048; }
    const int t0 = row0 - seq0;
    for (int it = tid; it < 94 * 32; it += 512) {
        const int rr = it >> 5, c8 = it & 31, t = t0 - 15 + rr;
        float hv[8];
        if (t >= 0 && t < L) {
            const bf16_t* p = RAW + (size_t)(seq0 + t) * INW + c8 * 8;
            const u32x4 wa = *(const u32x4*)p, wg = *(const u32x4*)(p + 256);
            float a[8], g[8]; unpack8(wa, a); unpack8(wg, g);
#pragma unroll
            for (int e = 0; e < 8; ++e) hv[e] = a[e] * sigmoidf_(g[e]);
        } else {
#pragma unroll
            for (int e = 0; e < 8; ++e) hv[e] = 0.f;
        }
        float* d = lds + rr * 256 + c8 * 8;
        *(f32x4*)d = (f32x4){hv[0], hv[1], hv[2], hv[3]}; *(f32x4*)(d + 4) = (f32x4){hv[4], hv[5], hv[6], hv[7]};
    }
    __syncthreads();
    const int c = tid & 255, th = tid >> 8;
    float w[31];
#pragma unroll
    for (int k = 0; k < 31; ++k) w[k] = dw_w[(size_t)(l * 31 + k) * 256 + c];
    const float bias = dw_b[l * 256 + c];
    float outv[32];
#pragma unroll
    for (int ch = 0; ch < 2; ++ch) {
        float hv[46];
#pragma unroll
        for (int i = 0; i < 46; ++i) hv[i] = lds[(th * 32 + ch * 16 + i) * 256 + c];
#pragma unroll
        for (int o = 0; o < 16; ++o) {
            float s = bias;
#pragma unroll
            for (int k = 0; k < 31; ++k) s += hv[o + k] * w[k];
            outv[ch * 16 + o] = s;
        }
    }
    __syncthreads();
#pragma unroll
    for (int o = 0; o < 32; ++o) lds[(th * 32 + o) * 256 + c] = outv[o];
    __syncthreads();
    const int wave = tid >> 6, lane = tid & 63;
    const f32x4 g4 = *(const f32x4*)(ln_g + l * 256 + 4 * lane), b4 = *(const f32x4*)(ln_b + l * 256 + 4 * lane);
#pragma unroll
    for (int i = 0; i < 8; ++i) {
        const int tk = wave * 8 + i;
        const f32x4 v = *(const f32x4*)(lds + tk * 256 + 4 * lane);
        const float mean = wave_sum((v.x + v.y) + (v.z + v.w)) * (1.f / 256.f);
        const f32x4 dv = v - mean;
        const float var = wave_sum((dv.x * dv.x + dv.y * dv.y) + (dv.z * dv.z + dv.w * dv.w)) * (1.f / 256.f);
        const float rstd = rsqrtf(var + EPS);
        f32x4 y = dv * rstd * g4 + b4;
        y.x *= sigmoidf_(y.x); y.y *= sigmoidf_(y.y); y.z *= sigmoidf_(y.z); y.w *= sigmoidf_(y.w);
        u32x2 o; o.x = pk2(y.x, y.y); o.y = pk2(y.z, y.w);
        *(u32x2*)(ATT + (size_t)(row0 + tk) * D + 4 * lane) = o;
    }
    __syncthreads();
}

struct PrepP { const bf16_t* RAW; bf16_t* Q; bf16_t* K; bf16_t* VT; float* out; const float *aqg, *akg, *nqg, *nkg; };
DI void qkv_unit(int ct, int l, const PrepP& P, bf16_t* ldsv, int tid) {
    const int row0 = ct * 64;
    const bool prompt = row0 < MP;
    int seq0, L, sb;
    if (prompt) { seq0 = row0 & ~255; L = 256; sb = row0 >> 8; } else { seq0 = MP + ((row0 - MP) & ~2047); L = 2048; sb = (row0 - MP) >> 11; }
    const int t0 = row0 - seq0;
    {
    const int lane = tid & 63, wave = __builtin_amdgcn_readfirstlane(tid >> 6), half = lane >> 5;
    for (int wi = wave; wi < 40; wi += 8) {
        const int hd = wi >> 1, tok = (wi & 1) * 32 + (lane & 31);
        const int row = row0 + tok, t = t0 + tok;
        int rcol; const float* gw; bool isq;
        if (hd < 6) { rcol = 512 + 64 * hd; gw = P.aqg; isq = true; }
        else if (hd < 8) { rcol = 896 + 64 * (hd - 6); gw = P.akg; isq = false; }
        else if (hd < 14) { rcol = 1152 + 64 * (hd - 8); gw = P.nqg; isq = true; }
        else { rcol = 1536 + 64 * (hd - 14); gw = P.nkg; isq = false; }
        float v[32];
        const bf16_t* rp = P.RAW + (size_t)row * INW + rcol + 32 * half;
#pragma unroll
        for (int c = 0; c < 4; ++c) { const u32x4 wv = *(const u32x4*)(rp + 8 * c); float tmp[8]; unpack8(wv, tmp);
#pragma unroll
            for (int e2 = 0; e2 < 8; ++e2) v[8 * c + e2] = tmp[e2]; }
        float ss = 0.f;
#pragma unroll
        for (int d = 0; d < 32; ++d) ss += v[d] * v[d];
        ss += __shfl_xor(ss, 32);
        const float rstd = rsqrtf(ss * (1.f / 64.f) + EPS);
        const float* gp = gw + l * 64 + 32 * half;
#pragma unroll
        for (int c4 = 0; c4 < 8; ++c4) { const f32x4 g4 = *(const f32x4*)(gp + 4 * c4); v[4 * c4] *= rstd * g4.x; v[4 * c4 + 1] *= rstd * g4.y; v[4 * c4 + 2] *= rstd * g4.z; v[4 * c4 + 3] *= rstd * g4.w; }
        if ((!prompt) && (hd < 8)) {
            const float pos = (float)(half ? (t & 63) : (t >> 6));
#pragma unroll
            for (int j = 0; j < 16; ++j) {
                const float inv = exp2f(-(float)j * 0.8304820237218406f);
                float sn, cs; __sincosf(pos * inv, &sn, &cs);
                const float a = v[j], b = v[16 + j];
                v[j] = a * cs - b * sn; v[16 + j] = b * cs + a * sn;
            }
        }
        if (isq) {
            const int qh = (hd < 6) ? hd : 6 + (hd - 8);
            bf16_t* qp = P.Q + (prompt ? ((size_t)(sb * 12 + qh) * 8 + (t >> 5)) * 2048 : (size_t)MP * 768 + ((size_t)(sb * 12 + qh) * 64 + (t >> 5)) * 2048) + (t & 31) * 8 + half * 1024;
#pragma unroll
            for (int c = 0; c < 4; ++c) {
                u32x4 o; o.x = pk2(v[8 * c] * QSCALE, v[8 * c + 1] * QSCALE); o.y = pk2(v[8 * c + 2] * QSCALE, v[8 * c + 3] * QSCALE);
                o.z = pk2(v[8 * c + 4] * QSCALE, v[8 * c + 5] * QSCALE); o.w = pk2(v[8 * c + 6] * QSCALE, v[8 * c + 7] * QSCALE);
                *(u32x4*)(qp + c * 256) = o;
            }
        } else {
            const int kh = (hd < 8) ? (hd - 6) : 2 + (hd - 14);
            bf16_t* kp = P.K + (prompt ? ((size_t)(sb * 8 + kh) * 8 + (t >> 5)) * 2048 : (size_t)MP * 512 + ((size_t)(sb * 8 + kh) * 64 + (t >> 5)) * 2048) + (t & 31) * 8 + half * 1024;
#pragma unroll
            for (int c = 0; c < 4; ++c) {
                u32x4 o; o.x = pk2(v[8 * c], v[8 * c + 1]); o.y = pk2(v[8 * c + 2], v[8 * c + 3]); o.z = pk2(v[8 * c + 4], v[8 * c + 5]); o.w = pk2(v[8 * c + 6], v[8 * c + 7]);
                *(u32x4*)(kp + c * 256) = o;
            }
            if (prompt) {
                float* op;
                if (hd < 8) op = P.out + OFF_AK + ((((size_t)sb * 4 + l) * 256 + t) * 2 + (hd - 6)) * 64 + 32 * half;
                else        op = P.out + OFF_NK + ((((size_t)sb * 4 + l) * 256 + t) * 6 + (hd - 14)) * 64 + 32 * half;
#pragma unroll
                for (int c4 = 0; c4 < 8; ++c4) *(f32x4*)(op + 4 * c4) = (f32x4){v[4 * c4], v[4 * c4 + 1], v[4 * c4 + 2], v[4 * c4 + 3]};
            }
        }
    }
    }
    for (int it = tid; it < 64 * 64; it += 512) {
        const int tok = it >> 6, ch = it & 63;
        const int cc = ch * 8, rcol = (cc < 128) ? 1024 + cc : 1920 + (cc - 128);
        const u32x4 wv = *(const u32x4*)(P.RAW + (size_t)(row0 + tok) * INW + rcol);
        *(u32x4*)(ldsv + tok * 512 + cc) = wv;
        if (prompt) {
            float v[8]; unpack8(wv, v);
            const int t = t0 + tok; float* op;
            if (cc < 128) op = P.out + OFF_AV + (((size_t)sb * 4 + l) * 256 + t) * 128 + cc;
            else          op = P.out + OFF_NV + (((size_t)sb * 4 + l) * 256 + t) * 384 + (cc - 128);
            *(f32x4*)op = (f32x4){v[0], v[1], v[2], v[3]}; *(f32x4*)(op + 4) = (f32x4){v[4], v[5], v[6], v[7]};
        }
    }
    __syncthreads();
    for (int it = tid; it < 512 * 8; it += 512) {
        const int hd_d = it & 511, g = it >> 9;
        unsigned short e[8];
#pragma unroll
        for (int jj = 0; jj < 8; ++jj) { const int p = 8 * g + jj; const int key = (p & ~31) + permkey(p & 31); e[jj] = ldsv[key * 512 + hd_d]; }
        u32x4 o; o.x = e[0] | ((unsigned)e[1] << 16); o.y = e[2] | ((unsigned)e[3] << 16); o.z = e[4] | ((unsigned)e[5] << 16); o.w = e[6] | ((unsigned)e[7] << 16);
        const int vh = hd_d >> 6, dd = hd_d & 63, tile = (t0 >> 5) + (g >> 2);
        const size_t base = prompt ? ((size_t)(sb * 8 + vh) * 8 + tile) * 2048 : (size_t)MP * 512 + ((size_t)(sb * 8 + vh) * 64 + tile) * 2048;
        *(u32x4*)(P.VT + base + ((((dd >> 5) * 2 + ((g >> 1) & 1)) * 2 + (g & 1)) * 32 + (dd & 31)) * 8) = o;
    }
    __syncthreads();
}

struct Seg { const bf16_t* k; const bf16_t* v; int nt; };
#define MFMA32(a, b, c) __builtin_amdgcn_mfma_f32_32x32x16_bf16((a), (b), (c), 0, 0, 0)
DI void ld_k(const Seg& A, const Seg& B, int t, int lane, bf16x8 (&kf)[4]) {
    const bf16_t* kp = (t < A.nt) ? A.k + (size_t)t * 2048 : B.k + (size_t)(t - A.nt) * 2048;
#pragma unroll
    for (int kk = 0; kk < 4; ++kk) kf[kk] = *(const bf16x8*)(kp + kk * 512 + lane * 8);
}
DI void ld_v(const Seg& A, const Seg& B, int t, int lane, bf16x8 (&vf)[2][2]) {
    const bf16_t* vp = (t < A.nt) ? A.v + (size_t)t * 2048 : B.v + (size_t)(t - A.nt) * 2048;
#pragma unroll
    for (int db = 0; db < 2; ++db)
#pragma unroll
        for (int s = 0; s < 2; ++s) vf[db][s] = *(const bf16x8*)(vp + (db * 2 + s) * 512 + lane * 8);
}
template <bool NA> DI void attn_wave(const bf16_t* Qp, const Seg A, const Seg B, bf16_t* Op, const float* rpbh, int r, int rs, int lane_) {
    int lane = lane_; asm volatile("" : "+v"(lane));
    const int r32 = lane & 31, hi = lane >> 5;
    bf16x8 qf[2][4];
#pragma unroll
    for (int qb = 0; qb < 2; ++qb)
#pragma unroll
        for (int kk = 0; kk < 4; ++kk) qf[qb][kk] = *(const bf16x8*)(Qp + qb * 2048 + kk * 512 + lane * 8);
    f32x16 o[2][2];
#pragma unroll
    for (int a = 0; a < 2; ++a)
#pragma unroll
        for (int b = 0; b < 2; ++b)
#pragma unroll
            for (int i = 0; i < 16; ++i) o[a][b][i] = 0.f;
    float mrun[2] = {-1e30f, -1e30f}, lrun[2] = {0.f, 0.f};
    const int nt = A.nt + B.nt;
    bf16x8 kf[4], vf[2][2], kn[4];
    ld_k(A, B, 0, lane, kf);
    for (int t = 0; t < nt; ++t) {
        const int tn = (t + 1 < nt) ? t + 1 : t;
        ld_v(A, B, t, lane, vf);
        ld_k(A, B, tn, lane, kn);
#pragma unroll
        for (int qb = 0; qb < 2; ++qb) {
            f32x16 s;
#pragma unroll
            for (int i = 0; i < 16; ++i) s[i] = 0.f;
#pragma unroll
            for (int kk = 0; kk < 4; ++kk) s = MFMA32(kf[kk], qf[qb][kk], s);
            if (NA) {
                if (t < A.nt) {
                    const int a = t >> 1, half = t & 1;
                    const float* bp = rpbh + (rs + a - r + 7) * 31;
                    const int qc = 32 * qb + r32; const int cs = min(max(qc - 8, 0), 48);
#pragma unroll
                    for (int i = 0; i < 16; ++i) {
                        const int kc = 32 * half + crow(i, hi);
                        const bool valid = (kc >= cs) && (kc < cs + 16);
                        const int co = min(max(kc - qc + 15, 0), 30);
                        const float bia = bp[co] * LOG2E;
                        s[i] = valid ? s[i] + bia : -1e30f;
                    }
                }
            }
            float mx = s[0];
#pragma unroll
            for (int i = 1; i < 16; ++i) mx = fmaxf(mx, s[i]);
            mx = fmaxf(mx, __shfl_xor(mx, 32));
            const float mn = fmaxf(mrun[qb], mx);
            const float alpha = __builtin_amdgcn_exp2f(mrun[qb] - mn);
            mrun[qb] = mn;
            float ps = 0.f;
#pragma unroll
            for (int i = 0; i < 16; ++i) { const float p = __builtin_amdgcn_exp2f(s[i] - mn); s[i] = p; ps += p; }
            lrun[qb] = lrun[qb] * alpha + ps;
#pragma unroll
            for (int i = 0; i < 16; ++i) { o[qb][0][i] *= alpha; o[qb][1][i] *= alpha; }
            u32x4 p0, p1;
            p0.x = pk2(s[0], s[1]); p0.y = pk2(s[2], s[3]); p0.z = pk2(s[4], s[5]); p0.w = pk2(s[6], s[7]);
            p1.x = pk2(s[8], s[9]); p1.y = pk2(s[10], s[11]); p1.z = pk2(s[12], s[13]); p1.w = pk2(s[14], s[15]);
            const bf16x8 P0 = __builtin_bit_cast(bf16x8, p0), P1 = __builtin_bit_cast(bf16x8, p1);
#pragma unroll
            for (int db = 0; db < 2; ++db) { o[qb][db] = MFMA32(vf[db][0], P0, o[qb][db]); o[qb][db] = MFMA32(vf[db][1], P1, o[qb][db]); }
        }
#pragma unroll
        for (int kk = 0; kk < 4; ++kk) kf[kk] = kn[kk];
    }
#pragma unroll
    for (int qb = 0; qb < 2; ++qb) {
        const float lt = lrun[qb] + __shfl_xor(lrun[qb], 32);
        const float inv = 1.f / lt;
        bf16_t* orow = Op + (size_t)(32 * qb + r32) * D;
#pragma unroll
        for (int db = 0; db < 2; ++db)
#pragma unroll
            for (int g = 0; g < 4; ++g) {
                u32x2 w; w.x = pk2(o[qb][db][4 * g] * inv, o[qb][db][4 * g + 1] * inv); w.y = pk2(o[qb][db][4 * g + 2] * inv, o[qb][db][4 * g + 3] * inv);
                *(u32x2*)(orow + 32 * db + 8 * g + 4 * hi) = w;
            }
    }
}

struct AttnP { const bf16_t *Q, *K, *VT, *KCA, *VCA, *KCN, *VCN; bf16_t* ATT; const float* rpb; };
DI void attn_run_unit(int uid, int l, const AttnP& P, int lane) {
    const Seg none{nullptr, nullptr, 0};
    const size_t QS = (size_t)MP * 768, KS = (size_t)MP * 512;
    if (uid < 1536) {
        const int qc = uid & 31, bh = uid >> 5, b = bh / 6, h = bh - 6 * b, kvh = h / 3;
        const int row0 = MP + b * 2048;
        Seg A{P.K + KS + (size_t)(b * 8 + kvh) * 64 * 2048, P.VT + KS + (size_t)(b * 8 + kvh) * 64 * 2048, 64};
        Seg B{P.KCA + (size_t)((b * 4 + l) * 2 + kvh) * 16384, P.VCA + (size_t)((b * 4 + l) * 2 + kvh) * 16384, 8};
        attn_wave<false>(P.Q + QS + ((size_t)(b * 12 + h) * 64 + 2 * qc) * 2048, A, B, P.ATT + (size_t)(row0 + qc * 64) * D + 256 + h * 64, nullptr, 0, 0, lane);
    } else if (uid < 3072) {
        const int u = uid - 1536, r = u & 31, bh = u >> 5, b = bh / 6, h = bh - 6 * b;
        const int row0 = MP + b * 2048, rs = min(max(r - 4, 0), 24);
        Seg A{P.K + KS + ((size_t)(b * 8 + 2 + h) * 64 + 2 * rs) * 2048, P.VT + KS + ((size_t)(b * 8 + 2 + h) * 64 + 2 * rs) * 2048, 16};
        Seg B{P.KCN + (size_t)((b * 4 + l) * 6 + h) * 16384, P.VCN + (size_t)((b * 4 + l) * 6 + h) * 16384, 8};
        attn_wave<true>(P.Q + QS + ((size_t)(b * 12 + 6 + h) * 64 + 2 * r) * 2048, A, B, P.ATT + (size_t)(row0 + r * 64) * D + 640 + h * 64, P.rpb + (size_t)(l * 6 + h) * 15 * 31, r, rs, lane);
    } else if (uid < 3840) {
        const int u = uid - 3072, qc = u & 3, bh = u >> 2, b = bh / 6, h = bh - 6 * b, kvh = h / 3;
        const int row0 = b * 256;
        Seg A{P.K + (size_t)(b * 8 + kvh) * 8 * 2048, P.VT + (size_t)(b * 8 + kvh) * 8 * 2048, 8};
        attn_wave<false>(P.Q + ((size_t)(b * 12 + h) * 8 + 2 * qc) * 2048, A, none, P.ATT + (size_t)(row0 + qc * 64) * D + 256 + h * 64, nullptr, 0, 0, lane);
    } else {
        const int u = uid - 3840, qc = u & 3, bh = u >> 2, b = bh / 6, h = bh - 6 * b;
        const int row0 = b * 256;
        Seg A{P.K + (size_t)(b * 8 + 2 + h) * 8 * 2048, P.VT + (size_t)(b * 8 + 2 + h) * 8 * 2048, 8};
        attn_wave<false>(P.Q + ((size_t)(b * 12 + 6 + h) * 8 + 2 * qc) * 2048, A, none, P.ATT + (size_t)(row0 + qc * 64) * D + 640 + h * 64, nullptr, 0, 0, lane);
    }
}

struct Args {
    const float* in[25]; float* out; unsigned char* ws; int ph_lo, ph_hi;
};
#define XB_TMO      128
#define XB_XCNT(j)  (256  + 64 * (j))
#define XB_XSUB(j)  (1280 + 64 * (j))
#define XB_XGEN(j)  (2304 + 64 * (j))
#define XB_TOP      3328
#define XB_TOPGEN   3392
#define XCD_BAR_WORDS 3456
#define XB_SPIN_CAP (1u << 18)

__device__ __forceinline__ unsigned xb_ld(unsigned* p)              { return __hip_atomic_load(p, __ATOMIC_RELAXED, __HIP_MEMORY_SCOPE_AGENT); }
__device__ __forceinline__ unsigned xb_add(unsigned* p, unsigned v) { return __hip_atomic_fetch_add(p, v, __ATOMIC_RELAXED, __HIP_MEMORY_SCOPE_AGENT); }
__device__ __forceinline__ unsigned xb_xcc_id() { return (unsigned)__builtin_amdgcn_s_getreg((3 << 11) | 20) & 0xFu; }
#define XB_SPIN(cond, bar) do { unsigned _sp = 0; while (cond) { __builtin_amdgcn_s_sleep(1); \
    if ((++_sp & 255u) == 0u) { if (xb_ld(&(bar)[XB_TMO])) break; if (_sp > XB_SPIN_CAP) { atomicAdd(&(bar)[XB_TMO], 1u); break; } } } } while (0)

struct XcdBarrier {
    unsigned* bar; unsigned x;
    volatile LAS unsigned* st;
};

__device__ __forceinline__ XcdBarrier xcd_barrier_post(unsigned* bar, volatile LAS unsigned* st) {
    XcdBarrier b; b.bar = bar; b.x = xb_xcc_id(); b.st = st;
    if (threadIdx.x == 0) (void)xb_add(&bar[XB_XCNT(b.x)], 1u);
    return b;
}
__device__ __forceinline__ void xcd_barrier_complete(unsigned* bar, unsigned x, unsigned& nloc, unsigned& nx) {
    const unsigned G = gridDim.x * gridDim.y * gridDim.z;
    unsigned sum, cnt, mine, sp = 0u;
    for (;;) {
        sum = 0u; cnt = 0u; mine = 0u;
#pragma unroll
        for (unsigned j = 0; j < 16; ++j) { const unsigned c = xb_ld(&bar[XB_XCNT(j)]); sum += c; cnt += (c > 0u) ? 1u : 0u; mine = (j == x) ? c : mine; }
        if (sum == G) break;
        __builtin_amdgcn_s_sleep(1);
        if ((++sp & 255u) == 0u) { if (xb_ld(&bar[XB_TMO])) break; if (sp > XB_SPIN_CAP) { atomicAdd(&bar[XB_TMO], 1u); break; } }
    }
    nloc = mine > 0u ? mine : 1u; nx = cnt > 0u ? cnt : 1u;
}

__device__ __forceinline__ void xcd_barrier(const XcdBarrier& b) {
    asm volatile("s_waitcnt vmcnt(0)" ::: "memory");
    __syncthreads();
    if (threadIdx.x == 0) {
        unsigned* bar = b.bar;
        __builtin_amdgcn_s_waitcnt(0);
        unsigned nloc = b.st[0], nx = b.st[1];
        if (nloc == 0u) { xcd_barrier_complete(bar, b.x, nloc, nx); b.st[0] = nloc; b.st[1] = nx; }
        const unsigned old = xb_add(&bar[XB_XSUB(b.x)], 1u);
        const unsigned gen = old / nloc;
        if (old + 1u == (gen + 1u) * nloc) {
            __builtin_amdgcn_fence(__ATOMIC_RELEASE, "agent");
            asm volatile("s_waitcnt vmcnt(0)" ::: "memory");
            const unsigned og = xb_add(&bar[XB_TOP], 1u);
            const unsigned tg = og / nx;
            if (og + 1u == (tg + 1u) * nx) xb_add(&bar[XB_TOPGEN], 1u);
            else XB_SPIN(xb_ld(&bar[XB_TOPGEN]) == tg, bar);
            __builtin_amdgcn_fence(__ATOMIC_ACQUIRE, "agent");
            xb_add(&bar[XB_XGEN(b.x)], 1u);
            asm volatile("s_waitcnt vmcnt(0)" ::: "memory");
        } else {
            XB_SPIN(xb_ld(&bar[XB_XGEN(b.x)]) == gen, bar);
            __builtin_amdgcn_fence(__ATOMIC_ACQUIRE, "agent");
            asm volatile("s_waitcnt vmcnt(0)" ::: "memory");
        }
    }
    __syncthreads();
}

typedef const __attribute__((address_space(4))) char* kargp_t;
DI const float* ldin(int i) { kargp_t kp = (kargp_t)__builtin_amdgcn_kernarg_segment_ptr(); asm volatile("" : "+s"(kp)); return (const float*)(*(const __attribute__((address_space(4))) unsigned long long*)(kp + 8 * i)); }
DI float* ldout() { return (float*)ldin(25); }
DI unsigned char* ldws() { return (unsigned char*)ldin(26); }
DI int opq_tid() { int t = threadIdx.x; asm volatile("" : "+v"(t)); return t; }

__global__ void __launch_bounds__(512, 2) fwd_kernel(Args a) {
    extern __shared__ __attribute__((aligned(16))) unsigned char lds[];
    cg::grid_group grid = cg::this_grid();
    const int G = gridDim.x, bx = blockIdx.x, NGW = G * 8;
    const int lo = a.ph_lo, hi = a.ph_hi;
#define IN(k) (lo <= (k) && (k) < hi)
    volatile LAS unsigned* MISC = (volatile LAS unsigned*)((LAS unsigned char*)lds + 131072);
    if (threadIdx.x < 16) MISC[threadIdx.x] = 0u;
    __syncthreads();
    XcdBarrier xbar; xbar.bar = (unsigned*)ldws(); xbar.x = 0; xbar.st = nullptr;
    if (hi - lo > 1) xbar = xcd_barrier_post((unsigned*)ldws(), MISC + 8);
    if (hi < 0) grid.sync();
#define SEAM(k) do { if (IN(k) && (k) + 1 < hi) xcd_barrier(xbar); } while (0)
#define WSP(T, off) ((T*)(ws + (off)))

    for (int sx_ = 0; sx_ < SYNCX; ++sx_) xcd_barrier(xbar);
    if (IN(0)) for (int rep_ = 0; rep_ < REP_P; ++rep_) {
        if (rep_) xcd_barrier(xbar);
        const int tid = opq_tid(), lane = tid & 63, wave = __builtin_amdgcn_readfirstlane(tid >> 6), gw = bx * 8 + wave;
        unsigned char* ws = ldws();
        {
            const float *cvec = ldin(6), *c_ctx = ldin(7), *ada_w = ldin(8), *ada_b = ldin(9);
            float* mod = WSP(float, WS_MOD);
            for (int u = bx; u < DEPTH * 96; u += G) {
                const int l = u / 96, nb = u - l * 96;
                gemv9_unit(ada_w + (size_t)l * D * 6144, 6144, nb * 64, c_ctx, cvec, D, true, ada_b + l * 6144, mod + (size_t)l * NMOD * 6144, 6144, (float*)lds, tid);
            }
        }
        {
            const float *w_in = ldin(12), *w_out = ldin(22), *w1 = ldin(23), *w2 = ldin(24);
            bf16_t *WIN = WSP(bf16_t, WS_WIN), *WOUT = WSP(bf16_t, WS_WOUT), *W1T = WSP(bf16_t, WS_W1), *W2T = WSP(bf16_t, WS_W2);
            LAS float* scr = (LAS float*)((LAS unsigned char*)lds + wave * 16384);
            constexpr int I_IN = 16 * 72, I_OUT = 16 * 32, I_1 = 16 * 128, I_2 = 64 * 32, I_L = I_IN + I_OUT + I_1 + I_2;
            for (int it = gw; it < DEPTH * I_L; it += NGW) {
                const int l = it / I_L; int r = it - l * I_L;
                if (r < I_IN) { transpose_item(w_in + (size_t)l * D * INW, D, INW, WIN + (size_t)l * INW * D, scr, r, lane); continue; } r -= I_IN;
                if (r < I_OUT) { transpose_item(w_out + (size_t)l * D * D, D, D, WOUT + (size_t)l * D * D, scr, r, lane); continue; } r -= I_OUT;
                if (r < I_1) { transpose_item(w1 + (size_t)l * D * FF, D, FF, W1T + (size_t)l * FF * D, scr, r, lane); continue; } r -= I_1;
                transpose_item(w2 + (size_t)l * FF * D, FF, D, W2T + (size_t)l * D * FF, scr, r, lane);
            }
        }
        {
            const float *cache_ak = ldin(2), *cache_av = ldin(3), *cache_nk = ldin(4), *cache_nv = ldin(5);
            bf16_t *KCA = WSP(bf16_t, WS_KCA), *VCA = WSP(bf16_t, WS_VCA), *KCN = WSP(bf16_t, WS_KCN), *VCN = WSP(bf16_t, WS_VCN);
            const int gt = bx * 512 + tid, NGT = G * 512;
            for (int e = gt; e < 8 * 4 * 256 * 8 * 8; e += NGT) {
                const int c8 = e & 7, hh = (e >> 3) & 7, key = (e >> 6) & 255, bl = e >> 14;
                const float* src; bf16_t* dst;
                if (hh < 2) { src = cache_ak + (((size_t)bl * 256 + key) * 2 + hh) * 64 + 8 * c8; dst = KCA + (((size_t)bl * 2 + hh) * 8 + (key >> 5)) * 2048 + (c8 * 32 + (key & 31)) * 8; }
                else { src = cache_nk + (((size_t)bl * 256 + key) * 6 + (hh - 2)) * 64 + 8 * c8; dst = KCN + (((size_t)bl * 6 + (hh - 2)) * 8 + (key >> 5)) * 2048 + (c8 * 32 + (key & 31)) * 8; }
                const f32x4 v0 = *(const f32x4*)src, v1 = *(const f32x4*)(src + 4);
                u32x4 o; o.x = pk2(v0.x, v0.y); o.y = pk2(v0.z, v0.w); o.z = pk2(v1.x, v1.y); o.w = pk2(v1.z, v1.w);
                *(u32x4*)dst = o;
            }
            for (int e = gt; e < 8 * 4 * 8 * 32 * 64; e += NGT) {
                const int d = e & 63, g = (e >> 6) & 31, hh = (e >> 11) & 7, bl = e >> 14;
                unsigned short q[8];
#pragma unroll
                for (int jj = 0; jj < 8; ++jj) {
                    const int p = 8 * g + jj, key = (p & ~31) + permkey(p & 31);
                    const float v = (hh < 2) ? cache_av[(((size_t)bl * 256 + key) * 2 + hh) * 64 + d] : cache_nv[(((size_t)bl * 256 + key) * 6 + (hh - 2)) * 64 + d];
                    q[jj] = (unsigned short)(pk2(v, 0.f) & 0xffffu);
                }
                u32x4 o; o.x = q[0] | ((unsigned)q[1] << 16); o.y = q[2] | ((unsigned)q[3] << 16); o.z = q[4] | ((unsigned)q[5] << 16); o.w = q[6] | ((unsigned)q[7] << 16);
                const int voff = (g >> 2) * 2048 + ((((d >> 5) * 2 + ((g >> 1) & 1)) * 2 + (g & 1)) * 32 + (d & 31)) * 8;
                bf16_t* dst = (hh < 2) ? VCA + ((size_t)bl * 2 + hh) * 16384 + voff : VCN + ((size_t)bl * 6 + (hh - 2)) * 16384 + voff;
                *(u32x4*)dst = o;
            }
        }
    }
    SEAM(0);
    if (IN(1)) for (int rep_ = 0; rep_ < REP_P; ++rep_) {
        if (rep_) xcd_barrier(xbar);
        const int tid = opq_tid(), lane = tid & 63, wave = __builtin_amdgcn_readfirstlane(tid >> 6), gw = bx * 8 + wave;
        unsigned char* ws = ldws();
        float* mod = WSP(float, WS_MOD);
        {
            const float *w_in = ldin(12), *w1 = ldin(23);
            float *bias1 = WSP(float, WS_BIAS1), *bias2 = WSP(float, WS_BIAS2);
            for (int u = bx; u < DEPTH * 100; u += G) {
                const int l = u / 100; int r = u - l * 100;
                const float* ml = mod + (size_t)l * NMOD * 6144;
                if (r < 36) gemv9_unit(w_in + (size_t)l * D * INW, INW, r * 64, ml, ml + 6144, 6144, false, nullptr, bias1 + (size_t)l * NMOD * INW, INW, (float*)lds, tid);
                else { r -= 36; gemv9_unit(w1 + (size_t)l * D * FF, FF, r * 64, ml + 3072, ml + 6144 + 3072, 6144, false, nullptr, bias2 + (size_t)l * NMOD * FF, FF, (float*)lds, tid); }
            }
        }
        {
            const float *x_prompt = ldin(0), *x_sample = ldin(1), *norm1_g = ldin(10);
            bf16_t* XG = WSP(bf16_t, WS_XG); float* ssq = WSP(float, WS_SSQ);
            for (int row = gw; row < M; row += NGW) {
                const float* xr = (row < MP) ? x_prompt + (size_t)row * D : x_sample + (size_t)(row - MP) * D;
                const float* scp = mod + (size_t)modidx(row) * 6144 + 1024;
                float s = 0.f;
#pragma unroll
                for (int j = 0; j < 4; ++j) {
                    const int c = 256 * j + 4 * lane;
                    const f32x4 v = *(const f32x4*)(xr + c);
                    s += (v.x * v.x + v.y * v.y) + (v.z * v.z + v.w * v.w);
                    const f32x4 y = v * (*(const f32x4*)(norm1_g + c)) * (*(const f32x4*)(scp + c) + 1.0f);
                    u32x2 w; w.x = pk2(y.x, y.y); w.y = pk2(y.z, y.w);
                    *(u32x2*)(XG + (size_t)row * D + c) = w;
                }
                s = wave_sum(s);
                if (lane < 16) ssq[(size_t)row * 16 + lane] = (lane == 0) ? s : 0.f;
            }
        }
    }
    SEAM(1);
#pragma nounroll
    for (int l_ = 0; l_ < DEPTH; ++l_) {
        int l = l_; asm volatile("" : "+s"(l));
        const int p0 = 2 + 6 * l;
        if (IN(p0)) for (int rep_ = 0; rep_ < REP_G1; ++rep_) {
            unsigned char* ws = ldws();
            pg8::Gemm g{WSP(bf16_t, WS_XG), WSP(bf16_t, WS_WIN) + (size_t)l * INW * D, M, INW, D}; pg8::StaticOrder S; S.init(M, INW, G, bx);
            EpiLin<0> E{WSP(bf16_t, WS_RAW), INW, WSP(float, WS_BIAS1) + (size_t)l * NMOD * INW, INW, WSP(float, WS_SSQ)};
            pg8::gemm_phase<EpiLin<0>, pg8::StaticOrder, true, true>((LAS unsigned char*)lds, g, S, E);
        }
        SEAM(p0);
        if (IN(p0 + 1)) for (int rep_ = 0; rep_ < REP_PREP; ++rep_) {
            const int tid = opq_tid();
            unsigned char* ws = ldws();
            for (int u = bx; u < 768; u += G) {
                if (u < 384) conv_unit(u, l, WSP(bf16_t, WS_RAW), WSP(bf16_t, WS_ATT), ldin(13), ldin(14), ldin(15), ldin(16), (float*)lds, tid);
                else { PrepP P{WSP(bf16_t, WS_RAW), WSP(bf16_t, WS_Q), WSP(bf16_t, WS_K), WSP(bf16_t, WS_VT), ldout(), ldin(17), ldin(18), ldin(19), ldin(20)}; qkv_unit(u - 384, l, P, (bf16_t*)lds, tid); }
            }
        }
        SEAM(p0 + 1);
        if (IN(p0 + 2)) for (int rep_ = 0; rep_ < REP_ATTN; ++rep_) {
            const int tid = opq_tid(), lane = tid & 63, wave = __builtin_amdgcn_readfirstlane(tid >> 6), gw = bx * 8 + wave;
            unsigned char* ws = ldws();
            AttnP P{WSP(bf16_t, WS_Q), WSP(bf16_t, WS_K), WSP(bf16_t, WS_VT), WSP(bf16_t, WS_KCA), WSP(bf16_t, WS_VCA), WSP(bf16_t, WS_KCN), WSP(bf16_t, WS_VCN), WSP(bf16_t, WS_ATT), ldin(21)};
            const bool bal = (NGW == 2048);
            const int nu = bal ? (gw < 1536 ? 2 : 3) : (4608 - gw + NGW - 1) / NGW;
            for (int k = 0; k < nu; ++k) {
                const int uid = bal ? (gw < 1536 ? (k == 0 ? gw : 3072 + gw) : 1536 + 3 * (gw - 1536) + k) : gw + k * NGW;
                attn_run_unit(uid, l, P, lane);
            }
        }
        SEAM(p0 + 2);
        if (IN(p0 + 3)) {
            unsigned char* ws = ldws(); float* X = ldout();
            const float* ml = WSP(float, WS_MOD) + (size_t)l * NMOD * 6144;
            pg8::Gemm g{WSP(bf16_t, WS_ATT), WSP(bf16_t, WS_WOUT) + (size_t)l * D * D, M, D, D}; pg8::StaticOrder S; S.init(M, D, G, bx);
            EpiRes E{l == 0 ? ldin(0) : X, l == 0 ? ldin(1) : X + (size_t)MP * D, X, ml + 2048, ldin(11) + l * D, ml + 4096, WSP(bf16_t, WS_XG), WSP(float, WS_SSQ), 1};
            pg8::gemm_phase<EpiRes, pg8::StaticOrder, true, true>((LAS unsigned char*)lds, g, S, E);
            SEAM(p0 + 3);
        }
        if (IN(p0 + 4)) for (int rep_ = 0; rep_ < REP_G3; ++rep_) {
            unsigned char* ws = ldws();
            pg8::Gemm g{WSP(bf16_t, WS_XG), WSP(bf16_t, WS_W1) + (size_t)l * FF * D, M, FF, D}; pg8::StaticOrder S; S.init(M, FF, G, bx);
            EpiLin<1> E{WSP(bf16_t, WS_H1), FF, WSP(float, WS_BIAS2) + (size_t)l * NMOD * FF, FF, WSP(float, WS_SSQ)};
            pg8::gemm_phase<EpiLin<1>, pg8::StaticOrder, true, true>((LAS unsigned char*)lds, g, S, E);
        }
        SEAM(p0 + 4);
        if (IN(p0 + 5)) {
            unsigned char* ws = ldws(); float* X = ldout();
            const float* ml = WSP(float, WS_MOD) + (size_t)l * NMOD * 6144;
            pg8::Gemm g{WSP(bf16_t, WS_H1), WSP(bf16_t, WS_W2) + (size_t)l * D * FF, M, D, FF}; pg8::StaticOrder S; S.init(M, D, G, bx);
            const int nx = (l + 1 < DEPTH) ? 1 : 0; const int ln = nx ? l + 1 : l;
            EpiRes E{X, X + (size_t)MP * D, X, ml + 5120, ldin(10) + ln * D, WSP(float, WS_MOD) + (size_t)ln * NMOD * 6144 + 1024, WSP(bf16_t, WS_XG), WSP(float, WS_SSQ), nx};
            pg8::gemm_phase<EpiRes, pg8::StaticOrder, true, true>((LAS unsigned char*)lds, g, S, E);
            SEAM(p0 + 5);
        }
    }
#undef IN
#undef SEAM
#undef WSP
}

extern "C" void kernel_launch(void* const* d_in, const int* in_sizes, int n_in, void* d_out, int out_size, void* d_ws, size_t ws_size, hipStream_t stream) {
    static int grid = 0;
    if (grid == 0) {
        if (n_in != 25 || ws_size < WS_END) { fprintf(stderr, "kernel_launch: need 25 inputs and >= %zu bytes of workspace; got %d, %zu\n", (size_t)WS_END, n_in, ws_size); grid = -1; return; }
        int dev = 0, cus = 0, per_cu = 0;
        hipGetDevice(&dev);
        hipDeviceGetAttribute(&cus, hipDeviceAttributeMultiprocessorCount, dev);
        if (hipFuncSetAttribute((const void*)fwd_kernel, hipFuncAttributeMaxDynamicSharedMemorySize, LDS_BYTES) != hipSuccess) { fprintf(stderr, "kernel_launch: hipFuncSetAttribute failed\n"); grid = -1; return; }
        if (hipOccupancyMaxActiveBlocksPerMultiprocessor(&per_cu, (const void*)fwd_kernel, 512, LDS_BYTES) != hipSuccess || per_cu < 1) { fprintf(stderr, "kernel_launch: occupancy query says %d\n", per_cu); per_cu = 1; }
        (void)hipGetLastError();
        grid = cus * per_cu;
    }
    if (grid < 0) return;
    if (hipMemsetAsync(d_ws, 0, 16384, stream) != hipSuccess) { fprintf(stderr, "kernel_launch: memset failed\n"); return; }
    Args a{};
    for (int i = 0; i < 25; ++i) a.in[i] = (const float*)d_in[i];
    a.out = (float*)d_out; a.ws = (unsigned char*)d_ws;
#if MK_SINGLE
    a.ph_lo = 0; a.ph_hi = NPH;
    void* args[] = {&a};
    hipError_t e = hipLaunchCooperativeKernel((const void*)fwd_kernel, dim3(grid), dim3(512), args, LDS_BYTES, stream);
    if (e != hipSuccess) fprintf(stderr, "cooperative launch failed: %s (grid %d)\n", hipGetErrorString(e), grid);
#else
    for (int ph = 0; ph < NPH; ++ph) {
        a.ph_lo = ph; a.ph_hi = ph + 1;
        hipLaunchKernelGGL(fwd_kernel, dim3(grid), dim3(512), LDS_BYTES, stream, a);
    }
#endif
}
```

```cpp
#include <hip/hip_runtime.h>
#include <hip/hip_cooperative_groups.h>
#include <cstdio>
#include <cstdint>
namespace cg = cooperative_groups;
namespace pg8 {
#define PG8_LAS __attribute__((address_space(3)))
typedef unsigned short bf16_t;
typedef short bf16x8 __attribute__((ext_vector_type(8)));
typedef float f32x4 __attribute__((ext_vector_type(4)));
typedef unsigned u32x4 __attribute__((ext_vector_type(4)));
constexpr int BM = 256, BK = 64, HALF = 128, HTB = HALF * BK * 2  , STAGE_BYTES = 8 * HTB, NXCD = 8, WGM = 8;

__host__ __device__ __forceinline__ int lds_byte(int r, int c) { const int st = (r >> 4) * 2 + (c >> 5), rr = r & 15, cc = c & 31, ob = rr * 64 + cc * 2; return st * 1024 + (ob ^ (((ob >> 9) & 1) << 5)); }
__host__ __device__ __forceinline__ void stage_rc(int b, int& R, int& C) { const int st = b / 1024, sb = b % 1024, swz = sb ^ (((sb >> 9) & 1) << 5); R = (st >> 1) * 16 + swz / 64; C = (st & 1) * 32 + (swz % 64) / 2; }
__host__ __device__ __forceinline__ int perm32(int rho) { const int n = rho >> 4, i = rho & 15; return 8 * (i >> 2) + 4 * n + (i & 3); }

struct Unit { int pm, pn; };
struct Gemm { const bf16_t* A; const bf16_t* Bt; int M, N, K; };

struct StaticOrder {
    int nM, nN, nwg, G, c;
    __host__ __device__ void init(int M, int N, int G_, int c_) { nM = M / BM; nN = N / BM; nwg = nM * nN; G = G_; c = c_; }
    __host__ __device__ bool next(int i, Unit& u) const {
        const long L = (long)i * G + c; if (L >= nwg) return false;
        int wgid = (int)L; { const int q = nwg / NXCD, r = nwg % NXCD, xcd = wgid % NXCD, off = wgid / NXCD; wgid = (xcd < r ? xcd * (q + 1) : r * (q + 1) + (xcd - r) * q) + off; }
        const int nig = WGM * nN, gid = wgid / nig, fm = gid * WGM, gsz = (nM - fm) < WGM ? (nM - fm) : WGM;
        u.pm = fm + ((wgid % nig) % gsz); u.pn = (wgid % nig) / gsz; return true;
    }
    __device__ __forceinline__ void a_ready(const Unit&) const {}
    __device__ __forceinline__ void done(const Unit&) const {}
};
__device__ __forceinline__ unsigned cvt_pk_bf16(float lo, float hi) { unsigned r; asm volatile("v_cvt_pk_bf16_f32 %0, %1, %2" : "=v"(r) : "v"(lo), "v"(hi)); return r; }
template <class Epi, class Sched, bool ALIGN_EPI = false, bool SP2 = false>
__device__ __forceinline__ void gemm_phase(PG8_LAS unsigned char* lds, const Gemm g, const Sched& S, const Epi& E) {
    int tid_ = threadIdx.x; asm volatile("" : "+v"(tid_));
    const int tid = tid_, wid = __builtin_amdgcn_readfirstlane(tid >> 6), lane = tid & 63, wr = wid >> 2, wc = wid & 3, fr = lane & 15, fq = lane >> 4;
    const int K = g.K, nt = K / BK;
    unsigned voffA[2], voffB[2];
#pragma unroll
    for (int i = 0; i < 2; ++i) { int R, C; stage_rc(tid * 16 + i * 8192, R, C); const int Rb = Epi::PERM ? ((R & ~31) + perm32(R & 31)) : R;
        voffA[i] = (unsigned)(R * K + C) * 2u; voffB[i] = (unsigned)(Rb * K + C) * 2u; }
    const size_t kstep = (size_t)(BK * 2);
    const size_t hstep = (size_t)HALF * K * 2;
    const size_t tstep = 2 * hstep;
    const unsigned ldsw = (unsigned)wid * 1024u;
    const int aoff = lds_byte(wr * 64 + fr, fq * 8), boff = lds_byte(wc * 32 + fr, fq * 8);
#define PG8_SA(b, h) (((b) * 2 + (h)) * HTB)
#define PG8_SB(b, h) ((4 + (b) * 2 + (h)) * HTB)
#define PG8_STAGE(bufoff, gbase, voff) do { _Pragma("unroll") for (int _i = 0; _i < 2; ++_i) \
        __builtin_amdgcn_global_load_lds((const unsigned*)((const char*)(gbase) + (voff)[_i]), (PG8_LAS unsigned*)(lds + (bufoff) + ldsw + _i * 8192), 16, 0, 0); } while (0)
#define PG8_LDA(dst, b, h) do { _Pragma("unroll") for (int m = 0; m < 4; ++m) _Pragma("unroll") for (int k = 0; k < 2; ++k) dst[m][k] = *(const PG8_LAS bf16x8*)(lds + PG8_SA(b, h) + aoff + m * 2048 + k * 1024); } while (0)
#define PG8_LDB(dst, b, h) do { _Pragma("unroll") for (int n = 0; n < 2; ++n) _Pragma("unroll") for (int k = 0; k < 2; ++k) dst[n][k] = *(const PG8_LAS bf16x8*)(lds + PG8_SB(b, h) + boff + n * 2048 + k * 1024); } while (0)
#define PG8_MMA(ai, bj, At, Bt) do { __builtin_amdgcn_s_setprio(1); _Pragma("unroll") for (int m = 0; m < 4; ++m) _Pragma("unroll") for (int n = 0; n < 2; ++n) _Pragma("unroll") for (int k = 0; k < 2; ++k) \
        acc[ai][bj][m][n] = __builtin_amdgcn_mfma_f32_16x16x32_bf16(Bt[n][k], At[m][k], acc[ai][bj][m][n], 0, 0, 0); __builtin_amdgcn_s_setprio(0); } while (0)
#define PG8_WAIT_V(n) asm volatile("s_waitcnt vmcnt(" #n ")" ::: "memory")
#define PG8_WAIT_L(n) asm volatile("s_waitcnt lgkmcnt(" #n ")" ::: "memory")
#define PG8_BAR __builtin_amdgcn_s_barrier()
#define PG8_SCHED __builtin_amdgcn_sched_barrier(0)
    Unit cur, nxt; int ui = 0;
    if (!S.next(0, cur)) return;
    f32x4 acc[2][2][4][2];
#pragma unroll
    for (int a = 0; a < 2; ++a)
#pragma unroll
        for (int b = 0; b < 2; ++b)
#pragma unroll
            for (int m = 0; m < 4; ++m)
#pragma unroll
                for (int n = 0; n < 2; ++n) acc[a][b][m][n] = (f32x4){0.f, 0.f, 0.f, 0.f};
    bf16x8 At[4][2], B0[2][2], B1[2][2];
    const char* cA = (const char*)g.A + (size_t)cur.pm * tstep; const char* cB = (const char*)g.Bt + (size_t)cur.pn * tstep;
    S.a_ready(cur);
    if constexpr (SP2) {
        PG8_STAGE(PG8_SB(0, 0), cB, voffB); PG8_STAGE(PG8_SB(0, 1), cB + hstep, voffB); PG8_STAGE(PG8_SA(0, 0), cA, voffA); PG8_STAGE(PG8_SA(0, 1), cA + hstep, voffA);
        if (wr == 1) PG8_BAR;
        PG8_WAIT_V(2); PG8_BAR;
        PG8_STAGE(PG8_SB(1, 0), cB + kstep, voffB); PG8_STAGE(PG8_SA(1, 0), cA + kstep, voffA); PG8_STAGE(PG8_SB(1, 1), cB + hstep + kstep, voffB);
        PG8_WAIT_V(6); PG8_BAR;
    } else {
        PG8_STAGE(PG8_SB(0, 0), cB, voffB); PG8_STAGE(PG8_SA(0, 0), cA, voffA); PG8_STAGE(PG8_SB(0, 1), cB + hstep, voffB); PG8_STAGE(PG8_SA(0, 1), cA + hstep, voffA);
        if (wr == 1) PG8_BAR;
        PG8_WAIT_V(4); PG8_BAR;
        PG8_STAGE(PG8_SB(1, 0), cB + kstep, voffB); PG8_STAGE(PG8_SA(1, 0), cA + kstep, voffA); PG8_STAGE(PG8_SB(1, 1), cB + hstep + kstep, voffB);
        PG8_WAIT_V(6); PG8_BAR;
    }
    for (;;) {
        const bool has_next = S.next(ui + 1, nxt);
        const char* nA = has_next ? (const char*)g.A + (size_t)nxt.pm * tstep : cA; const char* nB = has_next ? (const char*)g.Bt + (size_t)nxt.pn * tstep : cB;
        for (int t = 0; t < nt; t += 2) {
            const bool last = (t == nt - 2);
            const char* a1 = cA + (size_t)(t + 1) * kstep;
            const char* a2 = last ? nA : cA + (size_t)(t + 2) * kstep; const char* b2 = last ? nB : cB + (size_t)(t + 2) * kstep;
            const char* a3 = a2 + kstep; const char* b3 = b2 + kstep;
            if (last && has_next) S.a_ready(nxt);
            if constexpr (SP2) {
            PG8_LDB(B0, 0, 0); PG8_LDB(B1, 0, 1); PG8_SCHED; PG8_LDA(At, 0, 0); PG8_STAGE(PG8_SA(1, 1), a1 + hstep, voffA);
            PG8_WAIT_V(8); PG8_WAIT_L(0); PG8_BAR; PG8_MMA(0, 0, At, B0); PG8_MMA(0, 1, At, B1); PG8_BAR; PG8_SCHED;
            PG8_LDA(At, 0, 1); PG8_STAGE(PG8_SB(0, 0), b2, voffB); PG8_STAGE(PG8_SB(0, 1), b2 + hstep, voffB); PG8_STAGE(PG8_SA(0, 0), a2, voffA);
            PG8_WAIT_V(8); PG8_WAIT_L(0); PG8_BAR; PG8_MMA(1, 0, At, B0); PG8_MMA(1, 1, At, B1); PG8_BAR; PG8_SCHED;
            PG8_LDB(B0, 1, 0); PG8_LDB(B1, 1, 1); PG8_SCHED; PG8_LDA(At, 1, 0); PG8_STAGE(PG8_SA(0, 1), a2 + hstep, voffA);
            PG8_WAIT_V(8); PG8_WAIT_L(0); PG8_BAR; PG8_MMA(0, 0, At, B0); PG8_MMA(0, 1, At, B1); PG8_BAR; PG8_SCHED;
            PG8_LDA(At, 1, 1); PG8_STAGE(PG8_SB(1, 0), b3, voffB); PG8_STAGE(PG8_SB(1, 1), b3 + hstep, voffB); PG8_STAGE(PG8_SA(1, 0), a3, voffA);
            PG8_WAIT_V(8); PG8_WAIT_L(0); PG8_BAR; PG8_MMA(1, 0, At, B0); PG8_MMA(1, 1, At, B1); PG8_BAR; PG8_SCHED;
            } else {
            PG8_LDB(B0, 0, 0); PG8_SCHED; PG8_LDA(At, 0, 0); PG8_STAGE(PG8_SA(1, 1), a1 + hstep, voffA);
            PG8_WAIT_L(8); PG8_BAR; PG8_WAIT_L(0); PG8_MMA(0, 0, At, B0); PG8_BAR; PG8_SCHED;
            PG8_LDB(B1, 0, 1); PG8_STAGE(PG8_SB(0, 0), b2, voffB);
            PG8_BAR; PG8_WAIT_L(0); PG8_MMA(0, 1, At, B1); PG8_BAR;
            PG8_LDA(At, 0, 1); PG8_STAGE(PG8_SA(0, 0), a2, voffA);
            PG8_BAR; PG8_WAIT_L(0); PG8_MMA(1, 0, At, B0); PG8_BAR; PG8_SCHED;
            PG8_STAGE(PG8_SB(0, 1), b2 + hstep, voffB);
            PG8_WAIT_V(6); PG8_BAR; PG8_MMA(1, 1, At, B1); PG8_BAR;
            PG8_LDB(B0, 1, 0); PG8_SCHED; PG8_LDA(At, 1, 0); PG8_STAGE(PG8_SA(0, 1), a2 + hstep, voffA);
            PG8_WAIT_L(8); PG8_BAR; PG8_WAIT_L(0); PG8_MMA(0, 0, At, B0); PG8_BAR; PG8_SCHED;
            PG8_LDB(B1, 1, 1); PG8_STAGE(PG8_SB(1, 0), b3, voffB);
            PG8_BAR; PG8_WAIT_L(0); PG8_MMA(0, 1, At, B1); PG8_BAR;
            PG8_LDA(At, 1, 1); PG8_STAGE(PG8_SA(1, 0), a3, voffA);
            PG8_BAR; PG8_WAIT_L(0); PG8_MMA(1, 0, At, B0); PG8_BAR; PG8_SCHED;
            PG8_STAGE(PG8_SB(1, 1), b3 + hstep, voffB);
            PG8_WAIT_V(6); PG8_BAR; PG8_MMA(1, 1, At, B1); PG8_BAR;
            }
        }
        if constexpr (ALIGN_EPI) { if (wr == 0) PG8_BAR; }
        if constexpr (!Epi::AFTER_DRAIN) { E(acc, cur, wr, wc, fr, fq); S.done(cur); }
        if (!has_next) break;
#pragma unroll
        for (int a = 0; a < 2; ++a)
#pragma unroll
            for (int b = 0; b < 2; ++b)
#pragma unroll
                for (int m = 0; m < 4; ++m)
#pragma unroll
                    for (int n = 0; n < 2; ++n) acc[a][b][m][n] = (f32x4){0.f, 0.f, 0.f, 0.f};
        cur = nxt; cA = nA; cB = nB; ++ui;
        if constexpr (ALIGN_EPI) { if (wr == 1) PG8_BAR; }
    }
    PG8_WAIT_V(0);
    if constexpr (!ALIGN_EPI) { if (wr == 0) PG8_BAR; }
    PG8_BAR;
    if constexpr (Epi::AFTER_DRAIN) { E.fused(acc, cur, wr, wc, fr, fq, lds, wid, lane); S.done(cur); }
#undef PG8_SA
#undef PG8_SB
#undef PG8_STAGE
#undef PG8_LDA
#undef PG8_LDB
#undef PG8_MMA
#undef PG8_WAIT_V
#undef PG8_WAIT_L
#undef PG8_BAR
#undef PG8_SCHED
}
}

#define DI __device__ __forceinline__
#define LAS __attribute__((address_space(3)))
typedef unsigned short bf16_t;
typedef short bf16x8 __attribute__((ext_vector_type(8)));
typedef float f32x4 __attribute__((ext_vector_type(4)));
typedef float f32x16 __attribute__((ext_vector_type(16)));
typedef unsigned u32x4 __attribute__((ext_vector_type(4)));
typedef unsigned u32x2 __attribute__((ext_vector_type(2)));
typedef float f32x2_t __attribute__((ext_vector_type(2)));
typedef __bf16 bf16x2_t __attribute__((ext_vector_type(2)));

#ifndef REP_P
#define REP_P 1
#endif
#ifndef REP_G1
#define REP_G1 1
#endif
#ifndef REP_PREP
#define REP_PREP 1
#endif
#ifndef REP_ATTN
#define REP_ATTN 1
#endif
#ifndef REP_G3
#define REP_G3 1
#endif
#ifndef SYNCX
#define SYNCX 0
#endif
#ifndef MK_SINGLE
#define MK_SINGLE 1
#endif

constexpr int D = 1024, MP = 8192, MS = 16384, M = MP + MS, DEPTH = 4, NMOD = 9, INW = 2304, FF = 4096;
constexpr int NPH = 2 + 6 * DEPTH;
constexpr float QSCALE = 0.125f * 1.4426950408889634f, LOG2E = 1.4426950408889634f, EPS = 1e-6f;
constexpr size_t OFF_AK = 25165824, OFF_AV = 29360128, OFF_NK = 33554432, OFF_NV = 46137344;
constexpr size_t MiB = 1u << 20;
constexpr size_t WS_MOD = 1 * MiB, WS_BIAS1 = 2 * MiB, WS_BIAS2 = 3 * MiB, WS_SSQ = 4 * MiB;
constexpr size_t WS_KCA = 6 * MiB, WS_VCA = 8 * MiB, WS_KCN = 10 * MiB, WS_VCN = 16 * MiB;
constexpr size_t WS_WIN = 22 * MiB, WS_WOUT = 40 * MiB, WS_W1 = 48 * MiB, WS_W2 = 80 * MiB;
constexpr size_t WS_XG = 112 * MiB, WS_H1 = 160 * MiB, WS_RAW = 160 * MiB, WS_Q = 268 * MiB, WS_K = 304 * MiB, WS_VT = 328 * MiB, WS_ATT = 352 * MiB, WS_END = 400 * MiB;
constexpr int LDS_BYTES = 147456;

DI unsigned pk2(float lo, float hi) { f32x2_t v = {lo, hi}; bf16x2_t b = __builtin_convertvector(v, bf16x2_t); return __builtin_bit_cast(unsigned, b); }
DI float bflo(unsigned w) { return __uint_as_float(w << 16); }
DI float bfhi(unsigned w) { return __uint_as_float(w & 0xffff0000u); }
DI void unpack8(const u32x4 w, float (&v)[8]) { v[0] = bflo(w.x); v[1] = bfhi(w.x); v[2] = bflo(w.y); v[3] = bfhi(w.y); v[4] = bflo(w.z); v[5] = bfhi(w.z); v[6] = bflo(w.w); v[7] = bfhi(w.w); }
DI int modidx(int row) { return row < MP ? 0 : 1 + ((row - MP) >> 11); }
DI float wave_sum(float v) {
#pragma unroll
    for (int o = 1; o < 64; o <<= 1) v += __shfl_xor(v, o);
    return v;
}
DI float sigmoidf_(float x) { return 1.f / (1.f + __expf(-x)); }
DI int crow(int i, int hi) { return (i & 3) + 8 * (i >> 2) + 4 * hi; }
DI int permkey(int p) { const int s = p >> 4, hh = (p >> 3) & 1, jj = p & 7; return 16 * s + 8 * (jj >> 2) + 4 * hh + (jj & 3); }

template <int ACT> struct EpiLin {
    static constexpr bool PERM = true, AFTER_DRAIN = false;
    bf16_t* O; int ldc; const float* bias; int ldb; const float* ssq;
    DI void operator()(const f32x4 (&acc)[2][2][4][2], const pg8::Unit& u, int wr, int wc, int fr, int fq) const {
        const int row0 = u.pm * 256 + wr * 64 + fr, col0 = u.pn * 256 + wc * 32 + 8 * fq;
        const float* bp = bias + (size_t)modidx(u.pm * 256) * ldb + col0;
        f32x4 bv[2][2];
#pragma unroll
        for (int bj = 0; bj < 2; ++bj)
#pragma unroll
            for (int n = 0; n < 2; ++n) bv[bj][n] = *(const f32x4*)(bp + bj * 128 + 4 * n);
#pragma unroll
        for (int ai = 0; ai < 2; ++ai)
#pragma unroll
            for (int m = 0; m < 4; ++m) {
                const int row = row0 + ai * 128 + m * 16;
                const f32x4 s4 = *(const f32x4*)(ssq + (size_t)row * 16 + 4 * fq);
                float s = (s4.x + s4.y) + (s4.z + s4.w); s += __shfl_xor(s, 16); s += __shfl_xor(s, 32);
                const float rstd = rsqrtf(s * (1.f / 1024.f) + EPS);
                bf16_t* rowp = O + (size_t)row * ldc + col0;
#pragma unroll
                for (int bj = 0; bj < 2; ++bj) {
                    f32x4 v0 = acc[ai][bj][m][0] * rstd + bv[bj][0], v1 = acc[ai][bj][m][1] * rstd + bv[bj][1];
                    if (ACT == 1) {
#pragma unroll
                        for (int e = 0; e < 4; ++e) { const float a = fmaxf(v0[e], 0.f), b = fmaxf(v1[e], 0.f); v0[e] = a * a; v1[e] = b * b; }
                    }
                    u32x4 w; w.x = pk2(v0[0], v0[1]); w.y = pk2(v0[2], v0[3]); w.z = pk2(v1[0], v1[1]); w.w = pk2(v1[2], v1[3]);
                    *(u32x4*)(rowp + bj * 128) = w;
                }
            }
    }
};
struct EpiRes {
    static constexpr bool PERM = false, AFTER_DRAIN = false;
    const float* baseP; const float* baseS; float* out; const float* gate; const float* nw; const float* sc; bf16_t* xg; float* ssq; int has_next;
    DI void operator()(const f32x4 (&acc)[2][2][4][2], const pg8::Unit& u, int wr, int wc, int fr, int fq) const {
        const int col0 = u.pn * 256 + wc * 32 + 4 * fq, j = modidx(u.pm * 256);
        const float* gp = gate + (size_t)j * 6144 + col0;
        f32x4 gv[2][2], gn[2][2];
#pragma unroll
        for (int bj = 0; bj < 2; ++bj)
#pragma unroll
            for (int n = 0; n < 2; ++n) {
                gv[bj][n] = *(const f32x4*)(gp + bj * 128 + n * 16);
                if (has_next) gn[bj][n] = *(const f32x4*)(nw + col0 + bj * 128 + n * 16) * (*(const f32x4*)(sc + (size_t)j * 6144 + col0 + bj * 128 + n * 16) + 1.0f);
                else gn[bj][n] = (f32x4){0.f, 0.f, 0.f, 0.f};
            }
#pragma unroll
        for (int ai = 0; ai < 2; ++ai)
#pragma unroll
            for (int m = 0; m < 4; ++m) {
                const int row = u.pm * 256 + ai * 128 + wr * 64 + m * 16 + fr;
                const float* b = (row < MP) ? baseP + (size_t)row * D : baseS + (size_t)(row - MP) * D;
                float q = 0.f;
#pragma unroll
                for (int bj = 0; bj < 2; ++bj)
#pragma unroll
                    for (int n = 0; n < 2; ++n) {
                        const int c = col0 + bj * 128 + n * 16;
                        const f32x4 x = *(const f32x4*)(b + c) + gv[bj][n] * acc[ai][bj][m][n];
                        *(f32x4*)(out + (size_t)row * D + c) = x;
                        q += (x.x * x.x + x.y * x.y) + (x.z * x.z + x.w * x.w);
                        if (has_next) { const f32x4 y = x * gn[bj][n]; u32x2 w; w.x = pk2(y.x, y.y); w.y = pk2(y.z, y.w); *(u32x2*)(xg + (size_t)row * D + c) = w; }
                    }
                q += __shfl_xor(q, 16); q += __shfl_xor(q, 32);
                if (fq == 0 && has_next) ssq[(size_t)row * 16 + u.pn * 4 + wc] = q;
            }
    }
};

DI void transpose_item(const float* W, int K, int N, bf16_t* WT, LAS float* scr, int item, int lane) {
    const int nblk = N / 32, kb = item / nblk, nb = item % nblk, k0 = 64 * kb, n0 = 32 * nb;
#pragma unroll 8
    for (int i = 0; i < 32; ++i) { const int kk = 2 * i + (lane >> 5); scr[kk * 33 + (lane & 31)] = W[(size_t)(k0 + kk) * N + n0 + (lane & 31)]; }
    asm volatile("s_waitcnt lgkmcnt(0)" ::: "memory");
    const int c = lane & 7;
#pragma unroll
    for (int j = 0; j < 4; ++j) { const int n = (lane >> 3) + 8 * j; const LAS float* s = scr + (8 * c) * 33 + n;
        u32x4 o; o.x = pk2(s[0 * 33], s[1 * 33]); o.y = pk2(s[2 * 33], s[3 * 33]); o.z = pk2(s[4 * 33], s[5 * 33]); o.w = pk2(s[6 * 33], s[7 * 33]);
        *(u32x4*)(WT + (size_t)(n0 + n) * K + k0 + 8 * c) = o; }
    asm volatile("s_waitcnt lgkmcnt(0)" ::: "memory");
}
DI void gemv9_unit(const float* W, int N, int n0, const float* v0, const float* v1, int vs, bool do_silu, const float* badd, float* out, int ostride, float* scr, int tid) {
    const int wave = __builtin_amdgcn_readfirstlane(tid >> 6), lane = tid & 63;
    float acc[NMOD];
#pragma unroll
    for (int j = 0; j < NMOD; ++j) acc[j] = 0.f;
    const float* wp = W + (size_t)(wave * 128) * N + n0 + lane;
#pragma unroll 4
    for (int k = 0; k < 128; ++k) {
        const float w = wp[(size_t)k * N];
        const int kk = wave * 128 + k;
#pragma unroll
        for (int j = 0; j < NMOD; ++j) {
            float v = (j == 0) ? v0[kk] : v1[(size_t)(j - 1) * vs + kk];
            if (do_silu) v = v * sigmoidf_(v);
            acc[j] += v * w;
        }
    }
#pragma unroll
    for (int j = 0; j < NMOD; ++j) scr[(wave * NMOD + j) * 64 + lane] = acc[j];
    __syncthreads();
    for (int idx = tid; idx < NMOD * 64; idx += 512) {
        const int j = idx >> 6, ln = idx & 63; float s = 0.f;
#pragma unroll
        for (int w = 0; w < 8; ++w) s += scr[(w * NMOD + j) * 64 + ln];
        if (badd) s += badd[n0 + ln];
        out[(size_t)j * ostride + n0 + ln] = s;
    }
    __syncthreads();
}

DI void conv_unit(int ct, int l, const bf16_t* RAW, bf16_t* ATT, const float* dw_w, const float* dw_b, const float* ln_g, const float* ln_b, float* lds, int tid) {
    const int row0 = ct * 64;
    int seq0, L;
    if (row0 < MP) { seq0 = row0 & ~255; L = 256; } else { seq0 = MP + ((row0 - MP) & ~2047); L = 2048; }
    const int t0 = row0 - seq0;
    for (int it = tid; it < 94 * 32; it += 512) {
        const int rr = it >> 5, c8 = it & 31, t = t0 - 15 + rr;
        float hv[8];
        if (t >= 0 && t < L) {
            const bf16_t* p = RAW + (size_t)(seq0 + t) * INW + c8 * 8;
            const u32x4 wa = *(const u32x4*)p, wg = *(const u32x4*)(p + 256);
            float a[8], g[8]; unpack8(wa, a); unpack8(wg, g);
#pragma unroll
            for (int e = 0; e < 8; ++e) hv[e] = a[e] * sigmoidf_(g[e]);
        } else {
#pragma unroll
            for (int e = 0; e < 8; ++e) hv[e] = 0.f;
        }
        float* d = lds + rr * 256 + c8 * 8;
        *(f32x4*)d = (f32x4){hv[0], hv[1], hv[2], hv[3]}; *(f32x4*)(d + 4) = (f32x4){hv[4], hv[5], hv[6], hv[7]};
    }
    __syncthreads();
    const int c = tid & 255, th = tid >> 8;
    float w[31];
#pragma unroll
    for (int k = 0; k < 31; ++k) w[k] = dw_w[(size_t)(l * 31 + k) * 256 + c];
    const float bias = dw_b[l * 256 + c];
    float outv[32];
#pragma unroll
    for (int ch = 0; ch < 2; ++ch) {
        float hv[46];
#pragma unroll
        for (int i = 0; i < 46; ++i) hv[i] = lds[(th * 32 + ch * 16 + i) * 256 + c];
#pragma unroll
        for (int o = 0; o < 16; ++o) {
            float s = bias;
#pragma unroll
            for (int k = 0; k < 31; ++k) s += hv[o + k] * w[k];
            outv[ch * 16 + o] = s;
        }
    }
    __syncthreads();
#pragma unroll
    for (int o = 0; o < 32; ++o) lds[(th * 32 + o) * 256 + c] = outv[o];
    __syncthreads();
    const int wave = tid >> 6, lane = tid & 63;
    const f32x4 g4 = *(const f32x4*)(ln_g + l * 256 + 4 * lane), b4 = *(const f32x4*)(ln_b + l * 256 + 4 * lane);
#pragma unroll
    for (int i = 0; i < 8; ++i) {
        const int tk = wave * 8 + i;
        const f32x4 v = *(const f32x4*)(lds + tk * 256 + 4 * lane);
        const float mean = wave_sum((v.x + v.y) + (v.z + v.w)) * (1.f / 256.f);
        const f32x4 dv = v - mean;
        const float var = wave_sum((dv.x * dv.x + dv.y * dv.y) + (dv.z * dv.z + dv.w * dv.w)) * (1.f / 256.f);
        const float rstd = rsqrtf(var + EPS);
        f32x4 y = dv * rstd * g4 + b4;
        y.x *= sigmoidf_(y.x); y.y *= sigmoidf_(y.y); y.z *= sigmoidf_(y.z); y.w *= sigmoidf_(y.w);
        u32x2 o; o.x = pk2(y.x, y.y); o.y = pk2(y.z, y.w);
        *(u32x2*)(ATT + (size_t)(row0 + tk) * D + 4 * lane) = o;
    }
    __syncthreads();
}

struct PrepP { const bf16_t* RAW; bf16_t* Q; bf16_t* K; bf16_t* VT; float* out; const float *aqg, *akg, *nqg, *nkg; };
DI void qkv_unit(int ct, int l, const PrepP& P, bf16_t* ldsv, int tid) {
    const int row0 = ct * 64;
    const bool prompt = row0 < MP;
    int seq0, L, sb;
    if (prompt) { seq0 = row0 & ~255; L = 256; sb = row0 >> 8; } else { seq0 = MP + ((row0 - MP) & ~2047); L = 2048; sb = (row0 - MP) >> 11; }
    const int t0 = row0 - seq0;
    {
    const int lane = tid & 63, wave = __builtin_amdgcn_readfirstlane(tid >> 6), half = lane >> 5;
    for (int wi = wave; wi < 40; wi += 8) {
        const int hd = wi >> 1, tok = (wi & 1) * 32 + (lane & 31);
        const int row = row0 + tok, t = t0 + tok;
        int rcol; const float* gw; bool isq;
        if (hd < 6) { rcol = 512 + 64 * hd; gw = P.aqg; isq = true; }
        else if (hd < 8) { rcol = 896 + 64 * (hd - 6); gw = P.akg; isq = false; }
        else if (hd < 14) { rcol = 1152 + 64 * (hd - 8); gw = P.nqg; isq = true; }
        else { rcol = 1536 + 64 * (hd - 14); gw = P.nkg; isq = false; }
        float v[32];
        const bf16_t* rp = P.RAW + (size_t)row * INW + rcol + 32 * half;
#pragma unroll
        for (int c = 0; c < 4; ++c) { const u32x4 wv = *(const u32x4*)(rp + 8 * c); float tmp[8]; unpack8(wv, tmp);
#pragma unroll
            for (int e2 = 0; e2 < 8; ++e2) v[8 * c + e2] = tmp[e2]; }
        float ss = 0.f;
#pragma unroll
        for (int d = 0; d < 32; ++d) ss += v[d] * v[d];
        ss += __shfl_xor(ss, 32);
        const float rstd = rsqrtf(ss * (1.f / 64.f) + EPS);
        const float* gp = gw + l * 64 + 32 * half;
#pragma unroll
        for (int c4 = 0; c4 < 8; ++c4) { const f32x4 g4 = *(const f32x4*)(gp + 4 * c4); v[4 * c4] *= rstd * g4.x; v[4 * c4 + 1] *= rstd * g4.y; v[4 * c4 + 2] *= rstd * g4.z; v[4 * c4 + 3] *= rstd * g4.w; }
        if ((!prompt) && (hd < 8)) {
            const float pos = (float)(half ? (t & 63) : (t >> 6));
#pragma unroll
            for (int j = 0; j < 16; ++j) {
                const float inv = exp2f(-(float)j * 0.8304820237218406f);
                float sn, cs; __sincosf(pos * inv, &sn, &cs);
                const float a = v[j], b = v[16 + j];
                v[j] = a * cs - b * sn; v[16 + j] = b * cs + a * sn;
            }
        }
        if (isq) {
            const int qh = (hd < 6) ? hd : 6 + (hd - 8);
            bf16_t* qp = P.Q + (prompt ? ((size_t)(sb * 12 + qh) * 8 + (t >> 5)) * 2048 : (size_t)MP * 768 + ((size_t)(sb * 12 + qh) * 64 + (t >> 5)) * 2048) + (t & 31) * 8 + half * 1024;
#pragma unroll
            for (int c = 0; c < 4; ++c) {
                u32x4 o; o.x = pk2(v[8 * c] * QSCALE, v[8 * c + 1] * QSCALE); o.y = pk2(v[8 * c + 2] * QSCALE, v[8 * c + 3] * QSCALE);
                o.z = pk2(v[8 * c + 4] * QSCALE, v[8 * c + 5] * QSCALE); o.w = pk2(v[8 * c + 6] * QSCALE, v[8 * c + 7] * QSCALE);
                *(u32x4*)(qp + c * 256) = o;
            }
        } else {
            const int kh = (hd < 8) ? (hd - 6) : 2 + (hd - 14);
            bf16_t* kp = P.K + (prompt ? ((size_t)(sb * 8 + kh) * 8 + (t >> 5)) * 2048 : (size_t)MP * 512 + ((size_t)(sb * 8 + kh) * 64 + (t >> 5)) * 2048) + (t & 31) * 8 + half * 1024;
#pragma unroll
            for (int c = 0; c < 4; ++c) {
                u32x4 o; o.x = pk2(v[8 * c], v[8 * c + 1]); o.y = pk2(v[8 * c + 2], v[8 * c + 3]); o.z = pk2(v[8 * c + 4], v[8 * c + 5]); o.w = pk2(v[8 * c + 6], v[8 * c + 7]);
                *(u32x4*)(kp + c * 256) = o;
            }
            if (prompt) {
                float* op;
                if (hd < 8) op = P.out + OFF_AK + ((((size_t)sb * 4 + l) * 256 + t) * 2 + (hd - 6)) * 64 + 32 * half;
                else        op = P.out + OFF_NK + ((((size_t)sb * 4 + l) * 256 + t) * 6 + (hd - 14)) * 64 + 32 * half;
#pragma unroll
                for (int c4 = 0; c4 < 8; ++c4) *(f32x4*)(op + 4 * c4) = (f32x4){v[4 * c4], v[4 * c4 + 1], v[4 * c4 + 2], v[4 * c4 + 3]};
            }
        }
    }
    }
    for (int it = tid; it < 64 * 64; it += 512) {
        const int tok = it >> 6, ch = it & 63;
        const int cc = ch * 8, rcol = (cc < 128) ? 1024 + cc : 1920 + (cc - 128);
        const u32x4 wv = *(const u32x4*)(P.RAW + (size_t)(row0 + tok) * INW + rcol);
        *(u32x4*)(ldsv + tok * 512 + cc) = wv;
        if (prompt) {
            float v[8]; unpack8(wv, v);
            const int t = t0 + tok; float* op;
            if (cc < 128) op = P.out + OFF_AV + (((size_t)sb * 4 + l) * 256 + t) * 128 + cc;
            else          op = P.out + OFF_NV + (((size_t)sb * 4 + l) * 256 + t) * 384 + (cc - 128);
            *(f32x4*)op = (f32x4){v[0], v[1], v[2], v[3]}; *(f32x4*)(op + 4) = (f32x4){v[4], v[5], v[6], v[7]};
        }
    }
    __syncthreads();
    for (int it = tid; it < 512 * 8; it += 512) {
        const int hd_d = it & 511, g = it >> 9;
        unsigned short e[8];
#pragma unroll
        for (int jj = 0; jj < 8; ++jj) { const int p = 8 * g + jj; const int key = (p & ~31) + permkey(p & 31); e[jj] = ldsv[key * 512 + hd_d]; }
        u32x4 o; o.x = e[0] | ((unsigned)e[1] << 16); o.y = e[2] | ((unsigned)e[3] << 16); o.z = e[4] | ((unsigned)e[5] << 16); o.w = e[6] | ((unsigned)e[7] << 16);
        const int vh = hd_d >> 6, dd = hd_d & 63, tile = (t0 >> 5) + (g >> 2);
        const size_t base = prompt ? ((size_t)(sb * 8 + vh) * 8 + tile) * 2048 : (size_t)MP * 512 + ((size_t)(sb * 8 + vh) * 64 + tile) * 2048;
        *(u32x4*)(P.VT + base + ((((dd >> 5) * 2 + ((g >> 1) & 1)) * 2 + (g & 1)) * 32 + (dd & 31)) * 8) = o;
    }
    __syncthreads();
}

struct Seg { const bf16_t* k; const bf16_t* v; int nt; };
#define MFMA32(a, b, c) __builtin_amdgcn_mfma_f32_32x32x16_bf16((a), (b), (c), 0, 0, 0)
DI void issue_tile(const Seg& A, const Seg& B, int t, int lane, LAS unsigned char* slot) {
    const bf16_t* kp = (t < A.nt) ? A.k + (size_t)t * 2048 : B.k + (size_t)(t - A.nt) * 2048;
    const bf16_t* vp = (t < A.nt) ? A.v + (size_t)t * 2048 : B.v + (size_t)(t - A.nt) * 2048;
#pragma unroll
    for (int i = 0; i < 4; ++i) __builtin_amdgcn_global_load_lds((const unsigned*)(kp + i * 512 + lane * 8), (LAS unsigned*)(slot + i * 1024), 16, 0, 0);
#pragma unroll
    for (int i = 0; i < 4; ++i) __builtin_amdgcn_global_load_lds((const unsigned*)(vp + i * 512 + lane * 8), (LAS unsigned*)(slot + 4096 + i * 1024), 16, 0, 0);
}
template <bool NA> DI void attn_wave(const bf16_t* Qp, const Seg A, const Seg B, bf16_t* Op, const float* rpbh, int r, int rs, int lane_, LAS unsigned char* ring, LAS float* biasl) {
    int lane = lane_; asm volatile("" : "+v"(lane));
    const int r32 = lane & 31, hi = lane >> 5;
    const int nt = A.nt + B.nt;
    issue_tile(A, B, 0, lane, ring);
    issue_tile(A, B, 1, lane, ring + 8192);
    if (NA) { for (int i = lane; i < 15 * 31; i += 64) biasl[i] = rpbh[i] * LOG2E; }
    bf16x8 qf[2][4];
#pragma unroll
    for (int qb = 0; qb < 2; ++qb)
#pragma unroll
        for (int kk = 0; kk < 4; ++kk) qf[qb][kk] = *(const bf16x8*)(Qp + qb * 2048 + kk * 512 + lane * 8);
    f32x16 o[2][2];
#pragma unroll
    for (int a = 0; a < 2; ++a)
#pragma unroll
        for (int b = 0; b < 2; ++b)
#pragma unroll
            for (int i = 0; i < 16; ++i) o[a][b][i] = 0.f;
    float mrun[2] = {-1e30f, -1e30f}, lrun[2] = {0.f, 0.f};
    asm volatile("s_waitcnt vmcnt(0)" ::: "memory");
#pragma nounroll
    for (int t = 0; t < nt; ++t) {
        LAS unsigned char* slot = ring + (t & 1) * 8192;
        if (t + 1 < nt) asm volatile("s_waitcnt vmcnt(8)" ::: "memory"); else asm volatile("s_waitcnt vmcnt(0)" ::: "memory");
        bf16x8 kf[4], vf[2][2];
#pragma unroll
        for (int kk = 0; kk < 4; ++kk) kf[kk] = *(const LAS bf16x8*)(slot + kk * 1024 + lane * 16);
#pragma unroll
        for (int db = 0; db < 2; ++db)
#pragma unroll
            for (int s2 = 0; s2 < 2; ++s2) vf[db][s2] = *(const LAS bf16x8*)(slot + 4096 + (db * 2 + s2) * 1024 + lane * 16);
        asm volatile("s_waitcnt lgkmcnt(0)" ::: "memory");
        if (t + 2 < nt) issue_tile(A, B, t + 2, lane, slot);
#pragma unroll
        for (int qb = 0; qb < 2; ++qb) {
            f32x16 s;
#pragma unroll
            for (int i = 0; i < 16; ++i) s[i] = 0.f;
#pragma unroll
            for (int kk = 0; kk < 4; ++kk) s = MFMA32(kf[kk], qf[qb][kk], s);
            if (NA) {
                if (t < A.nt) {
                    const int a = t >> 1, half = t & 1;
                    const int qc = 32 * qb + r32, cs = min(max(qc - 8, 0), 48);
                    const int kc0 = 32 * half + 4 * hi;
                    const LAS float* bp = biasl + (rs + a - r + 7) * 31 + (kc0 - qc + 15);
                    float bia[16];
#pragma unroll
                    for (int i = 0; i < 16; ++i) {
                        const int dk = (i & 3) + 8 * (i >> 2);
                        const int co = min(max(kc0 - qc + 15 + dk, 0), 30) - (kc0 - qc + 15);
                        bia[i] = bp[co];
                    }
                    asm volatile("" : "+v"(bia[0]), "+v"(bia[1]), "+v"(bia[2]), "+v"(bia[3]), "+v"(bia[4]), "+v"(bia[5]), "+v"(bia[6]), "+v"(bia[7]),
                                      "+v"(bia[8]), "+v"(bia[9]), "+v"(bia[10]), "+v"(bia[11]), "+v"(bia[12]), "+v"(bia[13]), "+v"(bia[14]), "+v"(bia[15]));
#pragma unroll
                    for (int i = 0; i < 16; ++i) {
                        const int kc = kc0 + (i & 3) + 8 * (i >> 2);
                        const bool valid = (kc >= cs) && (kc < cs + 16);
                        s[i] = valid ? s[i] + bia[i] : -1e30f;
                    }
                }
            }
            float mx = s[0];
#pragma unroll
            for (int i = 1; i < 16; ++i) mx = fmaxf(mx, s[i]);
            mx = fmaxf(mx, __shfl_xor(mx, 32));
            const float mn = fmaxf(mrun[qb], mx);
            const float alpha = __builtin_amdgcn_exp2f(mrun[qb] - mn);
            mrun[qb] = mn;
            float ps = 0.f;
#pragma unroll
            for (int i = 0; i < 16; ++i) { const float p = __builtin_amdgcn_exp2f(s[i] - mn); s[i] = p; ps += p; }
            lrun[qb] = lrun[qb] * alpha + ps;
#pragma unroll
            for (int i = 0; i < 16; ++i) { o[qb][0][i] *= alpha; o[qb][1][i] *= alpha; }
            u32x4 p0, p1;
            p0.x = pk2(s[0], s[1]); p0.y = pk2(s[2], s[3]); p0.z = pk2(s[4], s[5]); p0.w = pk2(s[6], s[7]);
            p1.x = pk2(s[8], s[9]); p1.y = pk2(s[10], s[11]); p1.z = pk2(s[12], s[13]); p1.w = pk2(s[14], s[15]);
            const bf16x8 P0 = __builtin_bit_cast(bf16x8, p0), P1 = __builtin_bit_cast(bf16x8, p1);
#pragma unroll
            for (int db = 0; db < 2; ++db) { o[qb][db] = MFMA32(vf[db][0], P0, o[qb][db]); o[qb][db] = MFMA32(vf[db][1], P1, o[qb][db]); }
        }
    }
#pragma unroll
    for (int qb = 0; qb < 2; ++qb) {
        const float lt = lrun[qb] + __shfl_xor(lrun[qb], 32);
        const float inv = 1.f / lt;
        bf16_t* orow = Op + (size_t)(32 * qb + r32) * D;
#pragma unroll
        for (int db = 0; db < 2; ++db)
#pragma unroll
            for (int g = 0; g < 4; ++g) {
                u32x2 w; w.x = pk2(o[qb][db][4 * g] * inv, o[qb][db][4 * g + 1] * inv); w.y = pk2(o[qb][db][4 * g + 2] * inv, o[qb][db][4 * g + 3] * inv);
                *(u32x2*)(orow + 32 * db + 8 * g + 4 * hi) = w;
            }
    }
}

struct AttnP { const bf16_t *Q, *K, *VT, *KCA, *VCA, *KCN, *VCN; bf16_t* ATT; const float* rpb; };
DI void attn_run_unit(int uid, int l, const AttnP& P, int lane, LAS unsigned char* ring, LAS float* biasl) {
    const size_t QS = (size_t)MP * 768, KS = (size_t)MP * 512;
    Seg A, B{nullptr, nullptr, 0}; const bf16_t* Qp; bf16_t* Op; const float* rp = nullptr; int r = 0, rs = 0; bool na = false;
    if (uid < 1536) {
        const int qc = uid & 31, bh = uid >> 5, b = bh / 6, h = bh - 6 * b, kvh = h / 3;
        const int row0 = MP + b * 2048;
        A = Seg{P.K + KS + (size_t)(b * 8 + kvh) * 64 * 2048, P.VT + KS + (size_t)(b * 8 + kvh) * 64 * 2048, 64};
        B = Seg{P.KCA + (size_t)((b * 4 + l) * 2 + kvh) * 16384, P.VCA + (size_t)((b * 4 + l) * 2 + kvh) * 16384, 8};
        Qp = P.Q + QS + ((size_t)(b * 12 + h) * 64 + 2 * qc) * 2048; Op = P.ATT + (size_t)(row0 + qc * 64) * D + 256 + h * 64;
    } else if (uid < 3072) {
        const int u = uid - 1536, bh = u >> 5, b = bh / 6, h = bh - 6 * b;
        r = u & 31; rs = min(max(r - 4, 0), 24); na = true;
        const int row0 = MP + b * 2048;
        A = Seg{P.K + KS + ((size_t)(b * 8 + 2 + h) * 64 + 2 * rs) * 2048, P.VT + KS + ((size_t)(b * 8 + 2 + h) * 64 + 2 * rs) * 2048, 16};
        B = Seg{P.KCN + (size_t)((b * 4 + l) * 6 + h) * 16384, P.VCN + (size_t)((b * 4 + l) * 6 + h) * 16384, 8};
        Qp = P.Q + QS + ((size_t)(b * 12 + 6 + h) * 64 + 2 * r) * 2048; Op = P.ATT + (size_t)(row0 + r * 64) * D + 640 + h * 64;
        rp = P.rpb + (size_t)(l * 6 + h) * 15 * 31;
    } else {
        const int nah = uid >= 3840;
        const int u = uid - (nah ? 3840 : 3072), qc = u & 3, bh = u >> 2, b = bh / 6, h = bh - 6 * b, kh = nah ? 2 + h : h / 3;
        const int row0 = b * 256;
        A = Seg{P.K + (size_t)(b * 8 + kh) * 8 * 2048, P.VT + (size_t)(b * 8 + kh) * 8 * 2048, 8};
        Qp = P.Q + ((size_t)(b * 12 + (nah ? 6 : 0) + h) * 8 + 2 * qc) * 2048; Op = P.ATT + (size_t)(row0 + qc * 64) * D + (nah ? 640 : 256) + h * 64;
    }
    if (na) attn_wave<true>(Qp, A, B, Op, rp, r, rs, lane, ring, biasl);
    else attn_wave<false>(Qp, A, B, Op, rp, r, rs, lane, ring, biasl);
}

struct Args {
    const float* in[25]; float* out; unsigned char* ws; int ph_lo, ph_hi;
};
#define XB_TMO      128
#define XB_XCNT(j)  (256  + 64 * (j))
#define XB_XSUB(j)  (1280 + 64 * (j))
#define XB_XGEN(j)  (2304 + 64 * (j))
#define XB_TOP      3328
#define XB_TOPGEN   3392
#define XCD_BAR_WORDS 3456
#define XB_SPIN_CAP (1u << 18)

__device__ __forceinline__ unsigned xb_ld(unsigned* p)              { return __hip_atomic_load(p, __ATOMIC_RELAXED, __HIP_MEMORY_SCOPE_AGENT); }
__device__ __forceinline__ unsigned xb_add(unsigned* p, unsigned v) { return __hip_atomic_fetch_add(p, v, __ATOMIC_RELAXED, __HIP_MEMORY_SCOPE_AGENT); }
__device__ __forceinline__ unsigned xb_xcc_id() { return (unsigned)__builtin_amdgcn_s_getreg((3 << 11) | 20) & 0xFu; }
#define XB_SPIN(cond, bar) do { unsigned _sp = 0; while (cond) { __builtin_amdgcn_s_sleep(1); \
    if ((++_sp & 255u) == 0u) { if (xb_ld(&(bar)[XB_TMO])) break; if (_sp > XB_SPIN_CAP) { atomicAdd(&(bar)[XB_TMO], 1u); break; } } } } while (0)

struct XcdBarrier {
    unsigned* bar; unsigned x;
    volatile LAS unsigned* st;
};

__device__ __forceinline__ XcdBarrier xcd_barrier_post(unsigned* bar, volatile LAS unsigned* st) {
    XcdBarrier b; b.bar = bar; b.x = xb_xcc_id(); b.st = st;
    if (threadIdx.x == 0) { const unsigned old_ = xb_add(&bar[XB_XCNT(b.x)], 1u); st[2] = old_; st[3] = b.x; }
    return b;
}
__device__ __forceinline__ void xcd_barrier_complete(unsigned* bar, unsigned x, unsigned& nloc, unsigned& nx) {
    const unsigned G = gridDim.x * gridDim.y * gridDim.z;
    unsigned sum, cnt, mine, sp = 0u;
    for (;;) {
        sum = 0u; cnt = 0u; mine = 0u;
#pragma unroll
        for (unsigned j = 0; j < 16; ++j) { const unsigned c = xb_ld(&bar[XB_XCNT(j)]); sum += c; cnt += (c > 0u) ? 1u : 0u; mine = (j == x) ? c : mine; }
        if (sum == G) break;
        __builtin_amdgcn_s_sleep(1);
        if ((++sp & 255u) == 0u) { if (xb_ld(&bar[XB_TMO])) break; if (sp > XB_SPIN_CAP) { atomicAdd(&bar[XB_TMO], 1u); break; } }
    }
    nloc = mine > 0u ? mine : 1u; nx = cnt > 0u ? cnt : 1u;
}

__device__ __forceinline__ void xcd_barrier(const XcdBarrier& b) {
    asm volatile("s_waitcnt vmcnt(0)" ::: "memory");
    __syncthreads();
    if (threadIdx.x == 0) {
        unsigned* bar = b.bar; asm volatile("" : "+v"(bar));
        __builtin_amdgcn_s_waitcnt(0);
        unsigned nloc = b.st[0], nx = b.st[1];
        if (nloc == 0u) { xcd_barrier_complete(bar, b.x, nloc, nx); b.st[0] = nloc; b.st[1] = nx; }
        const unsigned old = xb_add(&bar[XB_XSUB(b.x)], 1u);
        const unsigned gen = old / nloc;
        if (old + 1u == (gen + 1u) * nloc) {
            __builtin_amdgcn_fence(__ATOMIC_RELEASE, "agent");
            asm volatile("s_waitcnt vmcnt(0)" ::: "memory");
            const unsigned og = xb_add(&bar[XB_TOP], 1u);
            const unsigned tg = og / nx;
            if (og + 1u == (tg + 1u) * nx) xb_add(&bar[XB_TOPGEN], 1u);
            else XB_SPIN(xb_ld(&bar[XB_TOPGEN]) == tg, bar);
            __builtin_amdgcn_fence(__ATOMIC_ACQUIRE, "agent");
            xb_add(&bar[XB_XGEN(b.x)], 1u);
            asm volatile("s_waitcnt vmcnt(0)" ::: "memory");
        } else {
            XB_SPIN(xb_ld(&bar[XB_XGEN(b.x)]) == gen, bar);
            __builtin_amdgcn_fence(__ATOMIC_ACQUIRE, "agent");
            asm volatile("s_waitcnt vmcnt(0)" ::: "memory");
        }
    }
    __syncthreads();
}

typedef const __attribute__((address_space(4))) char* kargp_t;
DI const float* ldin(int i) { kargp_t kp = (kargp_t)__builtin_amdgcn_kernarg_segment_ptr(); asm volatile("" : "+s"(kp)); return (const float*)(*(const __attribute__((address_space(4))) unsigned long long*)(kp + 8 * i)); }
DI float* ldout() { return (float*)ldin(25); }
DI unsigned char* ldws() { return (unsigned char*)ldin(26); }
DI int opq_tid() { int t = threadIdx.x; asm volatile("" : "+v"(t)); return t; }

__global__ void __launch_bounds__(512, 2) fwd_kernel(Args a) {
    extern __shared__ __attribute__((aligned(16))) unsigned char lds[];
    cg::grid_group grid = cg::this_grid();
    const int G = gridDim.x, bx = blockIdx.x, NGW = G * 8;
    const int lo = a.ph_lo, hi = a.ph_hi;
#define IN(k) (lo <= (k) && (k) < hi)
    volatile LAS unsigned* MISC = (volatile LAS unsigned*)((LAS unsigned char*)lds + 146432);
    if (threadIdx.x < 16) MISC[threadIdx.x] = 0u;
    __syncthreads();
    XcdBarrier xbar; xbar.bar = (unsigned*)ldws(); xbar.x = 0; xbar.st = nullptr;
    if (hi - lo > 1) xbar = xcd_barrier_post((unsigned*)ldws(), MISC + 8);
    if (hi < 0) grid.sync();
#define SEAM(k) do { if (IN(k) && (k) + 1 < hi) xcd_barrier(xbar); } while (0)
#define WSP(T, off) ((T*)(ws + (off)))

    for (int sx_ = 0; sx_ < SYNCX; ++sx_) xcd_barrier(xbar);
    if (IN(0)) for (int rep_ = 0; rep_ < REP_P; ++rep_) {
        if (rep_) xcd_barrier(xbar);
        const int tid = opq_tid(), lane = tid & 63, wave = __builtin_amdgcn_readfirstlane(tid >> 6), gw = bx * 8 + wave;
        unsigned char* ws = ldws();
        {
            const float *cvec = ldin(6), *c_ctx = ldin(7), *ada_w = ldin(8), *ada_b = ldin(9);
            float* mod = WSP(float, WS_MOD);
            for (int u = bx; u < DEPTH * 96; u += G) {
                const int l = u / 96, nb = u - l * 96;
                gemv9_unit(ada_w + (size_t)l * D * 6144, 6144, nb * 64, c_ctx, cvec, D, true, ada_b + l * 6144, mod + (size_t)l * NMOD * 6144, 6144, (float*)lds, tid);
            }
        }
        {
            const float *w_in = ldin(12), *w_out = ldin(22), *w1 = ldin(23), *w2 = ldin(24);
            bf16_t *WIN = WSP(bf16_t, WS_WIN), *WOUT = WSP(bf16_t, WS_WOUT), *W1T = WSP(bf16_t, WS_W1), *W2T = WSP(bf16_t, WS_W2);
            LAS float* scr = (LAS float*)((LAS unsigned char*)lds + wave * 16384);
            constexpr int I_IN = 16 * 72, I_OUT = 16 * 32, I_1 = 16 * 128, I_2 = 64 * 32, I_L = I_IN + I_OUT + I_1 + I_2;
            for (int it = gw; it < DEPTH * I_L; it += NGW) {
                const int l = it / I_L; int r = it - l * I_L;
                if (r < I_IN) { transpose_item(w_in + (size_t)l * D * INW, D, INW, WIN + (size_t)l * INW * D, scr, r, lane); continue; } r -= I_IN;
                if (r < I_OUT) { transpose_item(w_out + (size_t)l * D * D, D, D, WOUT + (size_t)l * D * D, scr, r, lane); continue; } r -= I_OUT;
                if (r < I_1) { transpose_item(w1 + (size_t)l * D * FF, D, FF, W1T + (size_t)l * FF * D, scr, r, lane); continue; } r -= I_1;
                transpose_item(w2 + (size_t)l * FF * D, FF, D, W2T + (size_t)l * D * FF, scr, r, lane);
            }
        }
        {
            const float *cache_ak = ldin(2), *cache_av = ldin(3), *cache_nk = ldin(4), *cache_nv = ldin(5);
            bf16_t *KCA = WSP(bf16_t, WS_KCA), *VCA = WSP(bf16_t, WS_VCA), *KCN = WSP(bf16_t, WS_KCN), *VCN = WSP(bf16_t, WS_VCN);
            const int gt = bx * 512 + tid, NGT = G * 512;
            for (int e = gt; e < 8 * 4 * 256 * 8 * 8; e += NGT) {
                const int c8 = e & 7, hh = (e >> 3) & 7, key = (e >> 6) & 255, bl = e >> 14;
                const float* src; bf16_t* dst;
                if (hh < 2) { src = cache_ak + (((size_t)bl * 256 + key) * 2 + hh) * 64 + 8 * c8; dst = KCA + (((size_t)bl * 2 + hh) * 8 + (key >> 5)) * 2048 + (c8 * 32 + (key & 31)) * 8; }
                else { src = cache_nk + (((size_t)bl * 256 + key) * 6 + (hh - 2)) * 64 + 8 * c8; dst = KCN + (((size_t)bl * 6 + (hh - 2)) * 8 + (key >> 5)) * 2048 + (c8 * 32 + (key & 31)) * 8; }
                const f32x4 v0 = *(const f32x4*)src, v1 = *(const f32x4*)(src + 4);
                u32x4 o; o.x = pk2(v0.x, v0.y); o.y = pk2(v0.z, v0.w); o.z = pk2(v1.x, v1.y); o.w = pk2(v1.z, v1.w);
                *(u32x4*)dst = o;
            }
            for (int e = gt; e < 8 * 4 * 8 * 32 * 64; e += NGT) {
                const int d = e & 63, g = (e >> 6) & 31, hh = (e >> 11) & 7, bl = e >> 14;
                unsigned short q[8];
#pragma unroll
                for (int jj = 0; jj < 8; ++jj) {
                    const int p = 8 * g + jj, key = (p & ~31) + permkey(p & 31);
                    const float v = (hh < 2) ? cache_av[(((size_t)bl * 256 + key) * 2 + hh) * 64 + d] : cache_nv[(((size_t)bl * 256 + key) * 6 + (hh - 2)) * 64 + d];
                    q[jj] = (unsigned short)(pk2(v, 0.f) & 0xffffu);
                }
                u32x4 o; o.x = q[0] | ((unsigned)q[1] << 16); o.y = q[2] | ((unsigned)q[3] << 16); o.z = q[4] | ((unsigned)q[5] << 16); o.w = q[6] | ((unsigned)q[7] << 16);
                const int voff = (g >> 2) * 2048 + ((((d >> 5) * 2 + ((g >> 1) & 1)) * 2 + (g & 1)) * 32 + (d & 31)) * 8;
                bf16_t* dst = (hh < 2) ? VCA + ((size_t)bl * 2 + hh) * 16384 + voff : VCN + ((size_t)bl * 6 + (hh - 2)) * 16384 + voff;
                *(u32x4*)dst = o;
            }
        }
    }
    SEAM(0);
    if (IN(1)) for (int rep_ = 0; rep_ < REP_P; ++rep_) {
        if (rep_) xcd_barrier(xbar);
        const int tid = opq_tid(), lane = tid & 63, wave = __builtin_amdgcn_readfirstlane(tid >> 6), gw = bx * 8 + wave;
        unsigned char* ws = ldws();
        float* mod = WSP(float, WS_MOD);
        {
            const float *w_in = ldin(12), *w1 = ldin(23);
            float *bias1 = WSP(float, WS_BIAS1), *bias2 = WSP(float, WS_BIAS2);
            for (int u = bx; u < DEPTH * 100; u += G) {
                const int l = u / 100; int r = u - l * 100;
                const float* ml = mod + (size_t)l * NMOD * 6144;
                if (r < 36) gemv9_unit(w_in + (size_t)l * D * INW, INW, r * 64, ml, ml + 6144, 6144, false, nullptr, bias1 + (size_t)l * NMOD * INW, INW, (float*)lds, tid);
                else { r -= 36; gemv9_unit(w1 + (size_t)l * D * FF, FF, r * 64, ml + 3072, ml + 6144 + 3072, 6144, false, nullptr, bias2 + (size_t)l * NMOD * FF, FF, (float*)lds, tid); }
            }
        }
        {
            const float *x_prompt = ldin(0), *x_sample = ldin(1), *norm1_g = ldin(10);
            bf16_t* XG = WSP(bf16_t, WS_XG); float* ssq = WSP(float, WS_SSQ);
            for (int row = gw; row < M; row += NGW) {
                const float* xr = (row < MP) ? x_prompt + (size_t)row * D : x_sample + (size_t)(row - MP) * D;
                const float* scp = mod + (size_t)modidx(row) * 6144 + 1024;
                float s = 0.f;
#pragma unroll
                for (int j = 0; j < 4; ++j) {
                    const int c = 256 * j + 4 * lane;
                    const f32x4 v = *(const f32x4*)(xr + c);
                    s += (v.x * v.x + v.y * v.y) + (v.z * v.z + v.w * v.w);
                    const f32x4 y = v * (*(const f32x4*)(norm1_g + c)) * (*(const f32x4*)(scp + c) + 1.0f);
                    u32x2 w; w.x = pk2(y.x, y.y); w.y = pk2(y.z, y.w);
                    *(u32x2*)(XG + (size_t)row * D + c) = w;
                }
                s = wave_sum(s);
                if (lane < 16) ssq[(size_t)row * 16 + lane] = (lane == 0) ? s : 0.f;
            }
        }
    }
    SEAM(1);
#pragma nounroll
    for (int l_ = 0; l_ < DEPTH; ++l_) {
        int l = l_; asm volatile("" : "+s"(l));
        const int p0 = 2 + 6 * l;
        if (IN(p0)) for (int rep_ = 0; rep_ < REP_G1; ++rep_) {
            unsigned char* ws = ldws();
            pg8::Gemm g{WSP(bf16_t, WS_XG), WSP(bf16_t, WS_WIN) + (size_t)l * INW * D, M, INW, D}; pg8::StaticOrder S; S.init(M, INW, G, bx);
            EpiLin<0> E{WSP(bf16_t, WS_RAW), INW, WSP(float, WS_BIAS1) + (size_t)l * NMOD * INW, INW, WSP(float, WS_SSQ)};
            pg8::gemm_phase<EpiLin<0>, pg8::StaticOrder, true, true>((LAS unsigned char*)lds, g, S, E);
        }
        SEAM(p0);
        if (IN(p0 + 1)) for (int rep_ = 0; rep_ < REP_PREP; ++rep_) {
            const int tid = opq_tid();
            unsigned char* ws = ldws();
            for (int u = bx; u < 768; u += G) {
                if (u < 384) conv_unit(u, l, WSP(bf16_t, WS_RAW), WSP(bf16_t, WS_ATT), ldin(13), ldin(14), ldin(15), ldin(16), (float*)lds, tid);
                else { PrepP P{WSP(bf16_t, WS_RAW), WSP(bf16_t, WS_Q), WSP(bf16_t, WS_K), WSP(bf16_t, WS_VT), ldout(), ldin(17), ldin(18), ldin(19), ldin(20)}; qkv_unit(u - 384, l, P, (bf16_t*)lds, tid); }
            }
        }
        SEAM(p0 + 1);
        if (IN(p0 + 2)) for (int rep_ = 0; rep_ < REP_ATTN; ++rep_) {
            const int tid = opq_tid(), lane = tid & 63, wave = __builtin_amdgcn_readfirstlane(tid >> 6), gw = bx * 8 + wave;
            unsigned char* ws = ldws();
            AttnP P{WSP(bf16_t, WS_Q), WSP(bf16_t, WS_K), WSP(bf16_t, WS_VT), WSP(bf16_t, WS_KCA), WSP(bf16_t, WS_VCA), WSP(bf16_t, WS_KCN), WSP(bf16_t, WS_VCN), WSP(bf16_t, WS_ATT), ldin(21)};
            bool bal = (NGW == 2048) && (hi - lo > 1);
            int xcd = bx & 7, slot = bx >> 3;
            if (bal) {
                for (unsigned j = 0; j < 16; ++j) bal = bal && (xb_ld(&xbar.bar[XB_XCNT(j)]) == (j < 8 ? 32u : 0u));
                xcd = (int)MISC[11]; slot = (int)MISC[10];
                bal = bal && xcd < 8 && slot < 32;
            }
            const int nu = bal ? (slot < 24 ? 2 : 3) : (4608 - gw + NGW - 1) / NGW;
            for (int k = 0; k < nu; ++k) {
#ifdef ATTN_PROBE
                if (rep_ == 1 && ((ATTN_PROBE == 1) ? (slot >= 24) : (slot < 24))) break;
#endif
                int uid;
                if (!bal) uid = gw + k * NGW;
                else if (slot < 24) {
                    const int idx = slot * 8 + wave;
                    if (k == 0) uid = (xcd * 6 + (idx >> 5)) * 32 + (idx & 31);
                    else { const int pb = 4 * xcd + idx / 48, r = idx % 48, kind = r / 24, rr = r % 24; uid = (kind ? 3840 : 3072) + (pb * 6 + (rr >> 2)) * 4 + (rr & 3); }
                } else {
                    const int idx = k * 64 + (slot - 24) * 8 + wave;
                    uid = 1536 + (xcd * 6 + (idx >> 5)) * 32 + (idx & 31);
                }
                attn_run_unit(uid, l, P, lane, (LAS unsigned char*)lds + wave * 16384, (LAS float*)((LAS unsigned char*)lds + 131072 + wave * 1920));
            }
        }
        SEAM(p0 + 2);
        if (IN(p0 + 3)) {
            unsigned char* ws = ldws(); float* X = ldout();
            const float* ml = WSP(float, WS_MOD) + (size_t)l * NMOD * 6144;
            pg8::Gemm g{WSP(bf16_t, WS_ATT), WSP(bf16_t, WS_WOUT) + (size_t)l * D * D, M, D, D}; pg8::StaticOrder S; S.init(M, D, G, bx);
            EpiRes E{l == 0 ? ldin(0) : X, l == 0 ? ldin(1) : X + (size_t)MP * D, X, ml + 2048, ldin(11) + l * D, ml + 4096, WSP(bf16_t, WS_XG), WSP(float, WS_SSQ), 1};
            pg8::gemm_phase<EpiRes, pg8::StaticOrder, true, true>((LAS unsigned char*)lds, g, S, E);
            SEAM(p0 + 3);
        }
        if (IN(p0 + 4)) for (int rep_ = 0; rep_ < REP_G3; ++rep_) {
            unsigned char* ws = ldws();
            pg8::Gemm g{WSP(bf16_t, WS_XG), WSP(bf16_t, WS_W1) + (size_t)l * FF * D, M, FF, D}; pg8::StaticOrder S; S.init(M, FF, G, bx);
            EpiLin<1> E{WSP(bf16_t, WS_H1), FF, WSP(float, WS_BIAS2) + (size_t)l * NMOD * FF, FF, WSP(float, WS_SSQ)};
            pg8::gemm_phase<EpiLin<1>, pg8::StaticOrder, true, true>((LAS unsigned char*)lds, g, S, E);
        }
        SEAM(p0 + 4);
        if (IN(p0 + 5)) {
            unsigned char* ws = ldws(); float* X = ldout();
            const float* ml = WSP(float, WS_MOD) + (size_t)l * NMOD * 6144;
            pg8::Gemm g{WSP(bf16_t, WS_H1), WSP(bf16_t, WS_W2) + (size_t)l * D * FF, M, D, FF}; pg8::StaticOrder S; S.init(M, D, G, bx);
            const int nx = (l + 1 < DEPTH) ? 1 : 0; const int ln = nx ? l + 1 : l;
            EpiRes E{X, X + (size_t)MP * D, X, ml + 5120, ldin(10) + ln * D, WSP(float, WS_MOD) + (size_t)ln * NMOD * 6144 + 1024, WSP(bf16_t, WS_XG), WSP(float, WS_SSQ), nx};
            pg8::gemm_phase<EpiRes, pg8::StaticOrder, true, true>((LAS unsigned char*)lds, g, S, E);
            SEAM(p0 + 5);
        }
    }
#undef IN
#undef SEAM
#undef WSP
}

extern "C" void kernel_launch(void* const* d_in, const int* in_sizes, int n_in, void* d_out, int out_size, void* d_ws, size_t ws_size, hipStream_t stream) {
    static int grid = 0;
    if (grid == 0) {
        if (n_in != 25 || ws_size < WS_END) { fprintf(stderr, "kernel_launch: need 25 inputs and >= %zu bytes of workspace; got %d, %zu\n", (size_t)WS_END, n_in, ws_size); grid = -1; return; }
        int dev = 0, cus = 0, per_cu = 0;
        hipGetDevice(&dev);
        hipDeviceGetAttribute(&cus, hipDeviceAttributeMultiprocessorCount, dev);
        if (hipFuncSetAttribute((const void*)fwd_kernel, hipFuncAttributeMaxDynamicSharedMemorySize, LDS_BYTES) != hipSuccess) { fprintf(stderr, "kernel_launch: hipFuncSetAttribute failed\n"); grid = -1; return; }
        if (hipOccupancyMaxActiveBlocksPerMultiprocessor(&per_cu, (const void*)fwd_kernel, 512, LDS_BYTES) != hipSuccess || per_cu < 1) { fprintf(stderr, "kernel_launch: occupancy query says %d\n", per_cu); per_cu = 1; }
        (void)hipGetLastError();
        grid = cus * per_cu;
    }
    if (grid < 0) return;
    if (hipMemsetAsync(d_ws, 0, 16384, stream) != hipSuccess) { fprintf(stderr, "kernel_launch: memset failed\n"); return; }
    Args a{};
    for (int i = 0; i < 25; ++i) a.in[i] = (const float*)d_in[i];
    a.out = (float*)d_out; a.ws = (unsigned char*)d_ws;
#if MK_SINGLE
    a.ph_lo = 0; a.ph_hi = NPH;
    void* args[] = {&a};
    hipError_t e = hipLaunchCooperativeKernel((const void*)fwd_kernel, dim3(grid), dim3(512), args, LDS_BYTES, stream);
    if (e != hipSuccess) fprintf(stderr, "cooperative launch failed: %s (grid %d)\n", hipGetErrorString(e), grid);
#else
    for (int ph = 0; ph < NPH; ++ph) {
        a.ph_lo = ph; a.ph_hi = ph + 1;
        hipLaunchKernelGGL(fwd_kernel, dim3(grid), dim3(512), LDS_BYTES, stream, a);
    }
#endif
}
```

```cpp
#include <hip/hip_runtime.h>
#include <hip/hip_cooperative_groups.h>
#include <cstdio>
#include <cstdint>
namespace cg = cooperative_groups;
namespace pg8 {
#define PG8_LAS __attribute__((address_space(3)))
typedef unsigned short bf16_t;
typedef short bf16x8 __attribute__((ext_vector_type(8)));
typedef float f32x4 __attribute__((ext_vector_type(4)));
typedef unsigned u32x4 __attribute__((ext_vector_type(4)));
constexpr int BM = 256, BK = 64, HALF = 128, HTB = HALF * BK * 2  , STAGE_BYTES = 8 * HTB, NXCD = 8, WGM = 8;

__host__ __device__ __forceinline__ int lds_byte(int r, int c) { const int st = (r >> 4) * 2 + (c >> 5), rr = r & 15, cc = c & 31, ob = rr * 64 + cc * 2; return st * 1024 + (ob ^ (((ob >> 9) & 1) << 5)); }
__host__ __device__ __forceinline__ void stage_rc(int b, int& R, int& C) { const int st = b / 1024, sb = b % 1024, swz = sb ^ (((sb >> 9) & 1) << 5); R = (st >> 1) * 16 + swz / 64; C = (st & 1) * 32 + (swz % 64) / 2; }
__host__ __device__ __forceinline__ int perm32(int rho) { const int n = rho >> 4, i = rho & 15; return 8 * (i >> 2) + 4 * n + (i & 3); }

struct Unit { int pm, pn; };
struct Gemm { const bf16_t* A; const bf16_t* Bt; int M, N, K, Kl; };

struct StaticOrder {
    int nM, nN, nwg, G, c;
    __host__ __device__ void init(int M, int N, int G_, int c_) { nM = M / BM; nN = N / BM; nwg = nM * nN; G = G_; c = c_; }
    __host__ __device__ bool next(int i, Unit& u) const {
        const long L = (long)i * G + c; if (L >= nwg) return false;
        int wgid = (int)L; { const int q = nwg / NXCD, r = nwg % NXCD, xcd = wgid % NXCD, off = wgid / NXCD; wgid = (xcd < r ? xcd * (q + 1) : r * (q + 1) + (xcd - r) * q) + off; }
        const int nig = WGM * nN, gid = wgid / nig, fm = gid * WGM, gsz = (nM - fm) < WGM ? (nM - fm) : WGM;
        u.pm = fm + ((wgid % nig) % gsz); u.pn = (wgid % nig) / gsz; return true;
    }
    __device__ __forceinline__ void a_ready(const Unit&) const {}
    __device__ __forceinline__ void done(const Unit&) const {}
};
__device__ __forceinline__ unsigned cvt_pk_bf16(float lo, float hi) { unsigned r; asm volatile("v_cvt_pk_bf16_f32 %0, %1, %2" : "=v"(r) : "v"(lo), "v"(hi)); return r; }
template <class Epi, class Sched, bool ALIGN_EPI = false, bool SP2 = false>
__device__ __forceinline__ void gemm_phase(PG8_LAS unsigned char* lds, const Gemm g, const Sched& S, const Epi& E) {
    int tid_ = threadIdx.x; asm volatile("" : "+v"(tid_));
    const int tid = tid_, wid = __builtin_amdgcn_readfirstlane(tid >> 6), lane = tid & 63, wr = wid >> 2, wc = wid & 3, fr = lane & 15, fq = lane >> 4;
    const int K = g.K, nt = g.Kl / BK;
    unsigned voffA[2], voffB[2];
#pragma unroll
    for (int i = 0; i < 2; ++i) { int R, C; stage_rc(tid * 16 + i * 8192, R, C); const int Rb = Epi::PERM ? ((R & ~31) + perm32(R & 31)) : R;
        voffA[i] = (unsigned)(R * K + C) * 2u; voffB[i] = (unsigned)(Rb * K + C) * 2u; }
    const size_t kstep = (size_t)(BK * 2);
    const size_t hstep = (size_t)HALF * K * 2;
    const size_t tstep = 2 * hstep;
    const unsigned ldsw = (unsigned)wid * 1024u;
    const int aoff = lds_byte(wr * 64 + fr, fq * 8), boff = lds_byte(wc * 32 + fr, fq * 8);
#define PG8_SA(b, h) (((b) * 2 + (h)) * HTB)
#define PG8_SB(b, h) ((4 + (b) * 2 + (h)) * HTB)
#define PG8_STAGE(bufoff, gbase, voff) do { _Pragma("unroll") for (int _i = 0; _i < 2; ++_i) \
        __builtin_amdgcn_global_load_lds((const unsigned*)((const char*)(gbase) + (voff)[_i]), (PG8_LAS unsigned*)(lds + (bufoff) + ldsw + _i * 8192), 16, 0, 0); } while (0)
#define PG8_LDA(dst, b, h) do { _Pragma("unroll") for (int m = 0; m < 4; ++m) _Pragma("unroll") for (int k = 0; k < 2; ++k) dst[m][k] = *(const PG8_LAS bf16x8*)(lds + PG8_SA(b, h) + aoff + m * 2048 + k * 1024); } while (0)
#define PG8_LDB(dst, b, h) do { _Pragma("unroll") for (int n = 0; n < 2; ++n) _Pragma("unroll") for (int k = 0; k < 2; ++k) dst[n][k] = *(const PG8_LAS bf16x8*)(lds + PG8_SB(b, h) + boff + n * 2048 + k * 1024); } while (0)
#define PG8_MMA(ai, bj, At, Bt) do { __builtin_amdgcn_s_setprio(1); _Pragma("unroll") for (int m = 0; m < 4; ++m) _Pragma("unroll") for (int n = 0; n < 2; ++n) _Pragma("unroll") for (int k = 0; k < 2; ++k) \
        acc[ai][bj][m][n] = __builtin_amdgcn_mfma_f32_16x16x32_bf16(Bt[n][k], At[m][k], acc[ai][bj][m][n], 0, 0, 0); __builtin_amdgcn_s_setprio(0); } while (0)
#define PG8_WAIT_V(n) asm volatile("s_waitcnt vmcnt(" #n ")" ::: "memory")
#define PG8_WAIT_L(n) asm volatile("s_waitcnt lgkmcnt(" #n ")" ::: "memory")
#define PG8_BAR __builtin_amdgcn_s_barrier()
#define PG8_SCHED __builtin_amdgcn_sched_barrier(0)
    Unit cur, nxt; int ui = 0;
    if (!S.next(0, cur)) return;
    f32x4 acc[2][2][4][2];
#pragma unroll
    for (int a = 0; a < 2; ++a)
#pragma unroll
        for (int b = 0; b < 2; ++b)
#pragma unroll
            for (int m = 0; m < 4; ++m)
#pragma unroll
                for (int n = 0; n < 2; ++n) acc[a][b][m][n] = (f32x4){0.f, 0.f, 0.f, 0.f};
    bf16x8 At[4][2], B0[2][2], B1[2][2];
    const char* cA = (const char*)g.A + (size_t)cur.pm * tstep; const char* cB = (const char*)g.Bt + (size_t)cur.pn * tstep;
    S.a_ready(cur);
    if constexpr (SP2) {
        PG8_STAGE(PG8_SB(0, 0), cB, voffB); PG8_STAGE(PG8_SB(0, 1), cB + hstep, voffB); PG8_STAGE(PG8_SA(0, 0), cA, voffA); PG8_STAGE(PG8_SA(0, 1), cA + hstep, voffA);
        if (wr == 1) PG8_BAR;
        PG8_WAIT_V(2); PG8_BAR;
        PG8_STAGE(PG8_SB(1, 0), cB + kstep, voffB); PG8_STAGE(PG8_SA(1, 0), cA + kstep, voffA); PG8_STAGE(PG8_SB(1, 1), cB + hstep + kstep, voffB);
        PG8_WAIT_V(6); PG8_BAR;
    } else {
        PG8_STAGE(PG8_SB(0, 0), cB, voffB); PG8_STAGE(PG8_SA(0, 0), cA, voffA); PG8_STAGE(PG8_SB(0, 1), cB + hstep, voffB); PG8_STAGE(PG8_SA(0, 1), cA + hstep, voffA);
        if (wr == 1) PG8_BAR;
        PG8_WAIT_V(4); PG8_BAR;
        PG8_STAGE(PG8_SB(1, 0), cB + kstep, voffB); PG8_STAGE(PG8_SA(1, 0), cA + kstep, voffA); PG8_STAGE(PG8_SB(1, 1), cB + hstep + kstep, voffB);
        PG8_WAIT_V(6); PG8_BAR;
    }
    for (;;) {
        const bool has_next = S.next(ui + 1, nxt);
        const char* nA = has_next ? (const char*)g.A + (size_t)nxt.pm * tstep : cA; const char* nB = has_next ? (const char*)g.Bt + (size_t)nxt.pn * tstep : cB;
        for (int t = 0; t < nt; t += 2) {
            const bool last = (t == nt - 2);
            const char* a1 = cA + (size_t)(t + 1) * kstep;
            const char* a2 = last ? nA : cA + (size_t)(t + 2) * kstep; const char* b2 = last ? nB : cB + (size_t)(t + 2) * kstep;
            const char* a3 = a2 + kstep; const char* b3 = b2 + kstep;
            if (last && has_next) S.a_ready(nxt);
            if constexpr (SP2) {
            PG8_LDB(B0, 0, 0); PG8_LDB(B1, 0, 1); PG8_SCHED; PG8_LDA(At, 0, 0); PG8_STAGE(PG8_SA(1, 1), a1 + hstep, voffA);
            PG8_WAIT_V(8); PG8_WAIT_L(0); PG8_BAR; PG8_MMA(0, 0, At, B0); PG8_MMA(0, 1, At, B1); PG8_BAR; PG8_SCHED;
            PG8_LDA(At, 0, 1); PG8_STAGE(PG8_SB(0, 0), b2, voffB); PG8_STAGE(PG8_SB(0, 1), b2 + hstep, voffB); PG8_STAGE(PG8_SA(0, 0), a2, voffA);
            PG8_WAIT_V(8); PG8_WAIT_L(0); PG8_BAR; PG8_MMA(1, 0, At, B0); PG8_MMA(1, 1, At, B1); PG8_BAR; PG8_SCHED;
            PG8_LDB(B0, 1, 0); PG8_LDB(B1, 1, 1); PG8_SCHED; PG8_LDA(At, 1, 0); PG8_STAGE(PG8_SA(0, 1), a2 + hstep, voffA);
            PG8_WAIT_V(8); PG8_WAIT_L(0); PG8_BAR; PG8_MMA(0, 0, At, B0); PG8_MMA(0, 1, At, B1); PG8_BAR; PG8_SCHED;
            PG8_LDA(At, 1, 1); PG8_STAGE(PG8_SB(1, 0), b3, voffB); PG8_STAGE(PG8_SB(1, 1), b3 + hstep, voffB); PG8_STAGE(PG8_SA(1, 0), a3, voffA);
            PG8_WAIT_V(8); PG8_WAIT_L(0); PG8_BAR; PG8_MMA(1, 0, At, B0); PG8_MMA(1, 1, At, B1); PG8_BAR; PG8_SCHED;
            } else {
            PG8_LDB(B0, 0, 0); PG8_SCHED; PG8_LDA(At, 0, 0); PG8_STAGE(PG8_SA(1, 1), a1 + hstep, voffA);
            PG8_WAIT_L(8); PG8_BAR; PG8_WAIT_L(0); PG8_MMA(0, 0, At, B0); PG8_BAR; PG8_SCHED;
            PG8_LDB(B1, 0, 1); PG8_STAGE(PG8_SB(0, 0), b2, voffB);
            PG8_BAR; PG8_WAIT_L(0); PG8_MMA(0, 1, At, B1); PG8_BAR;
            PG8_LDA(At, 0, 1); PG8_STAGE(PG8_SA(0, 0), a2, voffA);
            PG8_BAR; PG8_WAIT_L(0); PG8_MMA(1, 0, At, B0); PG8_BAR; PG8_SCHED;
            PG8_STAGE(PG8_SB(0, 1), b2 + hstep, voffB);
            PG8_WAIT_V(6); PG8_BAR; PG8_MMA(1, 1, At, B1); PG8_BAR;
            PG8_LDB(B0, 1, 0); PG8_SCHED; PG8_LDA(At, 1, 0); PG8_STAGE(PG8_SA(0, 1), a2 + hstep, voffA);
            PG8_WAIT_L(8); PG8_BAR; PG8_WAIT_L(0); PG8_MMA(0, 0, At, B0); PG8_BAR; PG8_SCHED;
            PG8_LDB(B1, 1, 1); PG8_STAGE(PG8_SB(1, 0), b3, voffB);
            PG8_BAR; PG8_WAIT_L(0); PG8_MMA(0, 1, At, B1); PG8_BAR;
            PG8_LDA(At, 1, 1); PG8_STAGE(PG8_SA(1, 0), a3, voffA);
            PG8_BAR; PG8_WAIT_L(0); PG8_MMA(1, 0, At, B0); PG8_BAR; PG8_SCHED;
            PG8_STAGE(PG8_SB(1, 1), b3 + hstep, voffB);
            PG8_WAIT_V(6); PG8_BAR; PG8_MMA(1, 1, At, B1); PG8_BAR;
            }
        }
        if constexpr (ALIGN_EPI) { if (wr == 0) PG8_BAR; }
        if constexpr (!Epi::AFTER_DRAIN) { E(acc, cur, wr, wc, fr, fq); S.done(cur); }
        if (!has_next) break;
#pragma unroll
        for (int a = 0; a < 2; ++a)
#pragma unroll
            for (int b = 0; b < 2; ++b)
#pragma unroll
                for (int m = 0; m < 4; ++m)
#pragma unroll
                    for (int n = 0; n < 2; ++n) acc[a][b][m][n] = (f32x4){0.f, 0.f, 0.f, 0.f};
        cur = nxt; cA = nA; cB = nB; ++ui;
        if constexpr (ALIGN_EPI) { if (wr == 1) PG8_BAR; }
    }
    PG8_WAIT_V(0);
    if constexpr (!ALIGN_EPI) { if (wr == 0) PG8_BAR; }
    PG8_BAR;
    if constexpr (Epi::AFTER_DRAIN) { E.fused(acc, cur, wr, wc, fr, fq, lds, wid, lane); S.done(cur); }
#undef PG8_SA
#undef PG8_SB
#undef PG8_STAGE
#undef PG8_LDA
#undef PG8_LDB
#undef PG8_MMA
#undef PG8_WAIT_V
#undef PG8_WAIT_L
#undef PG8_BAR
#undef PG8_SCHED
}
}

#define DI __device__ __forceinline__
#define LAS __attribute__((address_space(3)))
typedef unsigned short bf16_t;
typedef short bf16x8 __attribute__((ext_vector_type(8)));
typedef float f32x4 __attribute__((ext_vector_type(4)));
typedef float f32x16 __attribute__((ext_vector_type(16)));
typedef unsigned u32x4 __attribute__((ext_vector_type(4)));
typedef unsigned u32x2 __attribute__((ext_vector_type(2)));
typedef float f32x2_t __attribute__((ext_vector_type(2)));
typedef __bf16 bf16x2_t __attribute__((ext_vector_type(2)));

#ifndef REP_P
#define REP_P 1
#endif
#ifndef REP_G1
#define REP_G1 1
#endif
#ifndef REP_PREP
#define REP_PREP 1
#endif
#ifndef REP_ATTN
#define REP_ATTN 1
#endif
#ifndef REP_G3
#define REP_G3 1
#endif
#ifndef SYNCX
#define SYNCX 0
#endif
#ifndef MK_SINGLE
#define MK_SINGLE 1
#endif

constexpr int D = 1024, MP = 8192, MS = 16384, M = MP + MS, DEPTH = 4, NMOD = 9, INW = 2304, FF = 4096;
constexpr int NPH = 2 + 6 * DEPTH;
constexpr float QSCALE = 0.125f * 1.4426950408889634f, LOG2E = 1.4426950408889634f, EPS = 1e-6f;
constexpr size_t OFF_AK = 25165824, OFF_AV = 29360128, OFF_NK = 33554432, OFF_NV = 46137344;
constexpr size_t MiB = 1u << 20;
constexpr size_t WS_MOD = 1 * MiB, WS_BIAS1 = 2 * MiB, WS_BIAS2 = 3 * MiB, WS_SSQ = 4 * MiB;
constexpr size_t WS_KCA = 6 * MiB, WS_VCA = 8 * MiB, WS_KCN = 10 * MiB, WS_VCN = 16 * MiB;
constexpr size_t WS_WIN = 22 * MiB, WS_WOUT = 40 * MiB, WS_W1 = 48 * MiB, WS_W2 = 80 * MiB;
constexpr size_t WS_XG = 112 * MiB, WS_H1 = 160 * MiB, WS_RAW = 160 * MiB, WS_Q = 268 * MiB, WS_K = 304 * MiB, WS_VT = 328 * MiB, WS_ATT = 352 * MiB, WS_END = 400 * MiB;
constexpr int LDS_BYTES = 147456;

DI unsigned pk2(float lo, float hi) { f32x2_t v = {lo, hi}; bf16x2_t b = __builtin_convertvector(v, bf16x2_t); return __builtin_bit_cast(unsigned, b); }
DI float bflo(unsigned w) { return __uint_as_float(w << 16); }
DI float bfhi(unsigned w) { return __uint_as_float(w & 0xffff0000u); }
DI void unpack8(const u32x4 w, float (&v)[8]) { v[0] = bflo(w.x); v[1] = bfhi(w.x); v[2] = bflo(w.y); v[3] = bfhi(w.y); v[4] = bflo(w.z); v[5] = bfhi(w.z); v[6] = bflo(w.w); v[7] = bfhi(w.w); }
DI int modidx(int row) { return row < MP ? 0 : 1 + ((row - MP) >> 11); }
DI float wave_sum(float v) {
#pragma unroll
    for (int o = 1; o < 64; o <<= 1) v += __shfl_xor(v, o);
    return v;
}
DI float sigmoidf_(float x) { return 1.f / (1.f + __expf(-x)); }
DI int crow(int i, int hi) { return (i & 3) + 8 * (i >> 2) + 4 * hi; }
DI int permkey(int p) { const int s = p >> 4, hh = (p >> 3) & 1, jj = p & 7; return 16 * s + 8 * (jj >> 2) + 4 * hh + (jj & 3); }

template <int ACT> struct EpiLin {
    static constexpr bool PERM = true, AFTER_DRAIN = false;
    bf16_t* O; int ldc; const float* bias; int ldb; const float* ssq;
    DI void operator()(const f32x4 (&acc)[2][2][4][2], const pg8::Unit& u, int wr, int wc, int fr, int fq) const {
        const int row0 = u.pm * 256 + wr * 64 + fr, col0 = u.pn * 256 + wc * 32 + 8 * fq;
        const float* bp = bias + (size_t)modidx(u.pm * 256) * ldb + col0;
        f32x4 bv[2][2];
#pragma unroll
        for (int bj = 0; bj < 2; ++bj)
#pragma unroll
            for (int n = 0; n < 2; ++n) bv[bj][n] = *(const f32x4*)(bp + bj * 128 + 4 * n);
        float rs8[8];
        {
            f32x4 s4[8];
#pragma unroll
            for (int k = 0; k < 8; ++k) s4[k] = *(const f32x4*)(ssq + (size_t)(row0 + (k >> 2) * 128 + (k & 3) * 16) * 16 + 4 * fq);
#pragma unroll
            for (int k = 0; k < 8; ++k) { float s = (s4[k].x + s4[k].y) + (s4[k].z + s4[k].w); s += __shfl_xor(s, 16); s += __shfl_xor(s, 32); rs8[k] = rsqrtf(s * (1.f / 1024.f) + EPS); }
        }
#pragma unroll
        for (int ai = 0; ai < 2; ++ai)
#pragma unroll
            for (int m = 0; m < 4; ++m) {
                const int row = row0 + ai * 128 + m * 16;
                const float rstd = rs8[ai * 4 + m];
                bf16_t* rowp = O + (size_t)row * ldc + col0;
#pragma unroll
                for (int bj = 0; bj < 2; ++bj) {
                    f32x4 v0 = acc[ai][bj][m][0] * rstd + bv[bj][0], v1 = acc[ai][bj][m][1] * rstd + bv[bj][1];
                    if (ACT == 1) {
#pragma unroll
                        for (int e = 0; e < 4; ++e) { const float a = fmaxf(v0[e], 0.f), b = fmaxf(v1[e], 0.f); v0[e] = a * a; v1[e] = b * b; }
                    }
                    u32x4 w; w.x = pk2(v0[0], v0[1]); w.y = pk2(v0[2], v0[3]); w.z = pk2(v1[0], v1[1]); w.w = pk2(v1[2], v1[3]);
                    *(u32x4*)(rowp + bj * 128) = w;
                }
            }
    }
};
struct EpiRes {
    static constexpr bool PERM = false, AFTER_DRAIN = false;
    const float* baseP; const float* baseS; float* out; const float* gate; const float* nw; const float* sc; bf16_t* xg; float* ssq; int has_next;
    int mode; f32x4* part; unsigned* flag;
    DI void operator()(f32x4 (&acc)[2][2][4][2], const pg8::Unit& u, int wr, int wc, int fr, int fq) const {
        f32x4* pp = part + threadIdx.x; asm volatile("" : "+v"(pp));
        if (mode == 2) {
#pragma unroll
            for (int ai = 0; ai < 2; ++ai)
#pragma unroll
                for (int bj = 0; bj < 2; ++bj)
#pragma unroll
                    for (int m = 0; m < 4; ++m)
#pragma unroll
                        for (int n = 0; n < 2; ++n) pp[(size_t)((((ai * 2 + bj) * 4 + m) * 2 + n) * 512)] = acc[ai][bj][m][n];
            return;
        }
        if (mode == 1) {
            const unsigned long long t0 = __builtin_amdgcn_s_memrealtime();
            while ((unsigned)__builtin_amdgcn_readfirstlane(__hip_atomic_load(flag, __ATOMIC_RELAXED, __HIP_MEMORY_SCOPE_AGENT)) == 0u) {
                if (__builtin_amdgcn_s_memrealtime() - t0 > 2000000ull) break;
                __builtin_amdgcn_s_sleep(2); }
            __builtin_amdgcn_fence(__ATOMIC_ACQUIRE, "agent");
            asm volatile("s_waitcnt vmcnt(0)" ::: "memory");
#pragma unroll
            for (int ai = 0; ai < 2; ++ai)
#pragma unroll
                for (int bj = 0; bj < 2; ++bj) {
#pragma unroll
                    for (int m = 0; m < 4; ++m) {
#pragma unroll
                        for (int n = 0; n < 2; ++n) acc[ai][bj][m][n] += pp[(size_t)((((ai * 2 + bj) * 4 + m) * 2 + n) * 512)];
                        if (m & 1) asm volatile("" ::: "memory");
                    }
                }
        }
        const int col0 = u.pn * 256 + wc * 32 + 4 * fq, j = modidx(u.pm * 256);
        const float* gp = gate + (size_t)j * 6144 + col0;
        f32x4 gv[2][2], gn[2][2];
#pragma unroll
        for (int bj = 0; bj < 2; ++bj)
#pragma unroll
            for (int n = 0; n < 2; ++n) {
                gv[bj][n] = *(const f32x4*)(gp + bj * 128 + n * 16);
                if (has_next) gn[bj][n] = *(const f32x4*)(nw + col0 + bj * 128 + n * 16) * (*(const f32x4*)(sc + (size_t)j * 6144 + col0 + bj * 128 + n * 16) + 1.0f);
                else gn[bj][n] = (f32x4){0.f, 0.f, 0.f, 0.f};
            }
#pragma unroll
        for (int hp = 0; hp < 4; ++hp) {
            const int ai = hp >> 1, m0 = (hp & 1) * 2;
            f32x4 pre[2][2][2];
#pragma unroll
            for (int mm = 0; mm < 2; ++mm) {
                const int row = u.pm * 256 + ai * 128 + wr * 64 + (m0 + mm) * 16 + fr;
                const float* b = (row < MP) ? baseP + (size_t)row * D : baseS + (size_t)(row - MP) * D;
#pragma unroll
                for (int bj = 0; bj < 2; ++bj)
#pragma unroll
                    for (int n = 0; n < 2; ++n) pre[mm][bj][n] = *(const f32x4*)(b + col0 + bj * 128 + n * 16);
            }
#pragma unroll
            for (int mm = 0; mm < 2; ++mm) {
                const int m = m0 + mm;
                const int row = u.pm * 256 + ai * 128 + wr * 64 + m * 16 + fr;
                float q = 0.f;
#pragma unroll
                for (int bj = 0; bj < 2; ++bj)
#pragma unroll
                    for (int n = 0; n < 2; ++n) {
                        const int c = col0 + bj * 128 + n * 16;
                        const f32x4 x = pre[mm][bj][n] + gv[bj][n] * acc[ai][bj][m][n];
                        __builtin_nontemporal_store(x, (f32x4*)(out + (size_t)row * D + c));
                        q += (x.x * x.x + x.y * x.y) + (x.z * x.z + x.w * x.w);
                        if (has_next) { const f32x4 y = x * gn[bj][n]; u32x2 w; w.x = pk2(y.x, y.y); w.y = pk2(y.z, y.w); *(u32x2*)(xg + (size_t)row * D + c) = w; }
                    }
                q += __shfl_xor(q, 16); q += __shfl_xor(q, 32);
                if (fq == 0 && has_next) ssq[(size_t)row * 16 + u.pn * 4 + wc] = q;
            }
        }
    }
};

struct RangeOrder : pg8::StaticOrder {
    int lo, hi, fix;
    __host__ __device__ bool next(int i, pg8::Unit& u) const {
        long L;
        if (fix >= 0) { if (i > 0) return false; L = fix; } else { L = (long)lo + (long)i * G + c; if (L >= hi) return false; }
        int wgid = (int)L; { const int q = nwg / pg8::NXCD, r = nwg % pg8::NXCD, xcd = wgid % pg8::NXCD, off = wgid / pg8::NXCD; wgid = (xcd < r ? xcd * (q + 1) : r * (q + 1) + (xcd - r) * q) + off; }
        const int nig = pg8::WGM * nN, gid = wgid / nig, fm = gid * pg8::WGM, gsz = (nM - fm) < pg8::WGM ? (nM - fm) : pg8::WGM;
        u.pm = fm + ((wgid % nig) % gsz); u.pn = (wgid % nig) / gsz; return true;
    }
};

DI void transpose_item(const float* W, int K, int N, bf16_t* WT, LAS float* scr, int item, int lane) {
    const int nblk = N / 64, kb = item / nblk, nb = item - kb * nblk, k0 = 64 * kb, n0 = 64 * nb;
    const int kr = lane >> 4, nq = lane & 15;
    f32x4 v[16];
#pragma unroll
    for (int i = 0; i < 16; ++i) v[i] = *(const f32x4*)(W + (size_t)(k0 + 4 * i + kr) * N + n0 + 4 * nq);
#pragma unroll
    for (int i = 0; i < 16; ++i) { LAS float* d = scr + (4 * i + kr) * 65 + 4 * nq; d[0] = v[i].x; d[1] = v[i].y; d[2] = v[i].z; d[3] = v[i].w; }
    asm volatile("s_waitcnt lgkmcnt(0)" ::: "memory");
    const int c = lane & 7;
#pragma unroll
    for (int j = 0; j < 8; ++j) { const int n = (lane >> 3) + 8 * j; const LAS float* s = scr + (8 * c) * 65 + n;
        u32x4 o; o.x = pk2(s[0 * 65], s[1 * 65]); o.y = pk2(s[2 * 65], s[3 * 65]); o.z = pk2(s[4 * 65], s[5 * 65]); o.w = pk2(s[6 * 65], s[7 * 65]);
        *(u32x4*)(WT + (size_t)(n0 + n) * K + k0 + 8 * c) = o; }
    asm volatile("s_waitcnt lgkmcnt(0)" ::: "memory");
}
DI void gemv9_unit(const float* W, int N, int n0, const float* v0, const float* v1, int vs, bool do_silu, const float* badd, float* out, int ostride, float* scr, int tid) {
    const int wave = __builtin_amdgcn_readfirstlane(tid >> 6), lane = tid & 63;
    float* sv = scr; float* red = scr + NMOD * 1024;
    for (int idx = tid; idx < NMOD * 1024; idx += 512) {
        const int j = idx >> 10, k = idx & 1023;
        float v = (j == 0) ? v0[k] : v1[(size_t)(j - 1) * vs + k];
        if (do_silu) v = v * sigmoidf_(v);
        sv[idx] = v;
    }
    __syncthreads();
    float acc[NMOD];
#pragma unroll
    for (int j = 0; j < NMOD; ++j) acc[j] = 0.f;
    const float* wp = W + (size_t)(wave * 128) * N + n0 + lane;
#pragma unroll 2
    for (int k = 0; k < 128; k += 4) {
        const float w0 = wp[(size_t)k * N], w1 = wp[(size_t)(k + 1) * N], w2 = wp[(size_t)(k + 2) * N], w3 = wp[(size_t)(k + 3) * N];
#pragma unroll
        for (int j = 0; j < NMOD; ++j) {
            const f32x4 s = *(const f32x4*)(sv + j * 1024 + wave * 128 + k);
            acc[j] += (s.x * w0 + s.y * w1) + (s.z * w2 + s.w * w3);
        }
    }
#pragma unroll
    for (int j = 0; j < NMOD; ++j) red[(wave * NMOD + j) * 64 + lane] = acc[j];
    __syncthreads();
    for (int idx = tid; idx < NMOD * 64; idx += 512) {
        const int j = idx >> 6, ln = idx & 63; float s = 0.f;
#pragma unroll
        for (int w = 0; w < 8; ++w) s += red[(w * NMOD + j) * 64 + ln];
        if (badd) s += badd[n0 + ln];
        out[(size_t)j * ostride + n0 + ln] = s;
    }
    __syncthreads();
}

DI void conv_unit(int ct, int l, const bf16_t* RAW, bf16_t* ATT, const float* dw_w, const float* dw_b, const float* ln_g, const float* ln_b, float* lds, int tid) {
    const int row0 = ct * 64;
    int seq0, L;
    if (row0 < MP) { seq0 = row0 & ~255; L = 256; } else { seq0 = MP + ((row0 - MP) & ~2047); L = 2048; }
    const int t0 = row0 - seq0;
    {
        u32x4 wa[6], wg[6];
#pragma unroll
        for (int i = 0; i < 6; ++i) {
            const int it = tid + 512 * i, rr = it >> 5, c8 = it & 31, t = t0 - 15 + rr;
            if (it < 94 * 32 && t >= 0 && t < L) { const bf16_t* p = RAW + (size_t)(seq0 + t) * INW + c8 * 8; wa[i] = *(const u32x4*)p; wg[i] = *(const u32x4*)(p + 256); }
            else { wa[i] = (u32x4){0u, 0u, 0u, 0u}; wg[i] = (u32x4){0u, 0u, 0u, 0u}; }
        }
#pragma unroll
        for (int i = 0; i < 6; ++i) {
            const int it = tid + 512 * i, rr = it >> 5, c8 = it & 31;
            if (it < 94 * 32) {
                float a[8], g[8], hv[8]; unpack8(wa[i], a); unpack8(wg[i], g);
#pragma unroll
                for (int e2 = 0; e2 < 8; ++e2) hv[e2] = a[e2] * sigmoidf_(g[e2]);
                float* d = lds + rr * 256 + c8 * 8;
                *(f32x4*)d = (f32x4){hv[0], hv[1], hv[2], hv[3]}; *(f32x4*)(d + 4) = (f32x4){hv[4], hv[5], hv[6], hv[7]};
            }
        }
    }
    __syncthreads();
    const int c = tid & 255, th = tid >> 8;
    float w[31];
#pragma unroll
    for (int k = 0; k < 31; ++k) w[k] = dw_w[(size_t)(l * 31 + k) * 256 + c];
    const float bias = dw_b[l * 256 + c];
    float outv[32];
#pragma unroll
    for (int ch = 0; ch < 2; ++ch) {
        float hv[46];
#pragma unroll
        for (int i = 0; i < 46; ++i) hv[i] = lds[(th * 32 + ch * 16 + i) * 256 + c];
#pragma unroll
        for (int o = 0; o < 16; ++o) {
            float s = bias;
#pragma unroll
            for (int k = 0; k < 31; ++k) s += hv[o + k] * w[k];
            outv[ch * 16 + o] = s;
        }
    }
    __syncthreads();
#pragma unroll
    for (int o = 0; o < 32; ++o) lds[(th * 32 + o) * 256 + c] = outv[o];
    __syncthreads();
    const int wave = tid >> 6, lane = tid & 63;
    const f32x4 g4 = *(const f32x4*)(ln_g + l * 256 + 4 * lane), b4 = *(const f32x4*)(ln_b + l * 256 + 4 * lane);
#pragma unroll
    for (int i = 0; i < 8; ++i) {
        const int tk = wave * 8 + i;
        const f32x4 v = *(const f32x4*)(lds + tk * 256 + 4 * lane);
        const float mean = wave_sum((v.x + v.y) + (v.z + v.w)) * (1.f / 256.f);
        const f32x4 dv = v - mean;
        const float var = wave_sum((dv.x * dv.x + dv.y * dv.y) + (dv.z * dv.z + dv.w * dv.w)) * (1.f / 256.f);
        const float rstd = rsqrtf(var + EPS);
        f32x4 y = dv * rstd * g4 + b4;
        y.x *= sigmoidf_(y.x); y.y *= sigmoidf_(y.y); y.z *= sigmoidf_(y.z); y.w *= sigmoidf_(y.w);
        u32x2 o; o.x = pk2(y.x, y.y); o.y = pk2(y.z, y.w);
        *(u32x2*)(ATT + (size_t)(row0 + tk) * D + 4 * lane) = o;
    }
    __syncthreads();
}

struct PrepP { const bf16_t* RAW; bf16_t* Q; bf16_t* K; bf16_t* VT; float* out; const float *aqg, *akg, *nqg, *nkg; };
DI void qkv_unit(int ct, int l, const PrepP& P, bf16_t* ldsv, int tid) {
    const int row0 = ct * 64;
    const bool prompt = row0 < MP;
    int seq0, L, sb;
    if (prompt) { seq0 = row0 & ~255; L = 256; sb = row0 >> 8; } else { seq0 = MP + ((row0 - MP) & ~2047); L = 2048; sb = (row0 - MP) >> 11; }
    const int t0 = row0 - seq0;
    {
    const int lane = tid & 63, wave = __builtin_amdgcn_readfirstlane(tid >> 6), half = lane >> 5;
    for (int wi = wave; wi < 40; wi += 8) {
        const int hd = wi >> 1, tok = (wi & 1) * 32 + (lane & 31);
        const int row = row0 + tok, t = t0 + tok;
        int rcol; const float* gw; bool isq;
        if (hd < 6) { rcol = 512 + 64 * hd; gw = P.aqg; isq = true; }
        else if (hd < 8) { rcol = 896 + 64 * (hd - 6); gw = P.akg; isq = false; }
        else if (hd < 14) { rcol = 1152 + 64 * (hd - 8); gw = P.nqg; isq = true; }
        else { rcol = 1536 + 64 * (hd - 14); gw = P.nkg; isq = false; }
        float v[32];
        const bf16_t* rp = P.RAW + (size_t)row * INW + rcol + 32 * half;
#pragma unroll
        for (int c = 0; c < 4; ++c) { const u32x4 wv = *(const u32x4*)(rp + 8 * c); float tmp[8]; unpack8(wv, tmp);
#pragma unroll
            for (int e2 = 0; e2 < 8; ++e2) v[8 * c + e2] = tmp[e2]; }
        float ss = 0.f;
#pragma unroll
        for (int d = 0; d < 32; ++d) ss += v[d] * v[d];
        ss += __shfl_xor(ss, 32);
        const float rstd = rsqrtf(ss * (1.f / 64.f) + EPS);
        const float* gp = gw + l * 64 + 32 * half;
#pragma unroll
        for (int c4 = 0; c4 < 8; ++c4) { const f32x4 g4 = *(const f32x4*)(gp + 4 * c4); v[4 * c4] *= rstd * g4.x; v[4 * c4 + 1] *= rstd * g4.y; v[4 * c4 + 2] *= rstd * g4.z; v[4 * c4 + 3] *= rstd * g4.w; }
        if ((!prompt) && (hd < 8)) {
            const float pos = (float)(half ? (t & 63) : (t >> 6));
#pragma unroll
            for (int j = 0; j < 16; ++j) {
                const float inv = exp2f(-(float)j * 0.8304820237218406f);
                float sn, cs; __sincosf(pos * inv, &sn, &cs);
                const float a = v[j], b = v[16 + j];
                v[j] = a * cs - b * sn; v[16 + j] = b * cs + a * sn;
            }
        }
        if (isq) {
            const int qh = (hd < 6) ? hd : 6 + (hd - 8);
            bf16_t* qp = P.Q + (prompt ? ((size_t)(sb * 12 + qh) * 8 + (t >> 5)) * 2048 : (size_t)MP * 768 + ((size_t)(sb * 12 + qh) * 64 + (t >> 5)) * 2048) + (t & 31) * 8 + half * 1024;
#pragma unroll
            for (int c = 0; c < 4; ++c) {
                u32x4 o; o.x = pk2(v[8 * c] * QSCALE, v[8 * c + 1] * QSCALE); o.y = pk2(v[8 * c + 2] * QSCALE, v[8 * c + 3] * QSCALE);
                o.z = pk2(v[8 * c + 4] * QSCALE, v[8 * c + 5] * QSCALE); o.w = pk2(v[8 * c + 6] * QSCALE, v[8 * c + 7] * QSCALE);
                *(u32x4*)(qp + c * 256) = o;
            }
        } else {
            const int kh = (hd < 8) ? (hd - 6) : 2 + (hd - 14);
            bf16_t* kp = P.K + (prompt ? ((size_t)(sb * 8 + kh) * 8 + (t >> 5)) * 2048 : (size_t)MP * 512 + ((size_t)(sb * 8 + kh) * 64 + (t >> 5)) * 2048) + (t & 31) * 8 + half * 1024;
#pragma unroll
            for (int c = 0; c < 4; ++c) {
                u32x4 o; o.x = pk2(v[8 * c], v[8 * c + 1]); o.y = pk2(v[8 * c + 2], v[8 * c + 3]); o.z = pk2(v[8 * c + 4], v[8 * c + 5]); o.w = pk2(v[8 * c + 6], v[8 * c + 7]);
                *(u32x4*)(kp + c * 256) = o;
            }
            if (prompt) {
                float* op;
                if (hd < 8) op = P.out + OFF_AK + ((((size_t)sb * 4 + l) * 256 + t) * 2 + (hd - 6)) * 64 + 32 * half;
                else        op = P.out + OFF_NK + ((((size_t)sb * 4 + l) * 256 + t) * 6 + (hd - 14)) * 64 + 32 * half;
#pragma unroll
                for (int c4 = 0; c4 < 8; ++c4) *(f32x4*)(op + 4 * c4) = (f32x4){v[4 * c4], v[4 * c4 + 1], v[4 * c4 + 2], v[4 * c4 + 3]};
            }
        }
    }
    }
    {
        u32x4 wv8[8];
#pragma unroll
        for (int i = 0; i < 8; ++i) {
            const int it = tid + 512 * i, tok = it >> 6, cc = (it & 63) * 8, rcol = (cc < 128) ? 1024 + cc : 1920 + (cc - 128);
            wv8[i] = *(const u32x4*)(P.RAW + (size_t)(row0 + tok) * INW + rcol);
        }
#pragma unroll
        for (int i = 0; i < 8; ++i) {
            const int it = tid + 512 * i, tok = it >> 6, cc = (it & 63) * 8;
            const u32x4 wv = wv8[i];
            *(u32x4*)(ldsv + tok * 512 + cc) = wv;
            if (prompt) {
                float v[8]; unpack8(wv, v);
                const int t = t0 + tok; float* op;
                if (cc < 128) op = P.out + OFF_AV + (((size_t)sb * 4 + l) * 256 + t) * 128 + cc;
                else          op = P.out + OFF_NV + (((size_t)sb * 4 + l) * 256 + t) * 384 + (cc - 128);
                *(f32x4*)op = (f32x4){v[0], v[1], v[2], v[3]}; *(f32x4*)(op + 4) = (f32x4){v[4], v[5], v[6], v[7]};
            }
        }
    }
    __syncthreads();
    for (int it = tid; it < 512 * 8; it += 512) {
        const int hd_d = it & 511, g = it >> 9;
        unsigned short e[8];
#pragma unroll
        for (int jj = 0; jj < 8; ++jj) { const int p = 8 * g + jj; const int key = (p & ~31) + permkey(p & 31); e[jj] = ldsv[key * 512 + hd_d]; }
        u32x4 o; o.x = e[0] | ((unsigned)e[1] << 16); o.y = e[2] | ((unsigned)e[3] << 16); o.z = e[4] | ((unsigned)e[5] << 16); o.w = e[6] | ((unsigned)e[7] << 16);
        const int vh = hd_d >> 6, dd = hd_d & 63, tile = (t0 >> 5) + (g >> 2);
        const size_t base = prompt ? ((size_t)(sb * 8 + vh) * 8 + tile) * 2048 : (size_t)MP * 512 + ((size_t)(sb * 8 + vh) * 64 + tile) * 2048;
        *(u32x4*)(P.VT + base + ((((dd >> 5) * 2 + ((g >> 1) & 1)) * 2 + (g & 1)) * 32 + (dd & 31)) * 8) = o;
    }
    __syncthreads();
}

struct Seg { const bf16_t* k; const bf16_t* v; int nt; };
#define MFMA32(a, b, c) __builtin_amdgcn_mfma_f32_32x32x16_bf16((a), (b), (c), 0, 0, 0)
DI void issue_tile(const Seg& A, const Seg& B, int t, int lane, LAS unsigned char* slot) {
    const bf16_t* kp = (t < A.nt) ? A.k + (size_t)t * 2048 : B.k + (size_t)(t - A.nt) * 2048;
    const bf16_t* vp = (t < A.nt) ? A.v + (size_t)t * 2048 : B.v + (size_t)(t - A.nt) * 2048;
#pragma unroll
    for (int i = 0; i < 4; ++i) __builtin_amdgcn_global_load_lds((const unsigned*)(kp + i * 512 + lane * 8), (LAS unsigned*)(slot + i * 1024), 16, 0, 0);
#pragma unroll
    for (int i = 0; i < 4; ++i) __builtin_amdgcn_global_load_lds((const unsigned*)(vp + i * 512 + lane * 8), (LAS unsigned*)(slot + 4096 + i * 1024), 16, 0, 0);
}
template <bool NA, int NQB> DI void attn_wave(const bf16_t* Qp, const Seg A, const Seg B, bf16_t* Op, const float* rpbh, int r, int rs, int lane_, LAS unsigned char* ring, LAS float* biasl, int qoff) {
    int lane = lane_; asm volatile("" : "+v"(lane));
    const int r32 = lane & 31, hi = lane >> 5;
    const int nt = A.nt + B.nt;
    issue_tile(A, B, 0, lane, ring);
    issue_tile(A, B, 1, lane, ring + 8192);
    if (NA) { for (int i = lane; i < 15 * 31; i += 64) biasl[i] = rpbh[i] * LOG2E; }
    bf16x8 qf[NQB][4];
#pragma unroll
    for (int qb = 0; qb < NQB; ++qb)
#pragma unroll
        for (int kk = 0; kk < 4; ++kk) qf[qb][kk] = *(const bf16x8*)(Qp + (qoff + qb) * 2048 + kk * 512 + lane * 8);
    f32x16 o[NQB][2];
#pragma unroll
    for (int a = 0; a < NQB; ++a)
#pragma unroll
        for (int b = 0; b < 2; ++b)
#pragma unroll
            for (int i = 0; i < 16; ++i) o[a][b][i] = 0.f;
    float mrun[NQB], lrun[NQB];
#pragma unroll
    for (int a = 0; a < NQB; ++a) { mrun[a] = -1e30f; lrun[a] = 0.f; }
    asm volatile("s_waitcnt vmcnt(0)" ::: "memory");
#pragma nounroll
    for (int t = 0; t < nt; ++t) {
        LAS unsigned char* slot = ring + (t & 1) * 8192;
        if (t + 1 < nt) asm volatile("s_waitcnt vmcnt(8)" ::: "memory"); else asm volatile("s_waitcnt vmcnt(0)" ::: "memory");
        bf16x8 kf[4], vf[2][2];
#pragma unroll
        for (int kk = 0; kk < 4; ++kk) kf[kk] = *(const LAS bf16x8*)(slot + kk * 1024 + lane * 16);
#pragma unroll
        for (int db = 0; db < 2; ++db)
#pragma unroll
            for (int s2 = 0; s2 < 2; ++s2) vf[db][s2] = *(const LAS bf16x8*)(slot + 4096 + (db * 2 + s2) * 1024 + lane * 16);
        asm volatile("s_waitcnt lgkmcnt(0)" ::: "memory");
        if (t + 2 < nt) issue_tile(A, B, t + 2, lane, slot);
#pragma unroll
        for (int qb = 0; qb < NQB; ++qb) {
            f32x16 s;
#pragma unroll
            for (int i = 0; i < 16; ++i) s[i] = 0.f;
#pragma unroll
            for (int kk = 0; kk < 4; ++kk) s = MFMA32(kf[kk], qf[qb][kk], s);
            if (NA) {
                if (t < A.nt) {
                    const int a = t >> 1, half = t & 1;
                    const int qc = 32 * (qoff + qb) + r32, cs = min(max(qc - 8, 0), 48);
                    const int kc0 = 32 * half + 4 * hi;
                    const LAS float* bp = biasl + (rs + a - r + 7) * 31 + (kc0 - qc + 15);
                    const unsigned u0 = (unsigned)(kc0 - cs);
                    float bia[16];
#pragma unroll
                    for (int i = 0; i < 16; ++i) bia[i] = bp[(i & 3) + 8 * (i >> 2)];
                    asm volatile("" : "+v"(bia[0]), "+v"(bia[1]), "+v"(bia[2]), "+v"(bia[3]), "+v"(bia[4]), "+v"(bia[5]), "+v"(bia[6]), "+v"(bia[7]),
                                      "+v"(bia[8]), "+v"(bia[9]), "+v"(bia[10]), "+v"(bia[11]), "+v"(bia[12]), "+v"(bia[13]), "+v"(bia[14]), "+v"(bia[15]));
#pragma unroll
                    for (int i = 0; i < 16; ++i) {
                        const bool valid = (u0 + (unsigned)((i & 3) + 8 * (i >> 2))) < 16u;
                        s[i] = valid ? s[i] + bia[i] : -1e30f;
                    }
                }
            }
            float mx = s[0];
#pragma unroll
            for (int i = 1; i < 16; ++i) mx = fmaxf(mx, s[i]);
            mx = fmaxf(mx, __shfl_xor(mx, 32));
            const float mn = fmaxf(mrun[qb], mx);
            const float alpha = __builtin_amdgcn_exp2f(mrun[qb] - mn);
            mrun[qb] = mn;
            float ps = 0.f;
#pragma unroll
            for (int i = 0; i < 16; ++i) { const float p = __builtin_amdgcn_exp2f(s[i] - mn); s[i] = p; ps += p; }
            lrun[qb] = lrun[qb] * alpha + ps;
#pragma unroll
            for (int i = 0; i < 16; ++i) { o[qb][0][i] *= alpha; o[qb][1][i] *= alpha; }
            u32x4 p0, p1;
            p0.x = pk2(s[0], s[1]); p0.y = pk2(s[2], s[3]); p0.z = pk2(s[4], s[5]); p0.w = pk2(s[6], s[7]);
            p1.x = pk2(s[8], s[9]); p1.y = pk2(s[10], s[11]); p1.z = pk2(s[12], s[13]); p1.w = pk2(s[14], s[15]);
            const bf16x8 P0 = __builtin_bit_cast(bf16x8, p0), P1 = __builtin_bit_cast(bf16x8, p1);
#pragma unroll
            for (int db = 0; db < 2; ++db) { o[qb][db] = MFMA32(vf[db][0], P0, o[qb][db]); o[qb][db] = MFMA32(vf[db][1], P1, o[qb][db]); }
        }
    }
#pragma unroll
    for (int qb = 0; qb < NQB; ++qb) {
        const float lt = lrun[qb] + __shfl_xor(lrun[qb], 32);
        const float inv = 1.f / lt;
        bf16_t* orow = Op + (size_t)(32 * (qoff + qb) + r32) * D;
#pragma unroll
        for (int db = 0; db < 2; ++db)
#pragma unroll
            for (int g = 0; g < 4; ++g) {
                u32x2 w; w.x = pk2(o[qb][db][4 * g] * inv, o[qb][db][4 * g + 1] * inv); w.y = pk2(o[qb][db][4 * g + 2] * inv, o[qb][db][4 * g + 3] * inv);
                *(u32x2*)(orow + 32 * db + 8 * g + 4 * hi) = w;
            }
    }
}

struct AttnP { const bf16_t *Q, *K, *VT, *KCA, *VCA, *KCN, *VCN; bf16_t* ATT; const float* rpb; };
DI void attn_run_unit(int uid, int qsel, int l, const AttnP& P, int lane, LAS unsigned char* ring, LAS float* biasl, bool shared, int wave, LAS unsigned char* lds0) {
    const size_t QS = (size_t)MP * 768, KS = (size_t)MP * 512;
    Seg A, B{nullptr, nullptr, 0}; const bf16_t* Qp; bf16_t* Op; const float* rp = nullptr; int r = 0, rs = 0; bool na = false;
    if (uid < 1536) {
        const int qc = uid & 31, bh = uid >> 5, b = bh / 6, h = bh - 6 * b, kvh = h / 3;
        const int row0 = MP + b * 2048;
        A = Seg{P.K + KS + (size_t)(b * 8 + kvh) * 64 * 2048, P.VT + KS + (size_t)(b * 8 + kvh) * 64 * 2048, 64};
        B = Seg{P.KCA + (size_t)((b * 4 + l) * 2 + kvh) * 16384, P.VCA + (size_t)((b * 4 + l) * 2 + kvh) * 16384, 8};
        Qp = P.Q + QS + ((size_t)(b * 12 + h) * 64 + 2 * qc) * 2048; Op = P.ATT + (size_t)(row0 + qc * 64) * D + 256 + h * 64;
    } else if (uid < 3072) {
        const int u = uid - 1536, bh = u >> 5, b = bh / 6, h = bh - 6 * b;
        r = u & 31; rs = min(max(r - 4, 0), 24); na = true;
        const int row0 = MP + b * 2048;
        A = Seg{P.K + KS + ((size_t)(b * 8 + 2 + h) * 64 + 2 * rs) * 2048, P.VT + KS + ((size_t)(b * 8 + 2 + h) * 64 + 2 * rs) * 2048, 16};
        B = Seg{P.KCN + (size_t)((b * 4 + l) * 6 + h) * 16384, P.VCN + (size_t)((b * 4 + l) * 6 + h) * 16384, 8};
        Qp = P.Q + QS + ((size_t)(b * 12 + 6 + h) * 64 + 2 * r) * 2048; Op = P.ATT + (size_t)(row0 + r * 64) * D + 640 + h * 64;
        rp = P.rpb + (size_t)(l * 6 + h) * 15 * 31;
    } else {
        const int nah = uid >= 3840;
        const int u = uid - (nah ? 3840 : 3072), qc = u & 3, bh = u >> 2, b = bh / 6, h = bh - 6 * b, kh = nah ? 2 + h : h / 3;
        const int row0 = b * 256;
        A = Seg{P.K + (size_t)(b * 8 + kh) * 8 * 2048, P.VT + (size_t)(b * 8 + kh) * 8 * 2048, 8};
        Qp = P.Q + ((size_t)(b * 12 + (nah ? 6 : 0) + h) * 8 + 2 * qc) * 2048; Op = P.ATT + (size_t)(row0 + qc * 64) * D + (nah ? 640 : 256) + h * 64;
    }
    if (na) { if (qsel == 2) attn_wave<true, 2>(Qp, A, B, Op, rp, r, rs, lane, ring, biasl, 0); else attn_wave<true, 1>(Qp, A, B, Op, rp, r, rs, lane, ring, biasl, qsel); }
    else attn_wave<false, 2>(Qp, A, B, Op, rp, r, rs, lane, ring, biasl, 0);
}

struct Args {
    const float* in[25]; float* out; unsigned char* ws; int ph_lo, ph_hi;
};
#define XB_TMO      128
#define XB_XCNT(j)  (256  + 64 * (j))
#define XB_XSUB(j)  (1280 + 64 * (j))
#define XB_XGEN(j)  (2304 + 64 * (j))
#define XB_TOP      3328
#define XB_TOPGEN   3392
#define XCD_BAR_WORDS 3456
#define XB_SPIN_CAP (1u << 18)

__device__ __forceinline__ unsigned xb_ld(unsigned* p)              { return __hip_atomic_load(p, __ATOMIC_RELAXED, __HIP_MEMORY_SCOPE_AGENT); }
__device__ __forceinline__ unsigned xb_add(unsigned* p, unsigned v) { return __hip_atomic_fetch_add(p, v, __ATOMIC_RELAXED, __HIP_MEMORY_SCOPE_AGENT); }
__device__ __forceinline__ unsigned xb_xcc_id() { return (unsigned)__builtin_amdgcn_s_getreg((3 << 11) | 20) & 0xFu; }
#define XB_SPIN(cond, bar) do { unsigned _sp = 0; while (cond) { __builtin_amdgcn_s_sleep(1); \
    if ((++_sp & 255u) == 0u) { if (xb_ld(&(bar)[XB_TMO])) break; if (_sp > XB_SPIN_CAP) { atomicAdd(&(bar)[XB_TMO], 1u); break; } } } } while (0)

struct XcdBarrier {
    unsigned* bar; unsigned x;
    volatile LAS unsigned* st;
};

__device__ __forceinline__ XcdBarrier xcd_barrier_post(unsigned* bar, volatile LAS unsigned* st) {
    XcdBarrier b; b.bar = bar; b.x = xb_xcc_id(); b.st = st;
    if (threadIdx.x == 0) { const unsigned old_ = xb_add(&bar[XB_XCNT(b.x)], 1u); st[2] = old_; st[3] = b.x; }
    return b;
}
__device__ __forceinline__ void xcd_barrier_complete(unsigned* bar, unsigned x, unsigned& nloc, unsigned& nx) {
    const unsigned G = gridDim.x * gridDim.y * gridDim.z;
    unsigned sum, cnt, mine, sp = 0u;
    for (;;) {
        sum = 0u; cnt = 0u; mine = 0u;
#pragma unroll
        for (unsigned j = 0; j < 16; ++j) { const unsigned c = xb_ld(&bar[XB_XCNT(j)]); sum += c; cnt += (c > 0u) ? 1u : 0u; mine = (j == x) ? c : mine; }
        if (sum == G) break;
        __builtin_amdgcn_s_sleep(1);
        if ((++sp & 255u) == 0u) { if (xb_ld(&bar[XB_TMO])) break; if (sp > XB_SPIN_CAP) { atomicAdd(&bar[XB_TMO], 1u); break; } }
    }
    nloc = mine > 0u ? mine : 1u; nx = cnt > 0u ? cnt : 1u;
}

__device__ __forceinline__ void xcd_barrier(const XcdBarrier& b) {
    asm volatile("s_waitcnt vmcnt(0)" ::: "memory");
    __syncthreads();
    if (threadIdx.x == 0) {
        unsigned* bar = b.bar; asm volatile("" : "+v"(bar));
        __builtin_amdgcn_s_waitcnt(0);
        unsigned nloc = b.st[0], nx = b.st[1];
        if (nloc == 0u) { xcd_barrier_complete(bar, b.x, nloc, nx); b.st[0] = nloc; b.st[1] = nx; }
        const unsigned old = xb_add(&bar[XB_XSUB(b.x)], 1u);
        const unsigned gen = old / nloc;
        if (old + 1u == (gen + 1u) * nloc) {
            __builtin_amdgcn_fence(__ATOMIC_RELEASE, "agent");
            asm volatile("s_waitcnt vmcnt(0)" ::: "memory");
            const unsigned og = xb_add(&bar[XB_TOP], 1u);
            const unsigned tg = og / nx;
            if (og + 1u == (tg + 1u) * nx) xb_add(&bar[XB_TOPGEN], 1u);
            else XB_SPIN(xb_ld(&bar[XB_TOPGEN]) == tg, bar);
            __builtin_amdgcn_fence(__ATOMIC_ACQUIRE, "agent");
            xb_add(&bar[XB_XGEN(b.x)], 1u);
            asm volatile("s_waitcnt vmcnt(0)" ::: "memory");
        } else {
            XB_SPIN(xb_ld(&bar[XB_XGEN(b.x)]) == gen, bar);
            __builtin_amdgcn_fence(__ATOMIC_ACQUIRE, "agent");
            asm volatile("s_waitcnt vmcnt(0)" ::: "memory");
        }
    }
    __syncthreads();
}

typedef const __attribute__((address_space(4))) char* kargp_t;
DI const float* ldin(int i) { kargp_t kp = (kargp_t)__builtin_amdgcn_kernarg_segment_ptr(); asm volatile("" : "+s"(kp)); return (const float*)(*(const __attribute__((address_space(4))) unsigned long long*)(kp + 8 * i)); }
DI float* ldout() { return (float*)ldin(25); }
DI unsigned char* ldws() { return (unsigned char*)ldin(26); }
DI int opq_tid() { int t = threadIdx.x; asm volatile("" : "+v"(t)); return t; }

__global__ void __launch_bounds__(512, 2) fwd_kernel(Args a) {
    extern __shared__ __attribute__((aligned(16))) unsigned char lds[];
    cg::grid_group grid = cg::this_grid();
    const int G = gridDim.x, bx = blockIdx.x, NGW = G * 8;
    const int lo = a.ph_lo, hi = a.ph_hi;
#define IN(k) (lo <= (k) && (k) < hi)
    volatile LAS unsigned* MISC = (volatile LAS unsigned*)((LAS unsigned char*)lds + 146432);
    if (threadIdx.x < 16) MISC[threadIdx.x] = 0u;
    __syncthreads();
    XcdBarrier xbar; xbar.bar = (unsigned*)ldws(); xbar.x = 0; xbar.st = nullptr;
    if (hi - lo > 1) xbar = xcd_barrier_post((unsigned*)ldws(), MISC + 8);
    if (hi < 0) grid.sync();
#define SEAM(k) do { if (IN(k) && (k) + 1 < hi) xcd_barrier(xbar); } while (0)
#define WSP(T, off) ((T*)(ws + (off)))

    for (int sx_ = 0; sx_ < SYNCX; ++sx_) xcd_barrier(xbar);
    if (IN(0)) for (int rep_ = 0; rep_ < REP_P; ++rep_) {
        if (rep_) xcd_barrier(xbar);
        const int tid = opq_tid(), lane = tid & 63, wave = __builtin_amdgcn_readfirstlane(tid >> 6), gw = bx * 8 + wave;
        unsigned char* ws = ldws();
        {
            const float *cvec = ldin(6), *c_ctx = ldin(7), *ada_w = ldin(8), *ada_b = ldin(9);
            float* mod = WSP(float, WS_MOD);
            for (int u = bx; u < DEPTH * 96; u += G) {
                const int l = u / 96, nb = u - l * 96;
                gemv9_unit(ada_w + (size_t)l * D * 6144, 6144, nb * 64, c_ctx, cvec, D, true, ada_b + l * 6144, mod + (size_t)l * NMOD * 6144, 6144, (float*)lds, tid);
            }
        }
        {
            const float *w_in = ldin(12), *w1 = ldin(23);
            bf16_t *WIN = WSP(bf16_t, WS_WIN), *W1T = WSP(bf16_t, WS_W1);
            LAS float* scr = (LAS float*)((LAS unsigned char*)lds + wave * 17408);
            constexpr int I_IN = 16 * 36, I_1 = 16 * 64, I_L = I_IN + I_1;
            for (int it = gw; it < 1 * I_L; it += NGW) {
                const int l = it / I_L; int r = it - l * I_L;
                if (r < I_IN) transpose_item(w_in + (size_t)l * D * INW, D, INW, WIN + (size_t)l * INW * D, scr, r, lane);
                else transpose_item(w1 + (size_t)l * D * FF, D, FF, W1T + (size_t)l * FF * D, scr, r - I_IN, lane);
            }
        }
        {
            const float *cache_ak = ldin(2), *cache_av = ldin(3), *cache_nk = ldin(4), *cache_nv = ldin(5);
            bf16_t *KCA = WSP(bf16_t, WS_KCA), *VCA = WSP(bf16_t, WS_VCA), *KCN = WSP(bf16_t, WS_KCN), *VCN = WSP(bf16_t, WS_VCN);
            const int gt = bx * 512 + tid, NGT = G * 512;
            for (int e = gt; e < 8 * 4 * 256 * 8 * 8; e += NGT) {
                const int c8 = e & 7, hh = (e >> 3) & 7, key = (e >> 6) & 255, bl = e >> 14;
                const float* src; bf16_t* dst;
                if (hh < 2) { src = cache_ak + (((size_t)bl * 256 + key) * 2 + hh) * 64 + 8 * c8; dst = KCA + (((size_t)bl * 2 + hh) * 8 + (key >> 5)) * 2048 + (c8 * 32 + (key & 31)) * 8; }
                else { src = cache_nk + (((size_t)bl * 256 + key) * 6 + (hh - 2)) * 64 + 8 * c8; dst = KCN + (((size_t)bl * 6 + (hh - 2)) * 8 + (key >> 5)) * 2048 + (c8 * 32 + (key & 31)) * 8; }
                const f32x4 v0 = *(const f32x4*)src, v1 = *(const f32x4*)(src + 4);
                u32x4 o; o.x = pk2(v0.x, v0.y); o.y = pk2(v0.z, v0.w); o.z = pk2(v1.x, v1.y); o.w = pk2(v1.z, v1.w);
                *(u32x4*)dst = o;
            }
            for (int e = gt; e < 8 * 4 * 8 * 32 * 64; e += NGT) {
                const int d = e & 63, g = (e >> 6) & 31, hh = (e >> 11) & 7, bl = e >> 14;
                unsigned short q[8];
#pragma unroll
                for (int jj = 0; jj < 8; ++jj) {
                    const int p = 8 * g + jj, key = (p & ~31) + permkey(p & 31);
                    const float v = (hh < 2) ? cache_av[(((size_t)bl * 256 + key) * 2 + hh) * 64 + d] : cache_nv[(((size_t)bl * 256 + key) * 6 + (hh - 2)) * 64 + d];
                    q[jj] = (unsigned short)(pk2(v, 0.f) & 0xffffu);
                }
                u32x4 o; o.x = q[0] | ((unsigned)q[1] << 16); o.y = q[2] | ((unsigned)q[3] << 16); o.z = q[4] | ((unsigned)q[5] << 16); o.w = q[6] | ((unsigned)q[7] << 16);
                const int voff = (g >> 2) * 2048 + ((((d >> 5) * 2 + ((g >> 1) & 1)) * 2 + (g & 1)) * 32 + (d & 31)) * 8;
                bf16_t* dst = (hh < 2) ? VCA + ((size_t)bl * 2 + hh) * 16384 + voff : VCN + ((size_t)bl * 6 + (hh - 2)) * 16384 + voff;
                *(u32x4*)dst = o;
            }
        }
    }
    SEAM(0);
    if (IN(1)) for (int rep_ = 0; rep_ < REP_P; ++rep_) {
        if (rep_) xcd_barrier(xbar);
        const int tid = opq_tid(), lane = tid & 63, wave = __builtin_amdgcn_readfirstlane(tid >> 6), gw = bx * 8 + wave;
        unsigned char* ws = ldws();
        float* mod = WSP(float, WS_MOD);
        {
            const float *w_in = ldin(12), *w1 = ldin(23);
            float *bias1 = WSP(float, WS_BIAS1), *bias2 = WSP(float, WS_BIAS2);
            for (int u = bx; u < DEPTH * 100; u += G) {
                const int l = u / 100; int r = u - l * 100;
                const float* ml = mod + (size_t)l * NMOD * 6144;
                if (r < 36) gemv9_unit(w_in + (size_t)l * D * INW, INW, r * 64, ml, ml + 6144, 6144, false, nullptr, bias1 + (size_t)l * NMOD * INW, INW, (float*)lds, tid);
                else { r -= 36; gemv9_unit(w1 + (size_t)l * D * FF, FF, r * 64, ml + 3072, ml + 6144 + 3072, 6144, false, nullptr, bias2 + (size_t)l * NMOD * FF, FF, (float*)lds, tid); }
            }
        }
        {
            const float *w_out = ldin(22), *w2 = ldin(24);
            bf16_t *WOUT = WSP(bf16_t, WS_WOUT), *W2T = WSP(bf16_t, WS_W2);
            LAS float* scr = (LAS float*)((LAS unsigned char*)lds + wave * 17408);
            constexpr int I_OUT = 16 * 16, I_2 = 64 * 16, I_L = I_OUT + I_2;
            for (int it = gw; it < 1 * I_L; it += NGW) {
                const int l = it / I_L; int r = it - l * I_L;
                if (r < I_OUT) transpose_item(w_out + (size_t)l * D * D, D, D, WOUT + (size_t)l * D * D, scr, r, lane);
                else transpose_item(w2 + (size_t)l * FF * D, FF, D, W2T + (size_t)l * D * FF, scr, r - I_OUT, lane);
            }
        }
        {
            const float *x_prompt = ldin(0), *x_sample = ldin(1), *norm1_g = ldin(10);
            bf16_t* XG = WSP(bf16_t, WS_XG); float* ssq = WSP(float, WS_SSQ);
            for (int row = gw; row < M; row += NGW) {
                const float* xr = (row < MP) ? x_prompt + (size_t)row * D : x_sample + (size_t)(row - MP) * D;
                const float* scp = mod + (size_t)modidx(row) * 6144 + 1024;
                float s = 0.f;
#pragma unroll
                for (int j = 0; j < 4; ++j) {
                    const int c = 256 * j + 4 * lane;
                    const f32x4 v = *(const f32x4*)(xr + c);
                    s += (v.x * v.x + v.y * v.y) + (v.z * v.z + v.w * v.w);
                    const f32x4 y = v * (*(const f32x4*)(norm1_g + c)) * (*(const f32x4*)(scp + c) + 1.0f);
                    u32x2 w; w.x = pk2(y.x, y.y); w.y = pk2(y.z, y.w);
                    *(u32x2*)(XG + (size_t)row * D + c) = w;
                }
                s = wave_sum(s);
                if (lane < 16) ssq[(size_t)row * 16 + lane] = (lane == 0) ? s : 0.f;
            }
        }
    }
    SEAM(1);
#pragma nounroll
    for (int l_ = 0; l_ < DEPTH; ++l_) {
        int l = l_; asm volatile("" : "+s"(l));
        const int p0 = 2 + 6 * l;
        if (IN(p0)) for (int rep_ = 0; rep_ < REP_G1; ++rep_) {
            unsigned char* ws = ldws();
            pg8::Gemm g{WSP(bf16_t, WS_XG), WSP(bf16_t, WS_WIN) + (size_t)l * INW * D, M, INW, D, D}; pg8::StaticOrder S; S.init(M, INW, G, bx);
            EpiLin<0> E{WSP(bf16_t, WS_RAW), INW, WSP(float, WS_BIAS1) + (size_t)l * NMOD * INW, INW, WSP(float, WS_SSQ)};
            pg8::gemm_phase<EpiLin<0>, pg8::StaticOrder, true, true>((LAS unsigned char*)lds, g, S, E);
        }
        SEAM(p0);
        if (IN(p0 + 1)) for (int rep_ = 0; rep_ < REP_PREP; ++rep_) {
            const int tid = opq_tid();
            unsigned char* ws = ldws();
            for (int u = bx; u < 768; u += G) {
                if (u < 384) conv_unit(u, l, WSP(bf16_t, WS_RAW), WSP(bf16_t, WS_ATT), ldin(13), ldin(14), ldin(15), ldin(16), (float*)lds, tid);
                else { PrepP P{WSP(bf16_t, WS_RAW), WSP(bf16_t, WS_Q), WSP(bf16_t, WS_K), WSP(bf16_t, WS_VT), ldout(), ldin(17), ldin(18), ldin(19), ldin(20)}; qkv_unit(u - 384, l, P, (bf16_t*)lds, tid); }
            }
        }
        SEAM(p0 + 1);
        if (IN(p0 + 2)) for (int rep_ = 0; rep_ < REP_ATTN; ++rep_) {
            const int tid = opq_tid(), lane = tid & 63, wave = __builtin_amdgcn_readfirstlane(tid >> 6), gw = bx * 8 + wave;
            unsigned char* ws = ldws();
            AttnP P{WSP(bf16_t, WS_Q), WSP(bf16_t, WS_K), WSP(bf16_t, WS_VT), WSP(bf16_t, WS_KCA), WSP(bf16_t, WS_VCA), WSP(bf16_t, WS_KCN), WSP(bf16_t, WS_VCN), WSP(bf16_t, WS_ATT), ldin(21)};
            bool bal = (NGW == 2048) && (hi - lo > 1);
            int xcd = bx & 7, slot = bx >> 3;
            if (bal) {
                unsigned okc = 1u;
                for (unsigned j = 0; j < 16; ++j) okc &= (xb_ld(&xbar.bar[XB_XCNT(j)]) == (j < 8 ? 32u : 0u)) ? 1u : 0u;
                xcd = __builtin_amdgcn_readfirstlane((int)MISC[11]); slot = __builtin_amdgcn_readfirstlane((int)MISC[10]);
                bal = (__builtin_amdgcn_readfirstlane((int)okc) != 0) && xcd < 8 && slot < 32;
            }
            const int idx = slot * 8 + wave;
            const int nu = bal ? (slot < 24 ? (idx < 64 ? 4 : 2) : 2) : (4608 - gw + NGW - 1) / NGW;
            for (int k = 0; k < nu; ++k) {
#ifdef ATTN_PROBE
                if (rep_ == 1 && ((ATTN_PROBE == 1) ? (slot >= 24) : (ATTN_PROBE == 2) ? (slot < 24) : (slot >= 24 || k > 0))) break;
#endif
                int uid, qsel = 2;
                if (!bal) uid = gw + k * NGW;
                else if (slot < 24) {
                    if (k == 0) uid = (xcd * 6 + (idx >> 5)) * 32 + (idx & 31);
                    else if (idx < 64) { const int p = (k - 1) * 64 + idx; const int pb = 4 * xcd + p / 48, r = p % 48, kind = r / 24, rr = r % 24; uid = (kind ? 3840 : 3072) + (pb * 6 + (rr >> 2)) * 4 + (rr & 3); }
                    else { uid = 1536 + xcd * 192 + 128 + ((idx - 64) >> 1); qsel = (idx - 64) & 1; }
                } else uid = 1536 + xcd * 192 + k * 64 + (slot - 24) * 8 + wave;
                attn_run_unit(uid, qsel, l, P, lane, (LAS unsigned char*)lds + wave * 16384, (LAS float*)((LAS unsigned char*)lds + 131072 + wave * 1920), false, wave, (LAS unsigned char*)lds);
            }
        }
        SEAM(p0 + 2);
        if (IN(p0 + 3)) {
            unsigned char* ws = ldws(); float* X = ldout();
            const float* ml = WSP(float, WS_MOD) + (size_t)l * NMOD * 6144;
            const bool split = false;
#pragma nounroll
            for (int rnd = 0; rnd < (split ? 2 : 1); ++rnd) {
                const int kh = (rnd == 1) ? (bx >> 7) : 0, koff = kh * (D / 2);
                pg8::Gemm g{WSP(bf16_t, WS_ATT) + koff, WSP(bf16_t, WS_WOUT) + (size_t)l * D * D + koff, M, D, D, (rnd == 1) ? D / 2 : D};
                RangeOrder S; S.init(M, D, G, bx); S.lo = 0; S.hi = split ? 256 : 384; S.fix = (rnd == 1) ? 256 + (bx & 127) : -1;
                unsigned* flag = (unsigned*)(ws + 16384) + (size_t)((l * 2 + 0) * 128 + (bx & 127)) * 64;
                f32x4* part = (f32x4*)(ws + WS_RAW) + (size_t)(bx & 127) * 16384;
                EpiRes E{l == 0 ? ldin(0) : X, l == 0 ? ldin(1) : X + (size_t)MP * D, X, ml + 2048, ldin(11) + l * D, ml + 4096, WSP(bf16_t, WS_XG), WSP(float, WS_SSQ), 1, (rnd == 1) ? 1 + kh : 0, part, flag};
                pg8::gemm_phase<EpiRes, RangeOrder, true, true>((LAS unsigned char*)lds, g, S, E);
                if (rnd == 1 && kh == 1) {
                    asm volatile("s_waitcnt vmcnt(0)" ::: "memory"); __syncthreads();
                    if (threadIdx.x == 0) { __builtin_amdgcn_fence(__ATOMIC_RELEASE, "agent"); asm volatile("s_waitcnt vmcnt(0)" ::: "memory"); __hip_atomic_store(flag, 1u, __ATOMIC_RELAXED, __HIP_MEMORY_SCOPE_AGENT); }
                }
            }
            SEAM(p0 + 3);
        }
        if (IN(p0 + 4)) for (int rep_ = 0; rep_ < REP_G3; ++rep_) {
            unsigned char* ws = ldws();
            pg8::Gemm g{WSP(bf16_t, WS_XG), WSP(bf16_t, WS_W1) + (size_t)l * FF * D, M, FF, D, D}; pg8::StaticOrder S; S.init(M, FF, G, bx);
            EpiLin<1> E{WSP(bf16_t, WS_H1), FF, WSP(float, WS_BIAS2) + (size_t)l * NMOD * FF, FF, WSP(float, WS_SSQ)};
            pg8::gemm_phase<EpiLin<1>, pg8::StaticOrder, true, true>((LAS unsigned char*)lds, g, S, E);
        }
        SEAM(p0 + 4);
        if (IN(p0 + 5)) {
            unsigned char* ws = ldws(); float* X = ldout();
            const float* ml = WSP(float, WS_MOD) + (size_t)l * NMOD * 6144;
            const int nx = (l + 1 < DEPTH) ? 1 : 0; const int ln = nx ? l + 1 : l;
            const bool split = false;
#pragma nounroll
            for (int rnd = 0; rnd < (split ? 2 : 1); ++rnd) {
                const int kh = (rnd == 1) ? (bx >> 7) : 0, koff = kh * (FF / 2);
                pg8::Gemm g{WSP(bf16_t, WS_H1) + koff, WSP(bf16_t, WS_W2) + (size_t)l * D * FF + koff, M, D, FF, (rnd == 1) ? FF / 2 : FF};
                RangeOrder S; S.init(M, D, G, bx); S.lo = 0; S.hi = split ? 256 : 384; S.fix = (rnd == 1) ? 256 + (bx & 127) : -1;
                unsigned* flag = (unsigned*)(ws + 16384) + (size_t)((l * 2 + 1) * 128 + (bx & 127)) * 64;
                f32x4* part = (f32x4*)(ws + WS_ATT) + (size_t)(bx & 127) * 16384;
                EpiRes E{X, X + (size_t)MP * D, X, ml + 5120, ldin(10) + ln * D, WSP(float, WS_MOD) + (size_t)ln * NMOD * 6144 + 1024, WSP(bf16_t, WS_XG), WSP(float, WS_SSQ), nx, (rnd == 1) ? 1 + kh : 0, part, flag};
                pg8::gemm_phase<EpiRes, RangeOrder, true, true>((LAS unsigned char*)lds, g, S, E);
                if (rnd == 1 && kh == 1) {
                    asm volatile("s_waitcnt vmcnt(0)" ::: "memory"); __syncthreads();
                    if (threadIdx.x == 0) { __builtin_amdgcn_fence(__ATOMIC_RELEASE, "agent"); asm volatile("s_waitcnt vmcnt(0)" ::: "memory"); __hip_atomic_store(flag, 1u, __ATOMIC_RELAXED, __HIP_MEMORY_SCOPE_AGENT); }
                }
            }
            if (l + 1 < DEPTH) {
                const int first = (G == 256) ? 128 : 0, nwg_t = G - first;
                if (bx >= first) {
                    const int tid = opq_tid(), lane = tid & 63, wave = __builtin_amdgcn_readfirstlane(tid >> 6);
                    const int l2 = l + 1;
                    const float *w_in = ldin(12), *w_out = ldin(22), *w1 = ldin(23), *w2 = ldin(24);
                    LAS float* scr = (LAS float*)((LAS unsigned char*)lds + wave * 17408);
                    constexpr int I_IN = 16 * 36, I_1 = 16 * 64, I_OUT = 16 * 16, I_2 = 64 * 16, I_L = I_IN + I_1 + I_OUT + I_2;
                    for (int it = (bx - first) * 8 + wave; it < I_L; it += nwg_t * 8) {
                        int r = it;
                        if (r < I_IN) { transpose_item(w_in + (size_t)l2 * D * INW, D, INW, WSP(bf16_t, WS_WIN) + (size_t)l2 * INW * D, scr, r, lane); continue; } r -= I_IN;
                        if (r < I_1) { transpose_item(w1 + (size_t)l2 * D * FF, D, FF, WSP(bf16_t, WS_W1) + (size_t)l2 * FF * D, scr, r, lane); continue; } r -= I_1;
                        if (r < I_OUT) { transpose_item(w_out + (size_t)l2 * D * D, D, D, WSP(bf16_t, WS_WOUT) + (size_t)l2 * D * D, scr, r, lane); continue; } r -= I_OUT;
                        transpose_item(w2 + (size_t)l2 * FF * D, FF, D, WSP(bf16_t, WS_W2) + (size_t)l2 * D * FF, scr, r, lane);
                    }
                }
            }
            SEAM(p0 + 5);
        }
    }
#undef IN
#undef SEAM
#undef WSP
}

extern "C" void kernel_launch(void* const* d_in, const int* in_sizes, int n_in, void* d_out, int out_size, void* d_ws, size_t ws_size, hipStream_t stream) {
    static int grid = 0;
    if (grid == 0) {
        if (n_in != 25 || ws_size < WS_END) { fprintf(stderr, "kernel_launch: need 25 inputs and >= %zu bytes of workspace; got %d, %zu\n", (size_t)WS_END, n_in, ws_size); grid = -1; return; }
        int dev = 0, cus = 0, per_cu = 0;
        hipGetDevice(&dev);
        hipDeviceGetAttribute(&cus, hipDeviceAttributeMultiprocessorCount, dev);
        if (hipFuncSetAttribute((const void*)fwd_kernel, hipFuncAttributeMaxDynamicSharedMemorySize, LDS_BYTES) != hipSuccess) { fprintf(stderr, "kernel_launch: hipFuncSetAttribute failed\n"); grid = -1; return; }
        if (hipOccupancyMaxActiveBlocksPerMultiprocessor(&per_cu, (const void*)fwd_kernel, 512, LDS_BYTES) != hipSuccess || per_cu < 1) { fprintf(stderr, "kernel_launch: occupancy query says %d\n", per_cu); per_cu = 1; }
        (void)hipGetLastError();
        grid = cus * per_cu;
    }
    if (grid < 0) return;
    if (hipMemsetAsync(d_ws, 0, 16384, stream) != hipSuccess) { fprintf(stderr, "kernel_launch: memset failed\n"); return; }
    Args a{};
    for (int i = 0; i < 25; ++i) a.in[i] = (const float*)d_in[i];
    a.out = (float*)d_out; a.ws = (unsigned char*)d_ws;
#if MK_SINGLE
    a.ph_lo = 0; a.ph_hi = NPH;
    void* args[] = {&a};
    hipError_t e = hipLaunchCooperativeKernel((const void*)fwd_kernel, dim3(grid), dim3(512), args, LDS_BYTES, stream);
    if (e != hipSuccess) fprintf(stderr, "cooperative launch failed: %s (grid %d)\n", hipGetErrorString(e), grid);
#else
    for (int ph = 0; ph < NPH; ++ph) {
        a.ph_lo = ph; a.ph_hi = ph + 1;
        hipLaunchKernelGGL(fwd_kernel, dim3(grid), dim3(512), LDS_BYTES, stream, a);
    }
#endif
}
```

```cpp
#include <hip/hip_runtime.h>
#include <hip/hip_cooperative_groups.h>
#include <cstdio>
#include <cstdint>
namespace cg = cooperative_groups;
namespace pg8 {
#define PG8_LAS __attribute__((address_space(3)))
typedef unsigned short bf16_t;
typedef short bf16x8 __attribute__((ext_vector_type(8)));
typedef float f32x4 __attribute__((ext_vector_type(4)));
typedef unsigned u32x4 __attribute__((ext_vector_type(4)));
constexpr int BM = 256, BK = 64, HALF = 128, HTB = HALF * BK * 2  , STAGE_BYTES = 8 * HTB, NXCD = 8, WGM = 8;

__host__ __device__ __forceinline__ int lds_byte(int r, int c) { const int st = (r >> 4) * 2 + (c >> 5), rr = r & 15, cc = c & 31, ob = rr * 64 + cc * 2; return st * 1024 + (ob ^ (((ob >> 9) & 1) << 5)); }
__host__ __device__ __forceinline__ void stage_rc(int b, int& R, int& C) { const int st = b / 1024, sb = b % 1024, swz = sb ^ (((sb >> 9) & 1) << 5); R = (st >> 1) * 16 + swz / 64; C = (st & 1) * 32 + (swz % 64) / 2; }
__host__ __device__ __forceinline__ int perm32(int rho) { const int n = rho >> 4, i = rho & 15; return 8 * (i >> 2) + 4 * n + (i & 3); }

struct Unit { int pm, pn; };
struct Gemm { const bf16_t* A; const bf16_t* Bt; int M, N, K, Kl; };

struct StaticOrder {
    int nM, nN, nwg, G, c;
    __host__ __device__ void init(int M, int N, int G_, int c_) { nM = M / BM; nN = N / BM; nwg = nM * nN; G = G_; c = c_; }
    __host__ __device__ bool next(int i, Unit& u) const {
        const long L = (long)i * G + c; if (L >= nwg) return false;
        int wgid = (int)L; { const int q = nwg / NXCD, r = nwg % NXCD, xcd = wgid % NXCD, off = wgid / NXCD; wgid = (xcd < r ? xcd * (q + 1) : r * (q + 1) + (xcd - r) * q) + off; }
        const int nig = WGM * nN, gid = wgid / nig, fm = gid * WGM, gsz = (nM - fm) < WGM ? (nM - fm) : WGM;
        u.pm = fm + ((wgid % nig) % gsz); u.pn = (wgid % nig) / gsz; return true;
    }
    __device__ __forceinline__ void a_ready(const Unit&) const {}
    __device__ __forceinline__ void done(const Unit&) const {}
};
__device__ __forceinline__ unsigned cvt_pk_bf16(float lo, float hi) { unsigned r; asm volatile("v_cvt_pk_bf16_f32 %0, %1, %2" : "=v"(r) : "v"(lo), "v"(hi)); return r; }
template <class Epi, class Sched, bool ALIGN_EPI = false, bool SP2 = false>
__device__ __forceinline__ void gemm_phase(PG8_LAS unsigned char* lds, const Gemm g, const Sched& S, const Epi& E) {
    int tid_ = threadIdx.x; asm volatile("" : "+v"(tid_));
    const int tid = tid_, wid = __builtin_amdgcn_readfirstlane(tid >> 6), lane = tid & 63, wr = wid >> 2, wc = wid & 3, fr = lane & 15, fq = lane >> 4;
    const int K = g.K, nt = g.Kl / BK;
    unsigned voffA[2], voffB[2];
#pragma unroll
    for (int i = 0; i < 2; ++i) { int R, C; stage_rc(tid * 16 + i * 8192, R, C); const int Rb = Epi::PERM ? ((R & ~31) + perm32(R & 31)) : R;
        voffA[i] = (unsigned)(R * K + C) * 2u; voffB[i] = (unsigned)(Rb * K + C) * 2u; }
    const size_t kstep = (size_t)(BK * 2);
    const size_t hstep = (size_t)HALF * K * 2;
    const size_t tstep = 2 * hstep;
    const unsigned ldsw = (unsigned)wid * 1024u;
    const int aoff = lds_byte(wr * 64 + fr, fq * 8), boff = lds_byte(wc * 32 + fr, fq * 8);
#define PG8_SA(b, h) (((b) * 2 + (h)) * HTB)
#define PG8_SB(b, h) ((4 + (b) * 2 + (h)) * HTB)
#define PG8_STAGE(bufoff, gbase, voff) do { _Pragma("unroll") for (int _i = 0; _i < 2; ++_i) \
        __builtin_amdgcn_global_load_lds((const unsigned*)((const char*)(gbase) + (voff)[_i]), (PG8_LAS unsigned*)(lds + (bufoff) + ldsw + _i * 8192), 16, 0, 0); } while (0)
#define PG8_LDA(dst, b, h) do { _Pragma("unroll") for (int m = 0; m < 4; ++m) _Pragma("unroll") for (int k = 0; k < 2; ++k) dst[m][k] = *(const PG8_LAS bf16x8*)(lds + PG8_SA(b, h) + aoff + m * 2048 + k * 1024); } while (0)
#define PG8_LDB(dst, b, h) do { _Pragma("unroll") for (int n = 0; n < 2; ++n) _Pragma("unroll") for (int k = 0; k < 2; ++k) dst[n][k] = *(const PG8_LAS bf16x8*)(lds + PG8_SB(b, h) + boff + n * 2048 + k * 1024); } while (0)
#define PG8_MMA(ai, bj, At, Bt) do { __builtin_amdgcn_s_setprio(1); _Pragma("unroll") for (int m = 0; m < 4; ++m) _Pragma("unroll") for (int n = 0; n < 2; ++n) _Pragma("unroll") for (int k = 0; k < 2; ++k) \
        acc[ai][bj][m][n] = __builtin_amdgcn_mfma_f32_16x16x32_bf16(Bt[n][k], At[m][k], acc[ai][bj][m][n], 0, 0, 0); __builtin_amdgcn_s_setprio(0); } while (0)
#define PG8_WAIT_V(n) asm volatile("s_waitcnt vmcnt(" #n ")" ::: "memory")
#define PG8_WAIT_L(n) asm volatile("s_waitcnt lgkmcnt(" #n ")" ::: "memory")
#define PG8_BAR __builtin_amdgcn_s_barrier()
#define PG8_SCHED __builtin_amdgcn_sched_barrier(0)
    Unit cur, nxt; int ui = 0;
    if (!S.next(0, cur)) return;
    f32x4 acc[2][2][4][2];
#pragma unroll
    for (int a = 0; a < 2; ++a)
#pragma unroll
        for (int b = 0; b < 2; ++b)
#pragma unroll
            for (int m = 0; m < 4; ++m)
#pragma unroll
                for (int n = 0; n < 2; ++n) acc[a][b][m][n] = (f32x4){0.f, 0.f, 0.f, 0.f};
    bf16x8 At[4][2], B0[2][2], B1[2][2];
    const char* cA = (const char*)g.A + (size_t)cur.pm * tstep; const char* cB = (const char*)g.Bt + (size_t)cur.pn * tstep;
    S.a_ready(cur);
    if constexpr (SP2) {
        PG8_STAGE(PG8_SB(0, 0), cB, voffB); PG8_STAGE(PG8_SB(0, 1), cB + hstep, voffB); PG8_STAGE(PG8_SA(0, 0), cA, voffA); PG8_STAGE(PG8_SA(0, 1), cA + hstep, voffA);
        if (wr == 1) PG8_BAR;
        PG8_WAIT_V(2); PG8_BAR;
        PG8_STAGE(PG8_SB(1, 0), cB + kstep, voffB); PG8_STAGE(PG8_SA(1, 0), cA + kstep, voffA); PG8_STAGE(PG8_SB(1, 1), cB + hstep + kstep, voffB);
        PG8_WAIT_V(6); PG8_BAR;
    } else {
        PG8_STAGE(PG8_SB(0, 0), cB, voffB); PG8_STAGE(PG8_SA(0, 0), cA, voffA); PG8_STAGE(PG8_SB(0, 1), cB + hstep, voffB); PG8_STAGE(PG8_SA(0, 1), cA + hstep, voffA);
        if (wr == 1) PG8_BAR;
        PG8_WAIT_V(4); PG8_BAR;
        PG8_STAGE(PG8_SB(1, 0), cB + kstep, voffB); PG8_STAGE(PG8_SA(1, 0), cA + kstep, voffA); PG8_STAGE(PG8_SB(1, 1), cB + hstep + kstep, voffB);
        PG8_WAIT_V(6); PG8_BAR;
    }
    for (;;) {
        const bool has_next = S.next(ui + 1, nxt);
        const char* nA = has_next ? (const char*)g.A + (size_t)nxt.pm * tstep : cA; const char* nB = has_next ? (const char*)g.Bt + (size_t)nxt.pn * tstep : cB;
        for (int t = 0; t < nt; t += 2) {
            const bool last = (t == nt - 2);
            const char* a1 = cA + (size_t)(t + 1) * kstep;
            const char* a2 = last ? nA : cA + (size_t)(t + 2) * kstep; const char* b2 = last ? nB : cB + (size_t)(t + 2) * kstep;
            const char* a3 = a2 + kstep; const char* b3 = b2 + kstep;
            if (last && has_next) S.a_ready(nxt);
            if constexpr (SP2) {
            PG8_LDB(B0, 0, 0); PG8_LDB(B1, 0, 1); PG8_SCHED; PG8_LDA(At, 0, 0); PG8_STAGE(PG8_SA(1, 1), a1 + hstep, voffA);
            PG8_WAIT_V(8); PG8_WAIT_L(0); PG8_BAR; PG8_MMA(0, 0, At, B0); PG8_MMA(0, 1, At, B1); PG8_BAR; PG8_SCHED;
            PG8_LDA(At, 0, 1); PG8_STAGE(PG8_SB(0, 0), b2, voffB); PG8_STAGE(PG8_SB(0, 1), b2 + hstep, voffB); PG8_STAGE(PG8_SA(0, 0), a2, voffA);
            PG8_WAIT_V(8); PG8_WAIT_L(0); PG8_BAR; PG8_MMA(1, 0, At, B0); PG8_MMA(1, 1, At, B1); PG8_BAR; PG8_SCHED;
            PG8_LDB(B0, 1, 0); PG8_LDB(B1, 1, 1); PG8_SCHED; PG8_LDA(At, 1, 0); PG8_STAGE(PG8_SA(0, 1), a2 + hstep, voffA);
            PG8_WAIT_V(8); PG8_WAIT_L(0); PG8_BAR; PG8_MMA(0, 0, At, B0); PG8_MMA(0, 1, At, B1); PG8_BAR; PG8_SCHED;
            PG8_LDA(At, 1, 1); PG8_STAGE(PG8_SB(1, 0), b3, voffB); PG8_STAGE(PG8_SB(1, 1), b3 + hstep, voffB); PG8_STAGE(PG8_SA(1, 0), a3, voffA);
            PG8_WAIT_V(8); PG8_WAIT_L(0); PG8_BAR; PG8_MMA(1, 0, At, B0); PG8_MMA(1, 1, At, B1); PG8_BAR; PG8_SCHED;
            } else {
            PG8_LDB(B0, 0, 0); PG8_SCHED; PG8_LDA(At, 0, 0); PG8_STAGE(PG8_SA(1, 1), a1 + hstep, voffA);
            PG8_WAIT_L(8); PG8_BAR; PG8_WAIT_L(0); PG8_MMA(0, 0, At, B0); PG8_BAR; PG8_SCHED;
            PG8_LDB(B1, 0, 1); PG8_STAGE(PG8_SB(0, 0), b2, voffB);
            PG8_BAR; PG8_WAIT_L(0); PG8_MMA(0, 1, At, B1); PG8_BAR;
            PG8_LDA(At, 0, 1); PG8_STAGE(PG8_SA(0, 0), a2, voffA);
            PG8_BAR; PG8_WAIT_L(0); PG8_MMA(1, 0, At, B0); PG8_BAR; PG8_SCHED;
            PG8_STAGE(PG8_SB(0, 1), b2 + hstep, voffB);
            PG8_WAIT_V(6); PG8_BAR; PG8_MMA(1, 1, At, B1); PG8_BAR;
            PG8_LDB(B0, 1, 0); PG8_SCHED; PG8_LDA(At, 1, 0); PG8_STAGE(PG8_SA(0, 1), a2 + hstep, voffA);
            PG8_WAIT_L(8); PG8_BAR; PG8_WAIT_L(0); PG8_MMA(0, 0, At, B0); PG8_BAR; PG8_SCHED;
            PG8_LDB(B1, 1, 1); PG8_STAGE(PG8_SB(1, 0), b3, voffB);
            PG8_BAR; PG8_WAIT_L(0); PG8_MMA(0, 1, At, B1); PG8_BAR;
            PG8_LDA(At, 1, 1); PG8_STAGE(PG8_SA(1, 0), a3, voffA);
            PG8_BAR; PG8_WAIT_L(0); PG8_MMA(1, 0, At, B0); PG8_BAR; PG8_SCHED;
            PG8_STAGE(PG8_SB(1, 1), b3 + hstep, voffB);
            PG8_WAIT_V(6); PG8_BAR; PG8_MMA(1, 1, At, B1); PG8_BAR;
            }
        }
        if constexpr (ALIGN_EPI) { if (wr == 0) PG8_BAR; }
        if constexpr (!Epi::AFTER_DRAIN) { E(acc, cur, wr, wc, fr, fq); S.done(cur); }
        if (!has_next) break;
#pragma unroll
        for (int a = 0; a < 2; ++a)
#pragma unroll
            for (int b = 0; b < 2; ++b)
#pragma unroll
                for (int m = 0; m < 4; ++m)
#pragma unroll
                    for (int n = 0; n < 2; ++n) acc[a][b][m][n] = (f32x4){0.f, 0.f, 0.f, 0.f};
        cur = nxt; cA = nA; cB = nB; ++ui;
        if constexpr (ALIGN_EPI) { if (wr == 1) PG8_BAR; }
    }
    PG8_WAIT_V(0);
    if constexpr (!ALIGN_EPI) { if (wr == 0) PG8_BAR; }
    PG8_BAR;
    if constexpr (Epi::AFTER_DRAIN) { E.fused(acc, cur, wr, wc, fr, fq, lds, wid, lane); S.done(cur); }
#undef PG8_SA
#undef PG8_SB
#undef PG8_STAGE
#undef PG8_LDA
#undef PG8_LDB
#undef PG8_MMA
#undef PG8_WAIT_V
#undef PG8_WAIT_L
#undef PG8_BAR
#undef PG8_SCHED
}
}

#define DI __device__ __forceinline__
#define LAS __attribute__((address_space(3)))
typedef unsigned short bf16_t;
typedef short bf16x8 __attribute__((ext_vector_type(8)));
typedef float f32x4 __attribute__((ext_vector_type(4)));
typedef float f32x16 __attribute__((ext_vector_type(16)));
typedef unsigned u32x4 __attribute__((ext_vector_type(4)));
typedef unsigned u32x2 __attribute__((ext_vector_type(2)));
typedef float f32x2_t __attribute__((ext_vector_type(2)));
typedef __bf16 bf16x2_t __attribute__((ext_vector_type(2)));

#ifndef REP_P
#define REP_P 1
#endif
#ifndef REP_G1
#define REP_G1 1
#endif
#ifndef REP_PREP
#define REP_PREP 1
#endif
#ifndef REP_ATTN
#define REP_ATTN 1
#endif
#ifndef REP_G3
#define REP_G3 1
#endif
#ifndef SYNCX
#define SYNCX 0
#endif
#ifndef MK_SINGLE
#define MK_SINGLE 1
#endif

constexpr int D = 1024, MP = 8192, MS = 16384, M = MP + MS, DEPTH = 4, NMOD = 9, INW = 2304, FF = 4096;
constexpr int NPH = 2 + 6 * DEPTH;
constexpr float QSCALE = 0.125f * 1.4426950408889634f, LOG2E = 1.4426950408889634f, EPS = 1e-6f;
constexpr size_t OFF_AK = 25165824, OFF_AV = 29360128, OFF_NK = 33554432, OFF_NV = 46137344;
constexpr size_t MiB = 1u << 20;
constexpr size_t WS_MOD = 1 * MiB, WS_BIAS1 = 2 * MiB, WS_BIAS2 = 3 * MiB, WS_SSQ = 4 * MiB;
constexpr size_t WS_KCA = 6 * MiB, WS_VCA = 8 * MiB, WS_KCN = 10 * MiB, WS_VCN = 16 * MiB;
constexpr size_t WS_WIN = 22 * MiB, WS_WOUT = 40 * MiB, WS_W1 = 48 * MiB, WS_W2 = 80 * MiB;
constexpr size_t WS_XG = 112 * MiB, WS_H1 = 160 * MiB, WS_RAW = 160 * MiB, WS_Q = 268 * MiB, WS_K = 304 * MiB, WS_VT = 328 * MiB, WS_ATT = 352 * MiB, WS_END = 400 * MiB;
constexpr int LDS_BYTES = 147456;

DI unsigned pk2(float lo, float hi) { f32x2_t v = {lo, hi}; bf16x2_t b = __builtin_convertvector(v, bf16x2_t); return __builtin_bit_cast(unsigned, b); }
DI float bflo(unsigned w) { return __uint_as_float(w << 16); }
DI float bfhi(unsigned w) { return __uint_as_float(w & 0xffff0000u); }
DI void unpack8(const u32x4 w, float (&v)[8]) { v[0] = bflo(w.x); v[1] = bfhi(w.x); v[2] = bflo(w.y); v[3] = bfhi(w.y); v[4] = bflo(w.z); v[5] = bfhi(w.z); v[6] = bflo(w.w); v[7] = bfhi(w.w); }
DI int modidx(int row) { return row < MP ? 0 : 1 + ((row - MP) >> 11); }
DI float wave_sum(float v) {
#pragma unroll
    for (int o = 1; o < 64; o <<= 1) v += __shfl_xor(v, o);
    return v;
}
DI float sigmoidf_(float x) { return 1.f / (1.f + __expf(-x)); }
DI int crow(int i, int hi) { return (i & 3) + 8 * (i >> 2) + 4 * hi; }
DI int permkey(int p) { const int s = p >> 4, hh = (p >> 3) & 1, jj = p & 7; return 16 * s + 8 * (jj >> 2) + 4 * hh + (jj & 3); }

template <int ACT> struct EpiLin {
    static constexpr bool PERM = true, AFTER_DRAIN = false;
    bf16_t* O; int ldc; const float* bias; int ldb; const float* ssq;
    DI void operator()(const f32x4 (&acc)[2][2][4][2], const pg8::Unit& u, int wr, int wc, int fr, int fq) const {
        const int row0 = u.pm * 256 + wr * 64 + fr, col0 = u.pn * 256 + wc * 32 + 8 * fq;
        const float* bp = bias + (size_t)modidx(u.pm * 256) * ldb + col0;
        f32x4 bv[2][2];
#pragma unroll
        for (int bj = 0; bj < 2; ++bj)
#pragma unroll
            for (int n = 0; n < 2; ++n) bv[bj][n] = *(const f32x4*)(bp + bj * 128 + 4 * n);
        float rs8[8];
        {
            f32x4 s4[8];
#pragma unroll
            for (int k = 0; k < 8; ++k) s4[k] = *(const f32x4*)(ssq + (size_t)(row0 + (k >> 2) * 128 + (k & 3) * 16) * 16 + 4 * fq);
#pragma unroll
            for (int k = 0; k < 8; ++k) { float s = (s4[k].x + s4[k].y) + (s4[k].z + s4[k].w); s += __shfl_xor(s, 16); s += __shfl_xor(s, 32); rs8[k] = rsqrtf(s * (1.f / 1024.f) + EPS); }
        }
#pragma unroll
        for (int ai = 0; ai < 2; ++ai)
#pragma unroll
            for (int m = 0; m < 4; ++m) {
                const int row = row0 + ai * 128 + m * 16;
                const float rstd = rs8[ai * 4 + m];
                bf16_t* rowp = O + (size_t)row * ldc + col0;
#pragma unroll
                for (int bj = 0; bj < 2; ++bj) {
                    f32x4 v0 = acc[ai][bj][m][0] * rstd + bv[bj][0], v1 = acc[ai][bj][m][1] * rstd + bv[bj][1];
                    if (ACT == 1) {
#pragma unroll
                        for (int e = 0; e < 4; ++e) { const float a = fmaxf(v0[e], 0.f), b = fmaxf(v1[e], 0.f); v0[e] = a * a; v1[e] = b * b; }
                    }
                    u32x4 w; w.x = pk2(v0[0], v0[1]); w.y = pk2(v0[2], v0[3]); w.z = pk2(v1[0], v1[1]); w.w = pk2(v1[2], v1[3]);
                    *(u32x4*)(rowp + bj * 128) = w;
                }
            }
    }
};
struct EpiRes {
    static constexpr bool PERM = false, AFTER_DRAIN = false;
    const float* baseP; const float* baseS; float* out; const float* gate; const float* nw; const float* sc; bf16_t* xg; float* ssq; int has_next;
    int mode; f32x4* part; unsigned* flag;
    DI void operator()(f32x4 (&acc)[2][2][4][2], const pg8::Unit& u, int wr, int wc, int fr, int fq) const {
        f32x4* pp = part + threadIdx.x; asm volatile("" : "+v"(pp));
        if (mode == 2) {
#pragma unroll
            for (int ai = 0; ai < 2; ++ai)
#pragma unroll
                for (int bj = 0; bj < 2; ++bj)
#pragma unroll
                    for (int m = 0; m < 4; ++m)
#pragma unroll
                        for (int n = 0; n < 2; ++n) pp[(size_t)((((ai * 2 + bj) * 4 + m) * 2 + n) * 512)] = acc[ai][bj][m][n];
            return;
        }
        if (mode == 1) {
            const unsigned long long t0 = __builtin_amdgcn_s_memrealtime();
            while ((unsigned)__builtin_amdgcn_readfirstlane(__hip_atomic_load(flag, __ATOMIC_RELAXED, __HIP_MEMORY_SCOPE_AGENT)) == 0u) {
                if (__builtin_amdgcn_s_memrealtime() - t0 > 2000000ull) break;
                __builtin_amdgcn_s_sleep(2); }
            __builtin_amdgcn_fence(__ATOMIC_ACQUIRE, "agent");
            asm volatile("s_waitcnt vmcnt(0)" ::: "memory");
#pragma unroll
            for (int ai = 0; ai < 2; ++ai)
#pragma unroll
                for (int bj = 0; bj < 2; ++bj) {
#pragma unroll
                    for (int m = 0; m < 4; ++m) {
#pragma unroll
                        for (int n = 0; n < 2; ++n) acc[ai][bj][m][n] += pp[(size_t)((((ai * 2 + bj) * 4 + m) * 2 + n) * 512)];
                        if (m & 1) asm volatile("" ::: "memory");
                    }
                }
        }
        const int col0 = u.pn * 256 + wc * 32 + 4 * fq, j = modidx(u.pm * 256);
        const float* gp = gate + (size_t)j * 6144 + col0;
        f32x4 gv[2][2], gn[2][2];
#pragma unroll
        for (int bj = 0; bj < 2; ++bj)
#pragma unroll
            for (int n = 0; n < 2; ++n) {
                gv[bj][n] = *(const f32x4*)(gp + bj * 128 + n * 16);
                if (has_next) gn[bj][n] = *(const f32x4*)(nw + col0 + bj * 128 + n * 16) * (*(const f32x4*)(sc + (size_t)j * 6144 + col0 + bj * 128 + n * 16) + 1.0f);
                else gn[bj][n] = (f32x4){0.f, 0.f, 0.f, 0.f};
            }
#pragma unroll
        for (int hp = 0; hp < 4; ++hp) {
            const int ai = hp >> 1, m0 = (hp & 1) * 2;
            f32x4 pre[2][2][2];
#pragma unroll
            for (int mm = 0; mm < 2; ++mm) {
                const int row = u.pm * 256 + ai * 128 + wr * 64 + (m0 + mm) * 16 + fr;
                const float* b = (row < MP) ? baseP + (size_t)row * D : baseS + (size_t)(row - MP) * D;
#pragma unroll
                for (int bj = 0; bj < 2; ++bj)
#pragma unroll
                    for (int n = 0; n < 2; ++n) pre[mm][bj][n] = *(const f32x4*)(b + col0 + bj * 128 + n * 16);
            }
#pragma unroll
            for (int mm = 0; mm < 2; ++mm) {
                const int m = m0 + mm;
                const int row = u.pm * 256 + ai * 128 + wr * 64 + m * 16 + fr;
                float q = 0.f;
#pragma unroll
                for (int bj = 0; bj < 2; ++bj)
#pragma unroll
                    for (int n = 0; n < 2; ++n) {
                        const int c = col0 + bj * 128 + n * 16;
                        const f32x4 x = pre[mm][bj][n] + gv[bj][n] * acc[ai][bj][m][n];
                        __builtin_nontemporal_store(x, (f32x4*)(out + (size_t)row * D + c));
                        q += (x.x * x.x + x.y * x.y) + (x.z * x.z + x.w * x.w);
                        if (has_next) { const f32x4 y = x * gn[bj][n]; u32x2 w; w.x = pk2(y.x, y.y); w.y = pk2(y.z, y.w); *(u32x2*)(xg + (size_t)row * D + c) = w; }
                    }
                q += __shfl_xor(q, 16); q += __shfl_xor(q, 32);
                if (fq == 0 && has_next) ssq[(size_t)row * 16 + u.pn * 4 + wc] = q;
            }
        }
    }
};

struct RangeOrder : pg8::StaticOrder {
    int lo, hi, fix;
    __host__ __device__ bool next(int i, pg8::Unit& u) const {
        long L;
        if (fix >= 0) { if (i > 0) return false; L = fix; } else { L = (long)lo + (long)i * G + c; if (L >= hi) return false; }
        int wgid = (int)L; { const int q = nwg / pg8::NXCD, r = nwg % pg8::NXCD, xcd = wgid % pg8::NXCD, off = wgid / pg8::NXCD; wgid = (xcd < r ? xcd * (q + 1) : r * (q + 1) + (xcd - r) * q) + off; }
        const int nig = pg8::WGM * nN, gid = wgid / nig, fm = gid * pg8::WGM, gsz = (nM - fm) < pg8::WGM ? (nM - fm) : pg8::WGM;
        u.pm = fm + ((wgid % nig) % gsz); u.pn = (wgid % nig) / gsz; return true;
    }
};

DI void transpose_item(const float* W, int K, int N, bf16_t* WT, LAS float* scr, int item, int lane) {
    const int nblk = N / 64, kb = item / nblk, nb = item - kb * nblk, k0 = 64 * kb, n0 = 64 * nb;
    const int kr = lane >> 4, nq = lane & 15;
    f32x4 v[16];
#pragma unroll
    for (int i = 0; i < 16; ++i) v[i] = *(const f32x4*)(W + (size_t)(k0 + 4 * i + kr) * N + n0 + 4 * nq);
#pragma unroll
    for (int i = 0; i < 16; ++i) { LAS float* d = scr + (4 * i + kr) * 65 + 4 * nq; d[0] = v[i].x; d[1] = v[i].y; d[2] = v[i].z; d[3] = v[i].w; }
    asm volatile("s_waitcnt lgkmcnt(0)" ::: "memory");
    const int c = lane & 7;
#pragma unroll
    for (int j = 0; j < 8; ++j) { const int n = (lane >> 3) + 8 * j; const LAS float* s = scr + (8 * c) * 65 + n;
        u32x4 o; o.x = pk2(s[0 * 65], s[1 * 65]); o.y = pk2(s[2 * 65], s[3 * 65]); o.z = pk2(s[4 * 65], s[5 * 65]); o.w = pk2(s[6 * 65], s[7 * 65]);
        *(u32x4*)(WT + (size_t)(n0 + n) * K + k0 + 8 * c) = o; }
    asm volatile("s_waitcnt lgkmcnt(0)" ::: "memory");
}
DI void gemv9_unit(const float* W, int N, int n0, const float* v0, const float* v1, int vs, bool do_silu, const float* badd, float* out, int ostride, float* scr, int tid) {
    const int wave = __builtin_amdgcn_readfirstlane(tid >> 6), lane = tid & 63;
    float* sv = scr; float* red = scr + NMOD * 1024;
    for (int idx = tid; idx < NMOD * 1024; idx += 512) {
        const int j = idx >> 10, k = idx & 1023;
        float v = (j == 0) ? v0[k] : v1[(size_t)(j - 1) * vs + k];
        if (do_silu) v = v * sigmoidf_(v);
        sv[idx] = v;
    }
    __syncthreads();
    float acc[NMOD];
#pragma unroll
    for (int j = 0; j < NMOD; ++j) acc[j] = 0.f;
    const float* wp = W + (size_t)(wave * 128) * N + n0 + lane;
#pragma unroll 2
    for (int k = 0; k < 128; k += 4) {
        const float w0 = wp[(size_t)k * N], w1 = wp[(size_t)(k + 1) * N], w2 = wp[(size_t)(k + 2) * N], w3 = wp[(size_t)(k + 3) * N];
#pragma unroll
        for (int j = 0; j < NMOD; ++j) {
            const f32x4 s = *(const f32x4*)(sv + j * 1024 + wave * 128 + k);
            acc[j] += (s.x * w0 + s.y * w1) + (s.z * w2 + s.w * w3);
        }
    }
#pragma unroll
    for (int j = 0; j < NMOD; ++j) red[(wave * NMOD + j) * 64 + lane] = acc[j];
    __syncthreads();
    for (int idx = tid; idx < NMOD * 64; idx += 512) {
        const int j = idx >> 6, ln = idx & 63; float s = 0.f;
#pragma unroll
        for (int w = 0; w < 8; ++w) s += red[(w * NMOD + j) * 64 + ln];
        if (badd) s += badd[n0 + ln];
        out[(size_t)j * ostride + n0 + ln] = s;
    }
    __syncthreads();
}

DI void conv_unit(int ct, int l, const bf16_t* RAW, bf16_t* ATT, const float* dw_w, const float* dw_b, const float* ln_g, const float* ln_b, float* lds, int tid) {
    const int row0 = ct * 64;
    int seq0, L;
    if (row0 < MP) { seq0 = row0 & ~255; L = 256; } else { seq0 = MP + ((row0 - MP) & ~2047); L = 2048; }
    const int t0 = row0 - seq0;
    {
        u32x4 wa[6], wg[6];
#pragma unroll
        for (int i = 0; i < 6; ++i) {
            const int it = tid + 512 * i, rr = it >> 5, c8 = it & 31, t = t0 - 15 + rr;
            if (it < 94 * 32 && t >= 0 && t < L) { const bf16_t* p = RAW + (size_t)(seq0 + t) * INW + c8 * 8; wa[i] = *(const u32x4*)p; wg[i] = *(const u32x4*)(p + 256); }
            else { wa[i] = (u32x4){0u, 0u, 0u, 0u}; wg[i] = (u32x4){0u, 0u, 0u, 0u}; }
        }
#pragma unroll
        for (int i = 0; i < 6; ++i) {
            const int it = tid + 512 * i, rr = it >> 5, c8 = it & 31;
            if (it < 94 * 32) {
                float a[8], g[8], hv[8]; unpack8(wa[i], a); unpack8(wg[i], g);
#pragma unroll
                for (int e2 = 0; e2 < 8; ++e2) hv[e2] = a[e2] * sigmoidf_(g[e2]);
                float* d = lds + rr * 256 + c8 * 8;
                *(f32x4*)d = (f32x4){hv[0], hv[1], hv[2], hv[3]}; *(f32x4*)(d + 4) = (f32x4){hv[4], hv[5], hv[6], hv[7]};
            }
        }
    }
    __syncthreads();
    const int c = tid & 255, th = tid >> 8;
    float w[31];
#pragma unroll
    for (int k = 0; k < 31; ++k) w[k] = dw_w[(size_t)(l * 31 + k) * 256 + c];
    const float bias = dw_b[l * 256 + c];
    float outv[32];
#pragma unroll
    for (int ch = 0; ch < 2; ++ch) {
        float hv[46];
#pragma unroll
        for (int i = 0; i < 46; ++i) hv[i] = lds[(th * 32 + ch * 16 + i) * 256 + c];
#pragma unroll
        for (int o = 0; o < 16; ++o) {
            float s = bias;
#pragma unroll
            for (int k = 0; k < 31; ++k) s += hv[o + k] * w[k];
            outv[ch * 16 + o] = s;
        }
    }
    __syncthreads();
#pragma unroll
    for (int o = 0; o < 32; ++o) lds[(th * 32 + o) * 256 + c] = outv[o];
    __syncthreads();
    const int wave = tid >> 6, lane = tid & 63;
    const f32x4 g4 = *(const f32x4*)(ln_g + l * 256 + 4 * lane), b4 = *(const f32x4*)(ln_b + l * 256 + 4 * lane);
#pragma unroll
    for (int i = 0; i < 8; ++i) {
        const int tk = wave * 8 + i;
        const f32x4 v = *(const f32x4*)(lds + tk * 256 + 4 * lane);
        const float mean = wave_sum((v.x + v.y) + (v.z + v.w)) * (1.f / 256.f);
        const f32x4 dv = v - mean;
        const float var = wave_sum((dv.x * dv.x + dv.y * dv.y) + (dv.z * dv.z + dv.w * dv.w)) * (1.f / 256.f);
        const float rstd = rsqrtf(var + EPS);
        f32x4 y = dv * rstd * g4 + b4;
        y.x *= sigmoidf_(y.x); y.y *= sigmoidf_(y.y); y.z *= sigmoidf_(y.z); y.w *= sigmoidf_(y.w);
        u32x2 o; o.x = pk2(y.x, y.y); o.y = pk2(y.z, y.w);
        *(u32x2*)(ATT + (size_t)(row0 + tk) * D + 4 * lane) = o;
    }
    __syncthreads();
}

struct PrepP { const bf16_t* RAW; bf16_t* Q; bf16_t* K; bf16_t* VT; float* out; const float *aqg, *akg, *nqg, *nkg; };
DI void qkv_unit(int ct, int l, const PrepP& P, bf16_t* ldsv, int tid) {
    const int row0 = ct * 64;
    const bool prompt = row0 < MP;
    int seq0, L, sb;
    if (prompt) { seq0 = row0 & ~255; L = 256; sb = row0 >> 8; } else { seq0 = MP + ((row0 - MP) & ~2047); L = 2048; sb = (row0 - MP) >> 11; }
    const int t0 = row0 - seq0;
    {
    const int lane = tid & 63, wave = __builtin_amdgcn_readfirstlane(tid >> 6), half = lane >> 5;
    for (int wi = wave; wi < 40; wi += 8) {
        const int hd = wi >> 1, tok = (wi & 1) * 32 + (lane & 31);
        const int row = row0 + tok, t = t0 + tok;
        int rcol; const float* gw; bool isq;
        if (hd < 6) { rcol = 512 + 64 * hd; gw = P.aqg; isq = true; }
        else if (hd < 8) { rcol = 896 + 64 * (hd - 6); gw = P.akg; isq = false; }
        else if (hd < 14) { rcol = 1152 + 64 * (hd - 8); gw = P.nqg; isq = true; }
        else { rcol = 1536 + 64 * (hd - 14); gw = P.nkg; isq = false; }
        float v[32];
        const bf16_t* rp = P.RAW + (size_t)row * INW + rcol + 32 * half;
#pragma unroll
        for (int c = 0; c < 4; ++c) { const u32x4 wv = *(const u32x4*)(rp + 8 * c); float tmp[8]; unpack8(wv, tmp);
#pragma unroll
            for (int e2 = 0; e2 < 8; ++e2) v[8 * c + e2] = tmp[e2]; }
        float ss = 0.f;
#pragma unroll
        for (int d = 0; d < 32; ++d) ss += v[d] * v[d];
        ss += __shfl_xor(ss, 32);
        const float rstd = rsqrtf(ss * (1.f / 64.f) + EPS);
        const float* gp = gw + l * 64 + 32 * half;
#pragma unroll
        for (int c4 = 0; c4 < 8; ++c4) { const f32x4 g4 = *(const f32x4*)(gp + 4 * c4); v[4 * c4] *= rstd * g4.x; v[4 * c4 + 1] *= rstd * g4.y; v[4 * c4 + 2] *= rstd * g4.z; v[4 * c4 + 3] *= rstd * g4.w; }
        if ((!prompt) && (hd < 8)) {
            const float pos = (float)(half ? (t & 63) : (t >> 6));
#pragma unroll
            for (int j = 0; j < 16; ++j) {
                const float inv = exp2f(-(float)j * 0.8304820237218406f);
                float sn, cs; __sincosf(pos * inv, &sn, &cs);
                const float a = v[j], b = v[16 + j];
                v[j] = a * cs - b * sn; v[16 + j] = b * cs + a * sn;
            }
        }
        if (isq) {
            const int qh = (hd < 6) ? hd : 6 + (hd - 8);
            bf16_t* qp = P.Q + (prompt ? ((size_t)(sb * 12 + qh) * 8 + (t >> 5)) * 2048 : (size_t)MP * 768 + ((size_t)(sb * 12 + qh) * 64 + (t >> 5)) * 2048) + (t & 31) * 8 + half * 1024;
#pragma unroll
            for (int c = 0; c < 4; ++c) {
                u32x4 o; o.x = pk2(v[8 * c] * QSCALE, v[8 * c + 1] * QSCALE); o.y = pk2(v[8 * c + 2] * QSCALE, v[8 * c + 3] * QSCALE);
                o.z = pk2(v[8 * c + 4] * QSCALE, v[8 * c + 5] * QSCALE); o.w = pk2(v[8 * c + 6] * QSCALE, v[8 * c + 7] * QSCALE);
                *(u32x4*)(qp + c * 256) = o;
            }
        } else {
            const int kh = (hd < 8) ? (hd - 6) : 2 + (hd - 14);
            bf16_t* kp = P.K + (prompt ? ((size_t)(sb * 8 + kh) * 8 + (t >> 5)) * 2048 : (size_t)MP * 512 + ((size_t)(sb * 8 + kh) * 64 + (t >> 5)) * 2048) + (t & 31) * 8 + half * 1024;
#pragma unroll
            for (int c = 0; c < 4; ++c) {
                u32x4 o; o.x = pk2(v[8 * c], v[8 * c + 1]); o.y = pk2(v[8 * c + 2], v[8 * c + 3]); o.z = pk2(v[8 * c + 4], v[8 * c + 5]); o.w = pk2(v[8 * c + 6], v[8 * c + 7]);
                *(u32x4*)(kp + c * 256) = o;
            }
            if (prompt) {
                float* op;
                if (hd < 8) op = P.out + OFF_AK + ((((size_t)sb * 4 + l) * 256 + t) * 2 + (hd - 6)) * 64 + 32 * half;
                else        op = P.out + OFF_NK + ((((size_t)sb * 4 + l) * 256 + t) * 6 + (hd - 14)) * 64 + 32 * half;
#pragma unroll
                for (int c4 = 0; c4 < 8; ++c4) *(f32x4*)(op + 4 * c4) = (f32x4){v[4 * c4], v[4 * c4 + 1], v[4 * c4 + 2], v[4 * c4 + 3]};
            }
        }
    }
    }
    {
        u32x4 wv8[8];
#pragma unroll
        for (int i = 0; i < 8; ++i) {
            const int it = tid + 512 * i, tok = it >> 6, cc = (it & 63) * 8, rcol = (cc < 128) ? 1024 + cc : 1920 + (cc - 128);
            wv8[i] = *(const u32x4*)(P.RAW + (size_t)(row0 + tok) * INW + rcol);
        }
#pragma unroll
        for (int i = 0; i < 8; ++i) {
            const int it = tid + 512 * i, tok = it >> 6, cc = (it & 63) * 8;
            const u32x4 wv = wv8[i];
            *(u32x4*)(ldsv + tok * 512 + cc) = wv;
            if (prompt) {
                float v[8]; unpack8(wv, v);
                const int t = t0 + tok; float* op;
                if (cc < 128) op = P.out + OFF_AV + (((size_t)sb * 4 + l) * 256 + t) * 128 + cc;
                else          op = P.out + OFF_NV + (((size_t)sb * 4 + l) * 256 + t) * 384 + (cc - 128);
                *(f32x4*)op = (f32x4){v[0], v[1], v[2], v[3]}; *(f32x4*)(op + 4) = (f32x4){v[4], v[5], v[6], v[7]};
            }
        }
    }
    __syncthreads();
    for (int it = tid; it < 512 * 8; it += 512) {
        const int hd_d = it & 511, g = it >> 9;
        unsigned short e[8];
#pragma unroll
        for (int jj = 0; jj < 8; ++jj) { const int p = 8 * g + jj; const int key = (p & ~31) + permkey(p & 31); e[jj] = ldsv[key * 512 + hd_d]; }
        u32x4 o; o.x = e[0] | ((unsigned)e[1] << 16); o.y = e[2] | ((unsigned)e[3] << 16); o.z = e[4] | ((unsigned)e[5] << 16); o.w = e[6] | ((unsigned)e[7] << 16);
        const int vh = hd_d >> 6, dd = hd_d & 63, tile = (t0 >> 5) + (g >> 2);
        const size_t base = prompt ? ((size_t)(sb * 8 + vh) * 8 + tile) * 2048 : (size_t)MP * 512 + ((size_t)(sb * 8 + vh) * 64 + tile) * 2048;
        *(u32x4*)(P.VT + base + ((((dd >> 5) * 2 + ((g >> 1) & 1)) * 2 + (g & 1)) * 32 + (dd & 31)) * 8) = o;
    }
    __syncthreads();
}

struct Seg { const bf16_t* k; const bf16_t* v; int nt; };
#define MFMA32(a, b, c) __builtin_amdgcn_mfma_f32_32x32x16_bf16((a), (b), (c), 0, 0, 0)
DI void issue_tile(const Seg& A, const Seg& B, int t, int lane, LAS unsigned char* slot) {
    const bf16_t* kp = (t < A.nt) ? A.k + (size_t)t * 2048 : B.k + (size_t)(t - A.nt) * 2048;
    const bf16_t* vp = (t < A.nt) ? A.v + (size_t)t * 2048 : B.v + (size_t)(t - A.nt) * 2048;
#pragma unroll
    for (int i = 0; i < 4; ++i) __builtin_amdgcn_global_load_lds((const unsigned*)(kp + i * 512 + lane * 8), (LAS unsigned*)(slot + i * 1024), 16, 0, 0);
#pragma unroll
    for (int i = 0; i < 4; ++i) __builtin_amdgcn_global_load_lds((const unsigned*)(vp + i * 512 + lane * 8), (LAS unsigned*)(slot + 4096 + i * 1024), 16, 0, 0);
}
template <bool NA, int NQB> DI void attn_wave(const bf16_t* Qp, const Seg A, const Seg B, bf16_t* Op, const float* rpbh, int r, int rs, int lane_, LAS unsigned char* ring, LAS float* biasl, int qoff) {
    int lane = lane_; asm volatile("" : "+v"(lane));
    const int r32 = lane & 31, hi = lane >> 5;
    const int nt = A.nt + B.nt;
    issue_tile(A, B, 0, lane, ring);
    issue_tile(A, B, 1, lane, ring + 8192);
    if (NA) { for (int i = lane; i < 15 * 31; i += 64) biasl[i] = rpbh[i] * LOG2E; }
    bf16x8 qf[NQB][4];
#pragma unroll
    for (int qb = 0; qb < NQB; ++qb)
#pragma unroll
        for (int kk = 0; kk < 4; ++kk) qf[qb][kk] = *(const bf16x8*)(Qp + (qoff + qb) * 2048 + kk * 512 + lane * 8);
    f32x16 o[NQB][2];
#pragma unroll
    for (int a = 0; a < NQB; ++a)
#pragma unroll
        for (int b = 0; b < 2; ++b)
#pragma unroll
            for (int i = 0; i < 16; ++i) o[a][b][i] = 0.f;
    float mrun[NQB], lrun[NQB];
#pragma unroll
    for (int a = 0; a < NQB; ++a) { mrun[a] = -1e30f; lrun[a] = 0.f; }
    asm volatile("s_waitcnt vmcnt(0)" ::: "memory");
#pragma nounroll
    for (int t = 0; t < nt; ++t) {
        LAS unsigned char* slot = ring + (t & 1) * 8192;
        if (t + 1 < nt) asm volatile("s_waitcnt vmcnt(8)" ::: "memory"); else asm volatile("s_waitcnt vmcnt(0)" ::: "memory");
        bf16x8 kf[4], vf[2][2];
#pragma unroll
        for (int kk = 0; kk < 4; ++kk) kf[kk] = *(const LAS bf16x8*)(slot + kk * 1024 + lane * 16);
#pragma unroll
        for (int db = 0; db < 2; ++db)
#pragma unroll
            for (int s2 = 0; s2 < 2; ++s2) vf[db][s2] = *(const LAS bf16x8*)(slot + 4096 + (db * 2 + s2) * 1024 + lane * 16);
        asm volatile("s_waitcnt lgkmcnt(0)" ::: "memory");
        if (t + 2 < nt) issue_tile(A, B, t + 2, lane, slot);
#pragma unroll
        for (int qb = 0; qb < NQB; ++qb) {
            f32x16 s;
#pragma unroll
            for (int i = 0; i < 16; ++i) s[i] = 0.f;
#pragma unroll
            for (int kk = 0; kk < 4; ++kk) s = MFMA32(kf[kk], qf[qb][kk], s);
            if (NA) {
                if (t < A.nt) {
                    const int a = t >> 1, half = t & 1;
                    const int qc = 32 * (qoff + qb) + r32, cs = min(max(qc - 8, 0), 48);
                    const int kc0 = 32 * half + 4 * hi;
                    const LAS float* bp = biasl + (rs + a - r + 7) * 31 + (kc0 - qc + 15);
                    const unsigned u0 = (unsigned)(kc0 - cs);
                    float bia[16];
#pragma unroll
                    for (int i = 0; i < 16; ++i) bia[i] = bp[(i & 3) + 8 * (i >> 2)];
                    asm volatile("" : "+v"(bia[0]), "+v"(bia[1]), "+v"(bia[2]), "+v"(bia[3]), "+v"(bia[4]), "+v"(bia[5]), "+v"(bia[6]), "+v"(bia[7]),
                                      "+v"(bia[8]), "+v"(bia[9]), "+v"(bia[10]), "+v"(bia[11]), "+v"(bia[12]), "+v"(bia[13]), "+v"(bia[14]), "+v"(bia[15]));
#pragma unroll
                    for (int i = 0; i < 16; ++i) {
                        const bool valid = (u0 + (unsigned)((i & 3) + 8 * (i >> 2))) < 16u;
                        s[i] = valid ? s[i] + bia[i] : -1e30f;
                    }
                }
            }
            float mx = s[0];
#pragma unroll
            for (int i = 1; i < 16; ++i) mx = fmaxf(mx, s[i]);
            mx = fmaxf(mx, __shfl_xor(mx, 32));
            const float mn = fmaxf(mrun[qb], mx);
            const float alpha = __builtin_amdgcn_exp2f(mrun[qb] - mn);
            mrun[qb] = mn;
            float ps = 0.f;
#pragma unroll
            for (int i = 0; i < 16; ++i) { const float p = __builtin_amdgcn_exp2f(s[i] - mn); s[i] = p; ps += p; }
            lrun[qb] = lrun[qb] * alpha + ps;
#pragma unroll
            for (int i = 0; i < 16; ++i) { o[qb][0][i] *= alpha; o[qb][1][i] *= alpha; }
            u32x4 p0, p1;
            p0.x = pk2(s[0], s[1]); p0.y = pk2(s[2], s[3]); p0.z = pk2(s[4], s[5]); p0.w = pk2(s[6], s[7]);
            p1.x = pk2(s[8], s[9]); p1.y = pk2(s[10], s[11]); p1.z = pk2(s[12], s[13]); p1.w = pk2(s[14], s[15]);
            const bf16x8 P0 = __builtin_bit_cast(bf16x8, p0), P1 = __builtin_bit_cast(bf16x8, p1);
#pragma unroll
            for (int db = 0; db < 2; ++db) { o[qb][db] = MFMA32(vf[db][0], P0, o[qb][db]); o[qb][db] = MFMA32(vf[db][1], P1, o[qb][db]); }
        }
    }
#pragma unroll
    for (int qb = 0; qb < NQB; ++qb) {
        const float lt = lrun[qb] + __shfl_xor(lrun[qb], 32);
        const float inv = 1.f / lt;
        bf16_t* orow = Op + (size_t)(32 * (qoff + qb) + r32) * D;
#pragma unroll
        for (int db = 0; db < 2; ++db)
#pragma unroll
            for (int g = 0; g < 4; ++g) {
                u32x2 w; w.x = pk2(o[qb][db][4 * g] * inv, o[qb][db][4 * g + 1] * inv); w.y = pk2(o[qb][db][4 * g + 2] * inv, o[qb][db][4 * g + 3] * inv);
                *(u32x2*)(orow + 32 * db + 8 * g + 4 * hi) = w;
            }
    }
}

DI void attn_wave_shared(const bf16_t* Qp, const Seg A, const Seg B, bf16_t* Op, int lane_, int wave, LAS unsigned char* ring) {
    int lane = lane_; asm volatile("" : "+v"(lane));
    const int r32 = lane & 31, hi = lane >> 5;
    const int nt = A.nt + B.nt;
    const bool isk = wave < 4;
    const int poff = (isk ? wave : wave - 4) * 512;
    const int loff = isk ? wave * 1024 : 4096 + (wave - 4) * 1024;
    const bf16_t* srcA = (isk ? A.k : A.v) + poff + lane * 8;
    const bf16_t* srcB = (isk ? B.k : B.v) + poff + lane * 8;
#define ISSUE_PIECE(tt) do { const int t_ = (tt); const bf16_t* src_ = (t_ < A.nt) ? srcA + (size_t)t_ * 2048 : srcB + (size_t)(t_ - A.nt) * 2048; \
        __builtin_amdgcn_global_load_lds((const unsigned*)src_, (LAS unsigned*)(ring + (t_ & 15) * 8192 + loff), 16, 0, 0); } while (0)
    bf16x8 qf[2][4];
#pragma unroll
    for (int qb = 0; qb < 2; ++qb)
#pragma unroll
        for (int kk = 0; kk < 4; ++kk) qf[qb][kk] = *(const bf16x8*)(Qp + qb * 2048 + kk * 512 + lane * 8);
    asm volatile("s_waitcnt vmcnt(0) lgkmcnt(0)" ::: "memory");
#pragma unroll
    for (int tt = 0; tt < 8; ++tt) ISSUE_PIECE(tt);
    f32x16 o[2][2];
#pragma unroll
    for (int a = 0; a < 2; ++a)
#pragma unroll
        for (int b = 0; b < 2; ++b)
#pragma unroll
            for (int i = 0; i < 16; ++i) o[a][b][i] = 0.f;
    float mrun[2] = {-1e30f, -1e30f}, lrun[2] = {0.f, 0.f};
#pragma nounroll
    for (int t = 0; t < nt; ++t) {
        if ((t & 7) == 0) {
            asm volatile("s_waitcnt vmcnt(0) lgkmcnt(0)\n\ts_barrier" ::: "memory");
            if (t + 8 < nt) {
#pragma unroll
                for (int tt = 0; tt < 8; ++tt) ISSUE_PIECE(t + 8 + tt);
            }
            if (((wave ^ (wave >> 2)) & 1) != 0) __builtin_amdgcn_s_sleep(19);
        }
        LAS unsigned char* slot = ring + (t & 15) * 8192;
        bf16x8 kf[4], vf[2][2];
#pragma unroll
        for (int kk = 0; kk < 4; ++kk) kf[kk] = *(const LAS bf16x8*)(slot + kk * 1024 + lane * 16);
#pragma unroll
        for (int db = 0; db < 2; ++db)
#pragma unroll
            for (int s2 = 0; s2 < 2; ++s2) vf[db][s2] = *(const LAS bf16x8*)(slot + 4096 + (db * 2 + s2) * 1024 + lane * 16);
        asm volatile("s_waitcnt lgkmcnt(0)" ::: "memory");
#pragma unroll
        for (int qb = 0; qb < 2; ++qb) {
            f32x16 s;
#pragma unroll
            for (int i = 0; i < 16; ++i) s[i] = 0.f;
#pragma unroll
            for (int kk = 0; kk < 4; ++kk) s = MFMA32(kf[kk], qf[qb][kk], s);
            float mx = s[0];
#pragma unroll
            for (int i = 1; i < 16; ++i) mx = fmaxf(mx, s[i]);
            mx = fmaxf(mx, __shfl_xor(mx, 32));
            const float mn = fmaxf(mrun[qb], mx);
            const float alpha = __builtin_amdgcn_exp2f(mrun[qb] - mn);
            mrun[qb] = mn;
            float ps = 0.f;
#pragma unroll
            for (int i = 0; i < 16; ++i) { const float p = __builtin_amdgcn_exp2f(s[i] - mn); s[i] = p; ps += p; }
            lrun[qb] = lrun[qb] * alpha + ps;
#pragma unroll
            for (int i = 0; i < 16; ++i) { o[qb][0][i] *= alpha; o[qb][1][i] *= alpha; }
            u32x4 p0, p1;
            p0.x = pk2(s[0], s[1]); p0.y = pk2(s[2], s[3]); p0.z = pk2(s[4], s[5]); p0.w = pk2(s[6], s[7]);
            p1.x = pk2(s[8], s[9]); p1.y = pk2(s[10], s[11]); p1.z = pk2(s[12], s[13]); p1.w = pk2(s[14], s[15]);
            const bf16x8 P0 = __builtin_bit_cast(bf16x8, p0), P1 = __builtin_bit_cast(bf16x8, p1);
#pragma unroll
            for (int db = 0; db < 2; ++db) { o[qb][db] = MFMA32(vf[db][0], P0, o[qb][db]); o[qb][db] = MFMA32(vf[db][1], P1, o[qb][db]); }
        }
    }
#undef ISSUE_PIECE
#pragma unroll
    for (int qb = 0; qb < 2; ++qb) {
        const float lt = lrun[qb] + __shfl_xor(lrun[qb], 32);
        const float inv = 1.f / lt;
        bf16_t* orow = Op + (size_t)(32 * qb + r32) * D;
#pragma unroll
        for (int db = 0; db < 2; ++db)
#pragma unroll
            for (int g = 0; g < 4; ++g) {
                u32x2 w; w.x = pk2(o[qb][db][4 * g] * inv, o[qb][db][4 * g + 1] * inv); w.y = pk2(o[qb][db][4 * g + 2] * inv, o[qb][db][4 * g + 3] * inv);
                *(u32x2*)(orow + 32 * db + 8 * g + 4 * hi) = w;
            }
    }
    asm volatile("s_waitcnt vmcnt(0) lgkmcnt(0)\n\ts_barrier" ::: "memory");
}

struct AttnP { const bf16_t *Q, *K, *VT, *KCA, *VCA, *KCN, *VCN; bf16_t* ATT; const float* rpb; };
DI void attn_run_unit(int uid, int qsel, int l, const AttnP& P, int lane, LAS unsigned char* ring, LAS float* biasl, bool shared, int wave, LAS unsigned char* lds0) {
    const size_t QS = (size_t)MP * 768, KS = (size_t)MP * 512;
    Seg A, B{nullptr, nullptr, 0}; const bf16_t* Qp; bf16_t* Op; const float* rp = nullptr; int r = 0, rs = 0; bool na = false;
    if (uid < 1536) {
        const int qc = uid & 31, bh = uid >> 5, b = bh / 6, h = bh - 6 * b, kvh = h / 3;
        const int row0 = MP + b * 2048;
        A = Seg{P.K + KS + (size_t)(b * 8 + kvh) * 64 * 2048, P.VT + KS + (size_t)(b * 8 + kvh) * 64 * 2048, 64};
        B = Seg{P.KCA + (size_t)((b * 4 + l) * 2 + kvh) * 16384, P.VCA + (size_t)((b * 4 + l) * 2 + kvh) * 16384, 8};
        Qp = P.Q + QS + ((size_t)(b * 12 + h) * 64 + 2 * qc) * 2048; Op = P.ATT + (size_t)(row0 + qc * 64) * D + 256 + h * 64;
    } else if (uid < 3072) {
        const int u = uid - 1536, bh = u >> 5, b = bh / 6, h = bh - 6 * b;
        r = u & 31; rs = min(max(r - 4, 0), 24); na = true;
        const int row0 = MP + b * 2048;
        A = Seg{P.K + KS + ((size_t)(b * 8 + 2 + h) * 64 + 2 * rs) * 2048, P.VT + KS + ((size_t)(b * 8 + 2 + h) * 64 + 2 * rs) * 2048, 16};
        B = Seg{P.KCN + (size_t)((b * 4 + l) * 6 + h) * 16384, P.VCN + (size_t)((b * 4 + l) * 6 + h) * 16384, 8};
        Qp = P.Q + QS + ((size_t)(b * 12 + 6 + h) * 64 + 2 * r) * 2048; Op = P.ATT + (size_t)(row0 + r * 64) * D + 640 + h * 64;
        rp = P.rpb + (size_t)(l * 6 + h) * 15 * 31;
    } else {
        const int nah = uid >= 3840;
        const int u = uid - (nah ? 3840 : 3072), qc = u & 3, bh = u >> 2, b = bh / 6, h = bh - 6 * b, kh = nah ? 2 + h : h / 3;
        const int row0 = b * 256;
        A = Seg{P.K + (size_t)(b * 8 + kh) * 8 * 2048, P.VT + (size_t)(b * 8 + kh) * 8 * 2048, 8};
        Qp = P.Q + ((size_t)(b * 12 + (nah ? 6 : 0) + h) * 8 + 2 * qc) * 2048; Op = P.ATT + (size_t)(row0 + qc * 64) * D + (nah ? 640 : 256) + h * 64;
    }
    if (na) { if (qsel == 2) attn_wave<true, 2>(Qp, A, B, Op, rp, r, rs, lane, ring, biasl, 0); else attn_wave<true, 1>(Qp, A, B, Op, rp, r, rs, lane, ring, biasl, qsel); }
    else if (shared) attn_wave_shared(Qp, A, B, Op, lane, wave, lds0);
    else attn_wave<false, 2>(Qp, A, B, Op, rp, r, rs, lane, ring, biasl, 0);
}

struct Args {
    const float* in[25]; float* out; unsigned char* ws; int ph_lo, ph_hi;
};
#define XB_TMO      128
#define XB_XCNT(j)  (256  + 64 * (j))
#define XB_XSUB(j)  (1280 + 64 * (j))
#define XB_XGEN(j)  (2304 + 64 * (j))
#define XB_TOP      3328
#define XB_TOPGEN   3392
#define XCD_BAR_WORDS 3456
#define XB_SPIN_CAP (1u << 18)

__device__ __forceinline__ unsigned xb_ld(unsigned* p)              { return __hip_atomic_load(p, __ATOMIC_RELAXED, __HIP_MEMORY_SCOPE_AGENT); }
__device__ __forceinline__ unsigned xb_add(unsigned* p, unsigned v) { return __hip_atomic_fetch_add(p, v, __ATOMIC_RELAXED, __HIP_MEMORY_SCOPE_AGENT); }
__device__ __forceinline__ unsigned xb_xcc_id() { return (unsigned)__builtin_amdgcn_s_getreg((3 << 11) | 20) & 0xFu; }
#define XB_SPIN(cond, bar) do { unsigned _sp = 0; while (cond) { __builtin_amdgcn_s_sleep(1); \
    if ((++_sp & 255u) == 0u) { if (xb_ld(&(bar)[XB_TMO])) break; if (_sp > XB_SPIN_CAP) { atomicAdd(&(bar)[XB_TMO], 1u); break; } } } } while (0)

struct XcdBarrier {
    unsigned* bar; unsigned x;
    volatile LAS unsigned* st;
};

__device__ __forceinline__ XcdBarrier xcd_barrier_post(unsigned* bar, volatile LAS unsigned* st) {
    XcdBarrier b; b.bar = bar; b.x = xb_xcc_id(); b.st = st;
    if (threadIdx.x == 0) { const unsigned old_ = xb_add(&bar[XB_XCNT(b.x)], 1u); st[2] = old_; st[3] = b.x; }
    return b;
}
__device__ __forceinline__ void xcd_barrier_complete(unsigned* bar, unsigned x, unsigned& nloc, unsigned& nx) {
    const unsigned G = gridDim.x * gridDim.y * gridDim.z;
    unsigned sum, cnt, mine, sp = 0u;
    for (;;) {
        sum = 0u; cnt = 0u; mine = 0u;
#pragma unroll
        for (unsigned j = 0; j < 16; ++j) { const unsigned c = xb_ld(&bar[XB_XCNT(j)]); sum += c; cnt += (c > 0u) ? 1u : 0u; mine = (j == x) ? c : mine; }
        if (sum == G) break;
        __builtin_amdgcn_s_sleep(1);
        if ((++sp & 255u) == 0u) { if (xb_ld(&bar[XB_TMO])) break; if (sp > XB_SPIN_CAP) { atomicAdd(&bar[XB_TMO], 1u); break; } }
    }
    nloc = mine > 0u ? mine : 1u; nx = cnt > 0u ? cnt : 1u;
}

__device__ __forceinline__ void xcd_barrier(const XcdBarrier& b) {
    asm volatile("s_waitcnt vmcnt(0)" ::: "memory");
    __syncthreads();
    if (threadIdx.x == 0) {
        unsigned* bar = b.bar; asm volatile("" : "+v"(bar));
        __builtin_amdgcn_s_waitcnt(0);
        unsigned nloc = b.st[0], nx = b.st[1];
        if (nloc == 0u) { xcd_barrier_complete(bar, b.x, nloc, nx); b.st[0] = nloc; b.st[1] = nx; }
        const unsigned old = xb_add(&bar[XB_XSUB(b.x)], 1u);
        const unsigned gen = old / nloc;
        if (old + 1u == (gen + 1u) * nloc) {
            __builtin_amdgcn_fence(__ATOMIC_RELEASE, "agent");
            asm volatile("s_waitcnt vmcnt(0)" ::: "memory");
            const unsigned og = xb_add(&bar[XB_TOP], 1u);
            const unsigned tg = og / nx;
            if (og + 1u == (tg + 1u) * nx) xb_add(&bar[XB_TOPGEN], 1u);
            else XB_SPIN(xb_ld(&bar[XB_TOPGEN]) == tg, bar);
            __builtin_amdgcn_fence(__ATOMIC_ACQUIRE, "agent");
            xb_add(&bar[XB_XGEN(b.x)], 1u);
            asm volatile("s_waitcnt vmcnt(0)" ::: "memory");
        } else {
            XB_SPIN(xb_ld(&bar[XB_XGEN(b.x)]) == gen, bar);
            __builtin_amdgcn_fence(__ATOMIC_ACQUIRE, "agent");
            asm volatile("s_waitcnt vmcnt(0)" ::: "memory");
        }
    }
    __syncthreads();
}

typedef const __attribute__((address_space(4))) char* kargp_t;
DI const float* ldin(int i) { kargp_t kp = (kargp_t)__builtin_amdgcn_kernarg_segment_ptr(); asm volatile("" : "+s"(kp)); return (const float*)(*(const __attribute__((address_space(4))) unsigned long long*)(kp + 8 * i)); }
DI float* ldout() { return (float*)ldin(25); }
DI unsigned char* ldws() { return (unsigned char*)ldin(26); }
DI int opq_tid() { int t = threadIdx.x; asm volatile("" : "+v"(t)); return t; }

__global__ void __launch_bounds__(512, 2) fwd_kernel(Args a) {
    extern __shared__ __attribute__((aligned(16))) unsigned char lds[];
    cg::grid_group grid = cg::this_grid();
    const int G = gridDim.x, bx = blockIdx.x, NGW = G * 8;
    const int lo = a.ph_lo, hi = a.ph_hi;
#define IN(k) (lo <= (k) && (k) < hi)
    volatile LAS unsigned* MISC = (volatile LAS unsigned*)((LAS unsigned char*)lds + 146432);
    if (threadIdx.x < 16) MISC[threadIdx.x] = 0u;
    __syncthreads();
    XcdBarrier xbar; xbar.bar = (unsigned*)ldws(); xbar.x = 0; xbar.st = nullptr;
    if (hi - lo > 1) xbar = xcd_barrier_post((unsigned*)ldws(), MISC + 8);
    if (hi < 0) grid.sync();
#define SEAM(k) do { if (IN(k) && (k) + 1 < hi) xcd_barrier(xbar); } while (0)
#define WSP(T, off) ((T*)(ws + (off)))

    for (int sx_ = 0; sx_ < SYNCX; ++sx_) xcd_barrier(xbar);
    if (IN(0)) for (int rep_ = 0; rep_ < REP_P; ++rep_) {
        if (rep_) xcd_barrier(xbar);
        const int tid = opq_tid(), lane = tid & 63, wave = __builtin_amdgcn_readfirstlane(tid >> 6), gw = bx * 8 + wave;
        unsigned char* ws = ldws();
        {
            const float *cvec = ldin(6), *c_ctx = ldin(7), *ada_w = ldin(8), *ada_b = ldin(9);
            float* mod = WSP(float, WS_MOD);
            for (int u = bx; u < DEPTH * 96; u += G) {
                const int l = u / 96, nb = u - l * 96;
                gemv9_unit(ada_w + (size_t)l * D * 6144, 6144, nb * 64, c_ctx, cvec, D, true, ada_b + l * 6144, mod + (size_t)l * NMOD * 6144, 6144, (float*)lds, tid);
            }
        }
        {
            const float *w_in = ldin(12), *w1 = ldin(23);
            bf16_t *WIN = WSP(bf16_t, WS_WIN), *W1T = WSP(bf16_t, WS_W1);
            LAS float* scr = (LAS float*)((LAS unsigned char*)lds + wave * 17408);
            constexpr int I_IN = 16 * 36, I_1 = 16 * 64, I_L = I_IN + I_1;
            for (int it = gw; it < 1 * I_L; it += NGW) {
                const int l = it / I_L; int r = it - l * I_L;
                if (r < I_IN) transpose_item(w_in + (size_t)l * D * INW, D, INW, WIN + (size_t)l * INW * D, scr, r, lane);
                else transpose_item(w1 + (size_t)l * D * FF, D, FF, W1T + (size_t)l * FF * D, scr, r - I_IN, lane);
            }
        }
        {
            const float *cache_ak = ldin(2), *cache_av = ldin(3), *cache_nk = ldin(4), *cache_nv = ldin(5);
            bf16_t *KCA = WSP(bf16_t, WS_KCA), *VCA = WSP(bf16_t, WS_VCA), *KCN = WSP(bf16_t, WS_KCN), *VCN = WSP(bf16_t, WS_VCN);
            const int gt = bx * 512 + tid, NGT = G * 512;
            for (int e = gt; e < 8 * 4 * 256 * 8 * 8; e += NGT) {
                const int c8 = e & 7, hh = (e >> 3) & 7, key = (e >> 6) & 255, bl = e >> 14;
                const float* src; bf16_t* dst;
                if (hh < 2) { src = cache_ak + (((size_t)bl * 256 + key) * 2 + hh) * 64 + 8 * c8; dst = KCA + (((size_t)bl * 2 + hh) * 8 + (key >> 5)) * 2048 + (c8 * 32 + (key & 31)) * 8; }
                else { src = cache_nk + (((size_t)bl * 256 + key) * 6 + (hh - 2)) * 64 + 8 * c8; dst = KCN + (((size_t)bl * 6 + (hh - 2)) * 8 + (key >> 5)) * 2048 + (c8 * 32 + (key & 31)) * 8; }
                const f32x4 v0 = *(const f32x4*)src, v1 = *(const f32x4*)(src + 4);
                u32x4 o; o.x = pk2(v0.x, v0.y); o.y = pk2(v0.z, v0.w); o.z = pk2(v1.x, v1.y); o.w = pk2(v1.z, v1.w);
                *(u32x4*)dst = o;
            }
            for (int e = gt; e < 8 * 4 * 8 * 32 * 64; e += NGT) {
                const int d = e & 63, g = (e >> 6) & 31, hh = (e >> 11) & 7, bl = e >> 14;
                unsigned short q[8];
#pragma unroll
                for (int jj = 0; jj < 8; ++jj) {
                    const int p = 8 * g + jj, key = (p & ~31) + permkey(p & 31);
                    const float v = (hh < 2) ? cache_av[(((size_t)bl * 256 + key) * 2 + hh) * 64 + d] : cache_nv[(((size_t)bl * 256 + key) * 6 + (hh - 2)) * 64 + d];
                    q[jj] = (unsigned short)(pk2(v, 0.f) & 0xffffu);
                }
                u32x4 o; o.x = q[0] | ((unsigned)q[1] << 16); o.y = q[2] | ((unsigned)q[3] << 16); o.z = q[4] | ((unsigned)q[5] << 16); o.w = q[6] | ((unsigned)q[7] << 16);
                const int voff = (g >> 2) * 2048 + ((((d >> 5) * 2 + ((g >> 1) & 1)) * 2 + (g & 1)) * 32 + (d & 31)) * 8;
                bf16_t* dst = (hh < 2) ? VCA + ((size_t)bl * 2 + hh) * 16384 + voff : VCN + ((size_t)bl * 6 + (hh - 2)) * 16384 + voff;
                *(u32x4*)dst = o;
            }
        }
    }
    SEAM(0);
    if (IN(1)) for (int rep_ = 0; rep_ < REP_P; ++rep_) {
        if (rep_) xcd_barrier(xbar);
        const int tid = opq_tid(), lane = tid & 63, wave = __builtin_amdgcn_readfirstlane(tid >> 6), gw = bx * 8 + wave;
        unsigned char* ws = ldws();
        float* mod = WSP(float, WS_MOD);
        {
            const float *w_in = ldin(12), *w1 = ldin(23);
            float *bias1 = WSP(float, WS_BIAS1), *bias2 = WSP(float, WS_BIAS2);
            for (int u = bx; u < DEPTH * 100; u += G) {
                const int l = u / 100; int r = u - l * 100;
                const float* ml = mod + (size_t)l * NMOD * 6144;
                if (r < 36) gemv9_unit(w_in + (size_t)l * D * INW, INW, r * 64, ml, ml + 6144, 6144, false, nullptr, bias1 + (size_t)l * NMOD * INW, INW, (float*)lds, tid);
                else { r -= 36; gemv9_unit(w1 + (size_t)l * D * FF, FF, r * 64, ml + 3072, ml + 6144 + 3072, 6144, false, nullptr, bias2 + (size_t)l * NMOD * FF, FF, (float*)lds, tid); }
            }
        }
        {
            const float *w_out = ldin(22), *w2 = ldin(24);
            bf16_t *WOUT = WSP(bf16_t, WS_WOUT), *W2T = WSP(bf16_t, WS_W2);
            LAS float* scr = (LAS float*)((LAS unsigned char*)lds + wave * 17408);
            constexpr int I_OUT = 16 * 16, I_2 = 64 * 16, I_L = I_OUT + I_2;
            for (int it = gw; it < 1 * I_L; it += NGW) {
                const int l = it / I_L; int r = it - l * I_L;
                if (r < I_OUT) transpose_item(w_out + (size_t)l * D * D, D, D, WOUT + (size_t)l * D * D, scr, r, lane);
                else transpose_item(w2 + (size_t)l * FF * D, FF, D, W2T + (size_t)l * D * FF, scr, r - I_OUT, lane);
            }
        }
        {
            const float *x_prompt = ldin(0), *x_sample = ldin(1), *norm1_g = ldin(10);
            bf16_t* XG = WSP(bf16_t, WS_XG); float* ssq = WSP(float, WS_SSQ);
            for (int row = gw; row < M; row += NGW) {
                const float* xr = (row < MP) ? x_prompt + (size_t)row * D : x_sample + (size_t)(row - MP) * D;
                const float* scp = mod + (size_t)modidx(row) * 6144 + 1024;
                float s = 0.f;
#pragma unroll
                for (int j = 0; j < 4; ++j) {
                    const int c = 256 * j + 4 * lane;
                    const f32x4 v = *(const f32x4*)(xr + c);
                    s += (v.x * v.x + v.y * v.y) + (v.z * v.z + v.w * v.w);
                    const f32x4 y = v * (*(const f32x4*)(norm1_g + c)) * (*(const f32x4*)(scp + c) + 1.0f);
                    u32x2 w; w.x = pk2(y.x, y.y); w.y = pk2(y.z, y.w);
                    *(u32x2*)(XG + (size_t)row * D + c) = w;
                }
                s = wave_sum(s);
                if (lane < 16) ssq[(size_t)row * 16 + lane] = (lane == 0) ? s : 0.f;
            }
        }
    }
    SEAM(1);
#pragma nounroll
    for (int l_ = 0; l_ < DEPTH; ++l_) {
        int l = l_; asm volatile("" : "+s"(l));
        const int p0 = 2 + 6 * l;
        if (IN(p0)) for (int rep_ = 0; rep_ < REP_G1; ++rep_) {
            unsigned char* ws = ldws();
            pg8::Gemm g{WSP(bf16_t, WS_XG), WSP(bf16_t, WS_WIN) + (size_t)l * INW * D, M, INW, D, D}; pg8::StaticOrder S; S.init(M, INW, G, bx);
            EpiLin<0> E{WSP(bf16_t, WS_RAW), INW, WSP(float, WS_BIAS1) + (size_t)l * NMOD * INW, INW, WSP(float, WS_SSQ)};
            pg8::gemm_phase<EpiLin<0>, pg8::StaticOrder, true, true>((LAS unsigned char*)lds, g, S, E);
        }
        SEAM(p0);
        if (IN(p0 + 1)) for (int rep_ = 0; rep_ < REP_PREP; ++rep_) {
            const int tid = opq_tid();
            unsigned char* ws = ldws();
            for (int u = bx; u < 768; u += G) {
                if (u < 384) conv_unit(u, l, WSP(bf16_t, WS_RAW), WSP(bf16_t, WS_ATT), ldin(13), ldin(14), ldin(15), ldin(16), (float*)lds, tid);
                else { PrepP P{WSP(bf16_t, WS_RAW), WSP(bf16_t, WS_Q), WSP(bf16_t, WS_K), WSP(bf16_t, WS_VT), ldout(), ldin(17), ldin(18), ldin(19), ldin(20)}; qkv_unit(u - 384, l, P, (bf16_t*)lds, tid); }
            }
        }
        SEAM(p0 + 1);
        if (IN(p0 + 2)) for (int rep_ = 0; rep_ < REP_ATTN; ++rep_) {
            const int tid = opq_tid(), lane = tid & 63, wave = __builtin_amdgcn_readfirstlane(tid >> 6), gw = bx * 8 + wave;
            unsigned char* ws = ldws();
            AttnP P{WSP(bf16_t, WS_Q), WSP(bf16_t, WS_K), WSP(bf16_t, WS_VT), WSP(bf16_t, WS_KCA), WSP(bf16_t, WS_VCA), WSP(bf16_t, WS_KCN), WSP(bf16_t, WS_VCN), WSP(bf16_t, WS_ATT), ldin(21)};
            bool bal = (NGW == 2048) && (hi - lo > 1);
            int xcd = bx & 7, slot = bx >> 3;
            if (bal) {
                unsigned okc = 1u;
                for (unsigned j = 0; j < 16; ++j) okc &= (xb_ld(&xbar.bar[XB_XCNT(j)]) == (j < 8 ? 32u : 0u)) ? 1u : 0u;
                xcd = __builtin_amdgcn_readfirstlane((int)MISC[11]); slot = __builtin_amdgcn_readfirstlane((int)MISC[10]);
                bal = (__builtin_amdgcn_readfirstlane((int)okc) != 0) && xcd < 8 && slot < 32;
            }
            const int idx = slot * 8 + wave;
            const int nu = bal ? (slot < 24 ? (idx < 64 ? 4 : 2) : 2) : (4608 - gw + NGW - 1) / NGW;
            for (int k = 0; k < nu; ++k) {
#ifdef ATTN_PROBE
                if (rep_ == 1 && ((ATTN_PROBE == 1) ? (slot >= 24) : (ATTN_PROBE == 2) ? (slot < 24) : (slot >= 24 || k > 0))) break;
#endif
                int uid, qsel = 2; bool cshared = false;
                if (!bal) uid = gw + k * NGW;
                else if (slot < 24) {
                    if (k == 0) { uid = (xcd * 6 + (idx >> 5)) * 32 + (idx & 31); cshared = true; }
                    else if (idx < 64) { const int p = (k - 1) * 64 + idx; const int pb = 4 * xcd + p / 48, r = p % 48, kind = r / 24, rr = r % 24; uid = (kind ? 3840 : 3072) + (pb * 6 + (rr >> 2)) * 4 + (rr & 3); }
                    else { uid = 1536 + xcd * 192 + 128 + ((idx - 64) >> 1); qsel = (idx - 64) & 1; }
                } else uid = 1536 + xcd * 192 + k * 64 + (slot - 24) * 8 + wave;
                attn_run_unit(uid, qsel, l, P, lane, (LAS unsigned char*)lds + wave * 16384, (LAS float*)((LAS unsigned char*)lds + 131072 + wave * 1920), cshared, wave, (LAS unsigned char*)lds);
            }
        }
        SEAM(p0 + 2);
        if (IN(p0 + 3)) {
            unsigned char* ws = ldws(); float* X = ldout();
            const float* ml = WSP(float, WS_MOD) + (size_t)l * NMOD * 6144;
            const bool split = false;
#pragma nounroll
            for (int rnd = 0; rnd < (split ? 2 : 1); ++rnd) {
                const int kh = (rnd == 1) ? (bx >> 7) : 0, koff = kh * (D / 2);
                pg8::Gemm g{WSP(bf16_t, WS_ATT) + koff, WSP(bf16_t, WS_WOUT) + (size_t)l * D * D + koff, M, D, D, (rnd == 1) ? D / 2 : D};
                RangeOrder S; S.init(M, D, G, bx); S.lo = 0; S.hi = split ? 256 : 384; S.fix = (rnd == 1) ? 256 + (bx & 127) : -1;
                unsigned* flag = (unsigned*)(ws + 16384) + (size_t)((l * 2 + 0) * 128 + (bx & 127)) * 64;
                f32x4* part = (f32x4*)(ws + WS_RAW) + (size_t)(bx & 127) * 16384;
                EpiRes E{l == 0 ? ldin(0) : X, l == 0 ? ldin(1) : X + (size_t)MP * D, X, ml + 2048, ldin(11) + l * D, ml + 4096, WSP(bf16_t, WS_XG), WSP(float, WS_SSQ), 1, (rnd == 1) ? 1 + kh : 0, part, flag};
                pg8::gemm_phase<EpiRes, RangeOrder, true, true>((LAS unsigned char*)lds, g, S, E);
                if (rnd == 1 && kh == 1) {
                    asm volatile("s_waitcnt vmcnt(0)" ::: "memory"); __syncthreads();
                    if (threadIdx.x == 0) { __builtin_amdgcn_fence(__ATOMIC_RELEASE, "agent"); asm volatile("s_waitcnt vmcnt(0)" ::: "memory"); __hip_atomic_store(flag, 1u, __ATOMIC_RELAXED, __HIP_MEMORY_SCOPE_AGENT); }
                }
            }
            SEAM(p0 + 3);
        }
        if (IN(p0 + 4)) for (int rep_ = 0; rep_ < REP_G3; ++rep_) {
            unsigned char* ws = ldws();
            pg8::Gemm g{WSP(bf16_t, WS_XG), WSP(bf16_t, WS_W1) + (size_t)l * FF * D, M, FF, D, D}; pg8::StaticOrder S; S.init(M, FF, G, bx);
            EpiLin<1> E{WSP(bf16_t, WS_H1), FF, WSP(float, WS_BIAS2) + (size_t)l * NMOD * FF, FF, WSP(float, WS_SSQ)};
            pg8::gemm_phase<EpiLin<1>, pg8::StaticOrder, true, true>((LAS unsigned char*)lds, g, S, E);
        }
        SEAM(p0 + 4);
        if (IN(p0 + 5)) {
            unsigned char* ws = ldws(); float* X = ldout();
            const float* ml = WSP(float, WS_MOD) + (size_t)l * NMOD * 6144;
            const int nx = (l + 1 < DEPTH) ? 1 : 0; const int ln = nx ? l + 1 : l;
            const bool split = false;
#pragma nounroll
            for (int rnd = 0; rnd < (split ? 2 : 1); ++rnd) {
                const int kh = (rnd == 1) ? (bx >> 7) : 0, koff = kh * (FF / 2);
                pg8::Gemm g{WSP(bf16_t, WS_H1) + koff, WSP(bf16_t, WS_W2) + (size_t)l * D * FF + koff, M, D, FF, (rnd == 1) ? FF / 2 : FF};
                RangeOrder S; S.init(M, D, G, bx); S.lo = 0; S.hi = split ? 256 : 384; S.fix = (rnd == 1) ? 256 + (bx & 127) : -1;
                unsigned* flag = (unsigned*)(ws + 16384) + (size_t)((l * 2 + 1) * 128 + (bx & 127)) * 64;
                f32x4* part = (f32x4*)(ws + WS_ATT) + (size_t)(bx & 127) * 16384;
                EpiRes E{X, X + (size_t)MP * D, X, ml + 5120, ldin(10) + ln * D, WSP(float, WS_MOD) + (size_t)ln * NMOD * 6144 + 1024, WSP(bf16_t, WS_XG), WSP(float, WS_SSQ), nx, (rnd == 1) ? 1 + kh : 0, part, flag};
                pg8::gemm_phase<EpiRes, RangeOrder, true, true>((LAS unsigned char*)lds, g, S, E);
                if (rnd == 1 && kh == 1) {
                    asm volatile("s_waitcnt vmcnt(0)" ::: "memory"); __syncthreads();
                    if (threadIdx.x == 0) { __builtin_amdgcn_fence(__ATOMIC_RELEASE, "agent"); asm volatile("s_waitcnt vmcnt(0)" ::: "memory"); __hip_atomic_store(flag, 1u, __ATOMIC_RELAXED, __HIP_MEMORY_SCOPE_AGENT); }
                }
            }
            if (l + 1 < DEPTH) {
                const int first = (G == 256) ? 128 : 0, nwg_t = G - first;
                if (bx >= first) {
                    const int tid = opq_tid(), lane = tid & 63, wave = __builtin_amdgcn_readfirstlane(tid >> 6);
                    const int l2 = l + 1;
                    const float *w_in = ldin(12), *w_out = ldin(22), *w1 = ldin(23), *w2 = ldin(24);
                    LAS float* scr = (LAS float*)((LAS unsigned char*)lds + wave * 17408);
                    constexpr int I_IN = 16 * 36, I_1 = 16 * 64, I_OUT = 16 * 16, I_2 = 64 * 16, I_L = I_IN + I_1 + I_OUT + I_2;
                    for (int it = (bx - first) * 8 + wave; it < I_L; it += nwg_t * 8) {
                        int r = it;
                        if (r < I_IN) { transpose_item(w_in + (size_t)l2 * D * INW, D, INW, WSP(bf16_t, WS_WIN) + (size_t)l2 * INW * D, scr, r, lane); continue; } r -= I_IN;
                        if (r < I_1) { transpose_item(w1 + (size_t)l2 * D * FF, D, FF, WSP(bf16_t, WS_W1) + (size_t)l2 * FF * D, scr, r, lane); continue; } r -= I_1;
                        if (r < I_OUT) { transpose_item(w_out + (size_t)l2 * D * D, D, D, WSP(bf16_t, WS_WOUT) + (size_t)l2 * D * D, scr, r, lane); continue; } r -= I_OUT;
                        transpose_item(w2 + (size_t)l2 * FF * D, FF, D, WSP(bf16_t, WS_W2) + (size_t)l2 * D * FF, scr, r, lane);
                    }
                }
            }
            SEAM(p0 + 5);
        }
    }
#undef IN
#undef SEAM
#undef WSP
}

extern "C" void kernel_launch(void* const* d_in, const int* in_sizes, int n_in, void* d_out, int out_size, void* d_ws, size_t ws_size, hipStream_t stream) {
    static int grid = 0;
    if (grid == 0) {
        if (n_in != 25 || ws_size < WS_END) { fprintf(stderr, "kernel_launch: need 25 inputs and >= %zu bytes of workspace; got %d, %zu\n", (size_t)WS_END, n_in, ws_size); grid = -1; return; }
        int dev = 0, cus = 0, per_cu = 0;
        hipGetDevice(&dev);
        hipDeviceGetAttribute(&cus, hipDeviceAttributeMultiprocessorCount, dev);
        if (hipFuncSetAttribute((const void*)fwd_kernel, hipFuncAttributeMaxDynamicSharedMemorySize, LDS_BYTES) != hipSuccess) { fprintf(stderr, "kernel_launch: hipFuncSetAttribute failed\n"); grid = -1; return; }
        if (hipOccupancyMaxActiveBlocksPerMultiprocessor(&per_cu, (const void*)fwd_kernel, 512, LDS_BYTES) != hipSuccess || per_cu < 1) { fprintf(stderr, "kernel_launch: occupancy query says %d\n", per_cu); per_cu = 1; }
        (void)hipGetLastError();
        grid = cus * per_cu;
    }
    if (grid < 0) return;
    if (hipMemsetAsync(d_ws, 0, 16384, stream) != hipSuccess) { fprintf(stderr, "kernel_launch: memset failed\n"); return; }
    Args a{};
    for (int i = 0; i < 25; ++i) a.in[i] = (const float*)d_in[i];
    a.out = (float*)d_out; a.ws = (unsigned char*)d_ws;
#if MK_SINGLE
    a.ph_lo = 0; a.ph_hi = NPH;
    void* args[] = {&a};
    hipError_t e = hipLaunchCooperativeKernel((const void*)fwd_kernel, dim3(grid), dim3(512), args, LDS_BYTES, stream);
    if (e != hipSuccess) fprintf(stderr, "cooperative launch failed: %s (grid %d)\n", hipGetErrorString(e), grid);
#else
    for (int ph = 0; ph < NPH; ++ph) {
        a.ph_lo = ph; a.ph_hi = ph + 1;
        hipLaunchKernelGGL(fwd_kernel, dim3(grid), dim3(512), LDS_BYTES, stream, a);
    }
#endif
}
```

```cpp
#include <hip/hip_runtime.h>
#include <hip/hip_cooperative_groups.h>
#include <cstdio>
#include <cstdint>
namespace cg = cooperative_groups;
namespace pg8 {
#define PG8_LAS __attribute__((address_space(3)))
typedef unsigned short bf16_t;
typedef short bf16x8 __attribute__((ext_vector_type(8)));
typedef float f32x4 __attribute__((ext_vector_type(4)));
typedef unsigned u32x4 __attribute__((ext_vector_type(4)));
constexpr int BM = 256, BK = 64, HALF = 128, HTB = HALF * BK * 2  , STAGE_BYTES = 8 * HTB, NXCD = 8, WGM = 8;

__host__ __device__ __forceinline__ int lds_byte(int r, int c) { const int st = (r >> 4) * 2 + (c >> 5), rr = r & 15, cc = c & 31, ob = rr * 64 + cc * 2; return st * 1024 + (ob ^ (((ob >> 9) & 1) << 5)); }
__host__ __device__ __forceinline__ void stage_rc(int b, int& R, int& C) { const int st = b / 1024, sb = b % 1024, swz = sb ^ (((sb >> 9) & 1) << 5); R = (st >> 1) * 16 + swz / 64; C = (st & 1) * 32 + (swz % 64) / 2; }
__host__ __device__ __forceinline__ int perm32(int rho) { const int n = rho >> 4, i = rho & 15; return 8 * (i >> 2) + 4 * n + (i & 3); }

struct Unit { int pm, pn; };
struct Gemm { const bf16_t* A; const bf16_t* Bt; int M, N, K, Kl; };

struct StaticOrder {
    int nM, nN, nwg, G, c;
    __host__ __device__ void init(int M, int N, int G_, int c_) { nM = M / BM; nN = N / BM; nwg = nM * nN; G = G_; c = c_; }
    __host__ __device__ bool next(int i, Unit& u) const {
        const long L = (long)i * G + c; if (L >= nwg) return false;
        int wgid = (int)L; { const int q = nwg / NXCD, r = nwg % NXCD, xcd = wgid % NXCD, off = wgid / NXCD; wgid = (xcd < r ? xcd * (q + 1) : r * (q + 1) + (xcd - r) * q) + off; }
        const int nig = WGM * nN, gid = wgid / nig, fm = gid * WGM, gsz = (nM - fm) < WGM ? (nM - fm) : WGM;
        u.pm = fm + ((wgid % nig) % gsz); u.pn = (wgid % nig) / gsz; return true;
    }
    __device__ __forceinline__ void a_ready(const Unit&) const {}
    __device__ __forceinline__ void done(const Unit&) const {}
};
__device__ __forceinline__ unsigned cvt_pk_bf16(float lo, float hi) { unsigned r; asm volatile("v_cvt_pk_bf16_f32 %0, %1, %2" : "=v"(r) : "v"(lo), "v"(hi)); return r; }
template <class Epi, class Sched, bool ALIGN_EPI = false, bool SP2 = false>
__device__ __forceinline__ void gemm_phase(PG8_LAS unsigned char* lds, const Gemm g, const Sched& S, const Epi& E) {
    int tid_ = threadIdx.x; asm volatile("" : "+v"(tid_));
    const int tid = tid_, wid = __builtin_amdgcn_readfirstlane(tid >> 6), lane = tid & 63, wr = wid >> 2, wc = wid & 3, fr = lane & 15, fq = lane >> 4;
    const int K = g.K, nt = g.Kl / BK;
    unsigned voffA[2], voffB[2];
#pragma unroll
    for (int i = 0; i < 2; ++i) { int R, C; stage_rc(tid * 16 + i * 8192, R, C); const int Rb = Epi::PERM ? ((R & ~31) + perm32(R & 31)) : R;
        voffA[i] = (unsigned)(R * K + C) * 2u; voffB[i] = (unsigned)(Rb * K + C) * 2u; }
    const size_t kstep = (size_t)(BK * 2);
    const size_t hstep = (size_t)HALF * K * 2;
    const size_t tstep = 2 * hstep;
    const unsigned ldsw = (unsigned)wid * 1024u;
    const int aoff = lds_byte(wr * 64 + fr, fq * 8), boff = lds_byte(wc * 32 + fr, fq * 8);
#define PG8_SA(b, h) (((b) * 2 + (h)) * HTB)
#define PG8_SB(b, h) ((4 + (b) * 2 + (h)) * HTB)
#define PG8_STAGE(bufoff, gbase, voff) do { _Pragma("unroll") for (int _i = 0; _i < 2; ++_i) \
        __builtin_amdgcn_global_load_lds((const unsigned*)((const char*)(gbase) + (voff)[_i]), (PG8_LAS unsigned*)(lds + (bufoff) + ldsw + _i * 8192), 16, 0, 0); } while (0)
#define PG8_LDA(dst, b, h) do { _Pragma("unroll") for (int m = 0; m < 4; ++m) _Pragma("unroll") for (int k = 0; k < 2; ++k) dst[m][k] = *(const PG8_LAS bf16x8*)(lds + PG8_SA(b, h) + aoff + m * 2048 + k * 1024); } while (0)
#define PG8_LDB(dst, b, h) do { _Pragma("unroll") for (int n = 0; n < 2; ++n) _Pragma("unroll") for (int k = 0; k < 2; ++k) dst[n][k] = *(const PG8_LAS bf16x8*)(lds + PG8_SB(b, h) + boff + n * 2048 + k * 1024); } while (0)
#define PG8_MMA(ai, bj, At, Bt) do { __builtin_amdgcn_s_setprio(1); _Pragma("unroll") for (int m = 0; m < 4; ++m) _Pragma("unroll") for (int n = 0; n < 2; ++n) _Pragma("unroll") for (int k = 0; k < 2; ++k) \
        acc[ai][bj][m][n] = __builtin_amdgcn_mfma_f32_16x16x32_bf16(Bt[n][k], At[m][k], acc[ai][bj][m][n], 0, 0, 0); __builtin_amdgcn_s_setprio(0); } while (0)
#define PG8_WAIT_V(n) asm volatile("s_waitcnt vmcnt(" #n ")" ::: "memory")
#define PG8_WAIT_L(n) asm volatile("s_waitcnt lgkmcnt(" #n ")" ::: "memory")
#define PG8_BAR __builtin_amdgcn_s_barrier()
#define PG8_SCHED __builtin_amdgcn_sched_barrier(0)
    Unit cur, nxt; int ui = 0;
    if (!S.next(0, cur)) return;
    f32x4 acc[2][2][4][2];
#pragma unroll
    for (int a = 0; a < 2; ++a)
#pragma unroll
        for (int b = 0; b < 2; ++b)
#pragma unroll
            for (int m = 0; m < 4; ++m)
#pragma unroll
                for (int n = 0; n < 2; ++n) acc[a][b][m][n] = (f32x4){0.f, 0.f, 0.f, 0.f};
    bf16x8 At[4][2], B0[2][2], B1[2][2];
    const char* cA = (const char*)g.A + (size_t)cur.pm * tstep; const char* cB = (const char*)g.Bt + (size_t)cur.pn * tstep;
    S.a_ready(cur);
    if constexpr (SP2) {
        PG8_STAGE(PG8_SB(0, 0), cB, voffB); PG8_STAGE(PG8_SB(0, 1), cB + hstep, voffB); PG8_STAGE(PG8_SA(0, 0), cA, voffA); PG8_STAGE(PG8_SA(0, 1), cA + hstep, voffA);
        if (wr == 1) PG8_BAR;
        PG8_WAIT_V(2); PG8_BAR;
        PG8_STAGE(PG8_SB(1, 0), cB + kstep, voffB); PG8_STAGE(PG8_SA(1, 0), cA + kstep, voffA); PG8_STAGE(PG8_SB(1, 1), cB + hstep + kstep, voffB);
        PG8_WAIT_V(6); PG8_BAR;
    } else {
        PG8_STAGE(PG8_SB(0, 0), cB, voffB); PG8_STAGE(PG8_SA(0, 0), cA, voffA); PG8_STAGE(PG8_SB(0, 1), cB + hstep, voffB); PG8_STAGE(PG8_SA(0, 1), cA + hstep, voffA);
        if (wr == 1) PG8_BAR;
        PG8_WAIT_V(4); PG8_BAR;
        PG8_STAGE(PG8_SB(1, 0), cB + kstep, voffB); PG8_STAGE(PG8_SA(1, 0), cA + kstep, voffA); PG8_STAGE(PG8_SB(1, 1), cB + hstep + kstep, voffB);
        PG8_WAIT_V(6); PG8_BAR;
    }
    for (;;) {
        const bool has_next = S.next(ui + 1, nxt);
        const char* nA = has_next ? (const char*)g.A + (size_t)nxt.pm * tstep : cA; const char* nB = has_next ? (const char*)g.Bt + (size_t)nxt.pn * tstep : cB;
        for (int t = 0; t < nt; t += 2) {
            const bool last = (t == nt - 2);
            const char* a1 = cA + (size_t)(t + 1) * kstep;
            const char* a2 = last ? nA : cA + (size_t)(t + 2) * kstep; const char* b2 = last ? nB : cB + (size_t)(t + 2) * kstep;
            const char* a3 = a2 + kstep; const char* b3 = b2 + kstep;
            if (last && has_next) S.a_ready(nxt);
            if constexpr (SP2) {
            PG8_LDB(B0, 0, 0); PG8_LDB(B1, 0, 1); PG8_SCHED; PG8_LDA(At, 0, 0); PG8_STAGE(PG8_SA(1, 1), a1 + hstep, voffA);
            PG8_WAIT_V(8); PG8_WAIT_L(0); PG8_BAR; PG8_MMA(0, 0, At, B0); PG8_MMA(0, 1, At, B1); PG8_BAR; PG8_SCHED;
            PG8_LDA(At, 0, 1); PG8_STAGE(PG8_SB(0, 0), b2, voffB); PG8_STAGE(PG8_SB(0, 1), b2 + hstep, voffB); PG8_STAGE(PG8_SA(0, 0), a2, voffA);
            PG8_WAIT_V(8); PG8_WAIT_L(0); PG8_BAR; PG8_MMA(1, 0, At, B0); PG8_MMA(1, 1, At, B1); PG8_BAR; PG8_SCHED;
            PG8_LDB(B0, 1, 0); PG8_LDB(B1, 1, 1); PG8_SCHED; PG8_LDA(At, 1, 0); PG8_STAGE(PG8_SA(0, 1), a2 + hstep, voffA);
            PG8_WAIT_V(8); PG8_WAIT_L(0); PG8_BAR; PG8_MMA(0, 0, At, B0); PG8_MMA(0, 1, At, B1); PG8_BAR; PG8_SCHED;
            PG8_LDA(At, 1, 1); PG8_STAGE(PG8_SB(1, 0), b3, voffB); PG8_STAGE(PG8_SB(1, 1), b3 + hstep, voffB); PG8_STAGE(PG8_SA(1, 0), a3, voffA);
            PG8_WAIT_V(8); PG8_WAIT_L(0); PG8_BAR; PG8_MMA(1, 0, At, B0); PG8_MMA(1, 1, At, B1); PG8_BAR; PG8_SCHED;
            } else {
            PG8_LDB(B0, 0, 0); PG8_SCHED; PG8_LDA(At, 0, 0); PG8_STAGE(PG8_SA(1, 1), a1 + hstep, voffA);
            PG8_WAIT_L(8); PG8_BAR; PG8_WAIT_L(0); PG8_MMA(0, 0, At, B0); PG8_BAR; PG8_SCHED;
            PG8_LDB(B1, 0, 1); PG8_STAGE(PG8_SB(0, 0), b2, voffB);
            PG8_BAR; PG8_WAIT_L(0); PG8_MMA(0, 1, At, B1); PG8_BAR;
            PG8_LDA(At, 0, 1); PG8_STAGE(PG8_SA(0, 0), a2, voffA);
            PG8_BAR; PG8_WAIT_L(0); PG8_MMA(1, 0, At, B0); PG8_BAR; PG8_SCHED;
            PG8_STAGE(PG8_SB(0, 1), b2 + hstep, voffB);
            PG8_WAIT_V(6); PG8_BAR; PG8_MMA(1, 1, At, B1); PG8_BAR;
            PG8_LDB(B0, 1, 0); PG8_SCHED; PG8_LDA(At, 1, 0); PG8_STAGE(PG8_SA(0, 1), a2 + hstep, voffA);
            PG8_WAIT_L(8); PG8_BAR; PG8_WAIT_L(0); PG8_MMA(0, 0, At, B0); PG8_BAR; PG8_SCHED;
            PG8_LDB(B1, 1, 1); PG8_STAGE(PG8_SB(1, 0), b3, voffB);
            PG8_BAR; PG8_WAIT_L(0); PG8_MMA(0, 1, At, B1); PG8_BAR;
            PG8_LDA(At, 1, 1); PG8_STAGE(PG8_SA(1, 0), a3, voffA);
            PG8_BAR; PG8_WAIT_L(0); PG8_MMA(1, 0, At, B0); PG8_BAR; PG8_SCHED;
            PG8_STAGE(PG8_SB(1, 1), b3 + hstep, voffB);
            PG8_WAIT_V(6); PG8_BAR; PG8_MMA(1, 1, At, B1); PG8_BAR;
            }
        }
        if constexpr (ALIGN_EPI) { if (wr == 0) PG8_BAR; }
        if constexpr (!Epi::AFTER_DRAIN) { E(acc, cur, wr, wc, fr, fq); S.done(cur); }
        if (!has_next) break;
#pragma unroll
        for (int a = 0; a < 2; ++a)
#pragma unroll
            for (int b = 0; b < 2; ++b)
#pragma unroll
                for (int m = 0; m < 4; ++m)
#pragma unroll
                    for (int n = 0; n < 2; ++n) acc[a][b][m][n] = (f32x4){0.f, 0.f, 0.f, 0.f};
        cur = nxt; cA = nA; cB = nB; ++ui;
        if constexpr (ALIGN_EPI) { if (wr == 1) PG8_BAR; }
    }
    PG8_WAIT_V(0);
    if constexpr (!ALIGN_EPI) { if (wr == 0) PG8_BAR; }
    PG8_BAR;
    if constexpr (Epi::AFTER_DRAIN) { E.fused(acc, cur, wr, wc, fr, fq, lds, wid, lane); S.done(cur); }
#undef PG8_SA
#undef PG8_SB
#undef PG8_STAGE
#undef PG8_LDA
#undef PG8_LDB
#undef PG8_MMA
#undef PG8_WAIT_V
#undef PG8_WAIT_L
#undef PG8_BAR
#undef PG8_SCHED
}
}

#define DI __device__ __forceinline__
#define LAS __attribute__((address_space(3)))
typedef unsigned short bf16_t;
typedef short bf16x8 __attribute__((ext_vector_type(8)));
typedef float f32x4 __attribute__((ext_vector_type(4)));
typedef float f32x16 __attribute__((ext_vector_type(16)));
typedef unsigned u32x4 __attribute__((ext_vector_type(4)));
typedef unsigned u32x2 __attribute__((ext_vector_type(2)));
typedef float f32x2_t __attribute__((ext_vector_type(2)));
typedef __bf16 bf16x2_t __attribute__((ext_vector_type(2)));

#ifndef REP_P
#define REP_P 1
#endif
#ifndef REP_G1
#define REP_G1 1
#endif
#ifndef REP_PREP
#define REP_PREP 1
#endif
#ifndef REP_ATTN
#define REP_ATTN 1
#endif
#ifndef REP_G3
#define REP_G3 1
#endif
#ifndef SYNCX
#define SYNCX 0
#endif
#ifndef MK_SINGLE
#define MK_SINGLE 1
#endif

constexpr int D = 1024, MP = 8192, MS = 16384, M = MP + MS, DEPTH = 4, NMOD = 9, INW = 2304, FF = 4096;
constexpr int NPH = 2 + 6 * DEPTH;
constexpr float QSCALE = 0.125f * 1.4426950408889634f, LOG2E = 1.4426950408889634f, EPS = 1e-6f;
constexpr size_t OFF_AK = 25165824, OFF_AV = 29360128, OFF_NK = 33554432, OFF_NV = 46137344;
constexpr size_t MiB = 1u << 20;
constexpr size_t WS_MOD = 1 * MiB, WS_BIAS1 = 2 * MiB, WS_BIAS2 = 3 * MiB, WS_SSQ = 4 * MiB;
constexpr size_t WS_KCA = 6 * MiB, WS_VCA = 8 * MiB, WS_KCN = 10 * MiB, WS_VCN = 16 * MiB;
constexpr size_t WS_WIN = 22 * MiB, WS_WOUT = 40 * MiB, WS_W1 = 48 * MiB, WS_W2 = 80 * MiB;
constexpr size_t WS_XG = 112 * MiB, WS_H1 = 160 * MiB, WS_RAW = 160 * MiB, WS_Q = 268 * MiB, WS_K = 304 * MiB, WS_VT = 328 * MiB, WS_ATT = 352 * MiB, WS_END = 400 * MiB;
constexpr int LDS_BYTES = 147456;

DI unsigned pk2(float lo, float hi) { f32x2_t v = {lo, hi}; bf16x2_t b = __builtin_convertvector(v, bf16x2_t); return __builtin_bit_cast(unsigned, b); }
DI float bflo(unsigned w) { return __uint_as_float(w << 16); }
DI float bfhi(unsigned w) { return __uint_as_float(w & 0xffff0000u); }
DI void unpack8(const u32x4 w, float (&v)[8]) { v[0] = bflo(w.x); v[1] = bfhi(w.x); v[2] = bflo(w.y); v[3] = bfhi(w.y); v[4] = bflo(w.z); v[5] = bfhi(w.z); v[6] = bflo(w.w); v[7] = bfhi(w.w); }
DI int modidx(int row) { return row < MP ? 0 : 1 + ((row - MP) >> 11); }
DI float wave_sum(float v) {
#pragma unroll
    for (int o = 1; o < 64; o <<= 1) v += __shfl_xor(v, o);
    return v;
}
DI float sigmoidf_(float x) { return 1.f / (1.f + __expf(-x)); }
DI int crow(int i, int hi) { return (i & 3) + 8 * (i >> 2) + 4 * hi; }
DI int permkey(int p) { const int s = p >> 4, hh = (p >> 3) & 1, jj = p & 7; return 16 * s + 8 * (jj >> 2) + 4 * hh + (jj & 3); }

template <int ACT> struct EpiLin {
    static constexpr bool PERM = true, AFTER_DRAIN = false;
    bf16_t* O; int ldc; const float* bias; int ldb; const float* ssq;
    DI void operator()(const f32x4 (&acc)[2][2][4][2], const pg8::Unit& u, int wr, int wc, int fr, int fq) const {
        const int row0 = u.pm * 256 + wr * 64 + fr, col0 = u.pn * 256 + wc * 32 + 8 * fq;
        const float* bp = bias + (size_t)modidx(u.pm * 256) * ldb + col0;
        f32x4 bv[2][2];
#pragma unroll
        for (int bj = 0; bj < 2; ++bj)
#pragma unroll
            for (int n = 0; n < 2; ++n) bv[bj][n] = *(const f32x4*)(bp + bj * 128 + 4 * n);
        float rs8[8];
        {
            f32x4 s4[8];
#pragma unroll
            for (int k = 0; k < 8; ++k) s4[k] = *(const f32x4*)(ssq + (size_t)(row0 + (k >> 2) * 128 + (k & 3) * 16) * 16 + 4 * fq);
#pragma unroll
            for (int k = 0; k < 8; ++k) { float s = (s4[k].x + s4[k].y) + (s4[k].z + s4[k].w); s += __shfl_xor(s, 16); s += __shfl_xor(s, 32); rs8[k] = rsqrtf(s * (1.f / 1024.f) + EPS); }
        }
#pragma unroll
        for (int ai = 0; ai < 2; ++ai)
#pragma unroll
            for (int m = 0; m < 4; ++m) {
                const int row = row0 + ai * 128 + m * 16;
                const float rstd = rs8[ai * 4 + m];
                bf16_t* rowp = O + (size_t)row * ldc + col0;
#pragma unroll
                for (int bj = 0; bj < 2; ++bj) {
                    f32x4 v0 = acc[ai][bj][m][0] * rstd + bv[bj][0], v1 = acc[ai][bj][m][1] * rstd + bv[bj][1];
                    if (ACT == 1) {
#pragma unroll
                        for (int e = 0; e < 4; ++e) { const float a = fmaxf(v0[e], 0.f), b = fmaxf(v1[e], 0.f); v0[e] = a * a; v1[e] = b * b; }
                    }
                    u32x4 w; w.x = pk2(v0[0], v0[1]); w.y = pk2(v0[2], v0[3]); w.z = pk2(v1[0], v1[1]); w.w = pk2(v1[2], v1[3]);
                    *(u32x4*)(rowp + bj * 128) = w;
                }
            }
    }
};
struct EpiRes {
    static constexpr bool PERM = false, AFTER_DRAIN = false;
    const float* baseP; const float* baseS; float* out; const float* gate; const float* nw; const float* sc; bf16_t* xg; float* ssq; int has_next;
    int mode; f32x4* part; unsigned* flag;
    DI void operator()(f32x4 (&acc)[2][2][4][2], const pg8::Unit& u, int wr, int wc, int fr, int fq) const {
        f32x4* pp = part + threadIdx.x; asm volatile("" : "+v"(pp));
        if (mode == 2) {
#pragma unroll
            for (int ai = 0; ai < 2; ++ai)
#pragma unroll
                for (int bj = 0; bj < 2; ++bj)
#pragma unroll
                    for (int m = 0; m < 4; ++m)
#pragma unroll
                        for (int n = 0; n < 2; ++n) pp[(size_t)((((ai * 2 + bj) * 4 + m) * 2 + n) * 512)] = acc[ai][bj][m][n];
            return;
        }
        if (mode == 1) {
            const unsigned long long t0 = __builtin_amdgcn_s_memrealtime();
            while ((unsigned)__builtin_amdgcn_readfirstlane(__hip_atomic_load(flag, __ATOMIC_RELAXED, __HIP_MEMORY_SCOPE_AGENT)) == 0u) {
                if (__builtin_amdgcn_s_memrealtime() - t0 > 2000000ull) break;
                __builtin_amdgcn_s_sleep(2); }
            __builtin_amdgcn_fence(__ATOMIC_ACQUIRE, "agent");
            asm volatile("s_waitcnt vmcnt(0)" ::: "memory");
#pragma unroll
            for (int ai = 0; ai < 2; ++ai)
#pragma unroll
                for (int bj = 0; bj < 2; ++bj) {
#pragma unroll
                    for (int m = 0; m < 4; ++m) {
#pragma unroll
                        for (int n = 0; n < 2; ++n) acc[ai][bj][m][n] += pp[(size_t)((((ai * 2 + bj) * 4 + m) * 2 + n) * 512)];
                        if (m & 1) asm volatile("" ::: "memory");
                    }
                }
        }
        const int col0 = u.pn * 256 + wc * 32 + 4 * fq, j = modidx(u.pm * 256);
        const float* gp = gate + (size_t)j * 6144 + col0;
        f32x4 gv[2][2], gn[2][2];
#pragma unroll
        for (int bj = 0; bj < 2; ++bj)
#pragma unroll
            for (int n = 0; n < 2; ++n) {
                gv[bj][n] = *(const f32x4*)(gp + bj * 128 + n * 16);
                if (has_next) gn[bj][n] = *(const f32x4*)(nw + col0 + bj * 128 + n * 16) * (*(const f32x4*)(sc + (size_t)j * 6144 + col0 + bj * 128 + n * 16) + 1.0f);
                else gn[bj][n] = (f32x4){0.f, 0.f, 0.f, 0.f};
            }
#pragma unroll
        for (int hp = 0; hp < 4; ++hp) {
            const int ai = hp >> 1, m0 = (hp & 1) * 2;
            f32x4 pre[2][2][2];
#pragma unroll
            for (int mm = 0; mm < 2; ++mm) {
                const int row = u.pm * 256 + ai * 128 + wr * 64 + (m0 + mm) * 16 + fr;
                const float* b = (row < MP) ? baseP + (size_t)row * D : baseS + (size_t)(row - MP) * D;
#pragma unroll
                for (int bj = 0; bj < 2; ++bj)
#pragma unroll
                    for (int n = 0; n < 2; ++n) pre[mm][bj][n] = *(const f32x4*)(b + col0 + bj * 128 + n * 16);
            }
#pragma unroll
            for (int mm = 0; mm < 2; ++mm) {
                const int m = m0 + mm;
                const int row = u.pm * 256 + ai * 128 + wr * 64 + m * 16 + fr;
                float q = 0.f;
#pragma unroll
                for (int bj = 0; bj < 2; ++bj)
#pragma unroll
                    for (int n = 0; n < 2; ++n) {
                        const int c = col0 + bj * 128 + n * 16;
                        const f32x4 x = pre[mm][bj][n] + gv[bj][n] * acc[ai][bj][m][n];
                        __builtin_nontemporal_store(x, (f32x4*)(out + (size_t)row * D + c));
                        q += (x.x * x.x + x.y * x.y) + (x.z * x.z + x.w * x.w);
                        if (has_next) { const f32x4 y = x * gn[bj][n]; u32x2 w; w.x = pk2(y.x, y.y); w.y = pk2(y.z, y.w); *(u32x2*)(xg + (size_t)row * D + c) = w; }
                    }
                q += __shfl_xor(q, 16); q += __shfl_xor(q, 32);
                if (fq == 0 && has_next) ssq[(size_t)row * 16 + u.pn * 4 + wc] = q;
            }
        }
    }
};

struct RangeOrder : pg8::StaticOrder {
    int lo, hi, fix;
    __host__ __device__ bool next(int i, pg8::Unit& u) const {
        long L;
        if (fix >= 0) { if (i > 0) return false; L = fix; } else { L = (long)lo + (long)i * G + c; if (L >= hi) return false; }
        int wgid = (int)L; { const int q = nwg / pg8::NXCD, r = nwg % pg8::NXCD, xcd = wgid % pg8::NXCD, off = wgid / pg8::NXCD; wgid = (xcd < r ? xcd * (q + 1) : r * (q + 1) + (xcd - r) * q) + off; }
        const int nig = pg8::WGM * nN, gid = wgid / nig, fm = gid * pg8::WGM, gsz = (nM - fm) < pg8::WGM ? (nM - fm) : pg8::WGM;
        u.pm = fm + ((wgid % nig) % gsz); u.pn = (wgid % nig) / gsz; return true;
    }
};

DI void transpose_item(const float* W, int K, int N, bf16_t* WT, LAS float* scr, int item, int lane) {
    const int nblk = N / 64, kb = item / nblk, nb = item - kb * nblk, k0 = 64 * kb, n0 = 64 * nb;
    const int kr = lane >> 4, nq = lane & 15;
    f32x4 v[16];
#pragma unroll
    for (int i = 0; i < 16; ++i) v[i] = *(const f32x4*)(W + (size_t)(k0 + 4 * i + kr) * N + n0 + 4 * nq);
#pragma unroll
    for (int i = 0; i < 16; ++i) { LAS float* d = scr + (4 * i + kr) * 65 + 4 * nq; d[0] = v[i].x; d[1] = v[i].y; d[2] = v[i].z; d[3] = v[i].w; }
    asm volatile("s_waitcnt lgkmcnt(0)" ::: "memory");
    const int c = lane & 7;
#pragma unroll
    for (int j = 0; j < 8; ++j) { const int n = (lane >> 3) + 8 * j; const LAS float* s = scr + (8 * c) * 65 + n;
        u32x4 o; o.x = pk2(s[0 * 65], s[1 * 65]); o.y = pk2(s[2 * 65], s[3 * 65]); o.z = pk2(s[4 * 65], s[5 * 65]); o.w = pk2(s[6 * 65], s[7 * 65]);
        *(u32x4*)(WT + (size_t)(n0 + n) * K + k0 + 8 * c) = o; }
    asm volatile("s_waitcnt lgkmcnt(0)" ::: "memory");
}
DI void gemv9_unit(const float* W, int N, int n0, const float* v0, const float* v1, int vs, bool do_silu, const float* badd, float* out, int ostride, float* scr, int tid) {
    const int wave = __builtin_amdgcn_readfirstlane(tid >> 6), lane = tid & 63;
    float* sv = scr; float* red = scr + NMOD * 1024;
    for (int idx = tid; idx < NMOD * 1024; idx += 512) {
        const int j = idx >> 10, k = idx & 1023;
        float v = (j == 0) ? v0[k] : v1[(size_t)(j - 1) * vs + k];
        if (do_silu) v = v * sigmoidf_(v);
        sv[idx] = v;
    }
    __syncthreads();
    float acc[NMOD];
#pragma unroll
    for (int j = 0; j < NMOD; ++j) acc[j] = 0.f;
    const float* wp = W + (size_t)(wave * 128) * N + n0 + lane;
#pragma unroll 2
    for (int k = 0; k < 128; k += 4) {
        const float w0 = wp[(size_t)k * N], w1 = wp[(size_t)(k + 1) * N], w2 = wp[(size_t)(k + 2) * N], w3 = wp[(size_t)(k + 3) * N];
#pragma unroll
        for (int j = 0; j < NMOD; ++j) {
            const f32x4 s = *(const f32x4*)(sv + j * 1024 + wave * 128 + k);
            acc[j] += (s.x * w0 + s.y * w1) + (s.z * w2 + s.w * w3);
        }
    }
#pragma unroll
    for (int j = 0; j < NMOD; ++j) red[(wave * NMOD + j) * 64 + lane] = acc[j];
    __syncthreads();
    for (int idx = tid; idx < NMOD * 64; idx += 512) {
        const int j = idx >> 6, ln = idx & 63; float s = 0.f;
#pragma unroll
        for (int w = 0; w < 8; ++w) s += red[(w * NMOD + j) * 64 + ln];
        if (badd) s += badd[n0 + ln];
        out[(size_t)j * ostride + n0 + ln] = s;
    }
    __syncthreads();
}

DI void conv_unit(int ct, int l, const bf16_t* RAW, bf16_t* ATT, const float* dw_w, const float* dw_b, const float* ln_g, const float* ln_b, float* lds, int tid) {
    const int row0 = ct * 64;
    int seq0, L;
    if (row0 < MP) { seq0 = row0 & ~255; L = 256; } else { seq0 = MP + ((row0 - MP) & ~2047); L = 2048; }
    const int t0 = row0 - seq0;
    {
        u32x4 wa[6], wg[6];
#pragma unroll
        for (int i = 0; i < 6; ++i) {
            const int it = tid + 512 * i, rr = it >> 5, c8 = it & 31, t = t0 - 15 + rr;
            if (it < 94 * 32 && t >= 0 && t < L) { const bf16_t* p = RAW + (size_t)(seq0 + t) * INW + c8 * 8; wa[i] = *(const u32x4*)p; wg[i] = *(const u32x4*)(p + 256); }
            else { wa[i] = (u32x4){0u, 0u, 0u, 0u}; wg[i] = (u32x4){0u, 0u, 0u, 0u}; }
        }
#pragma unroll
        for (int i = 0; i < 6; ++i) {
            const int it = tid + 512 * i, rr = it >> 5, c8 = it & 31;
            if (it < 94 * 32) {
                float a[8], g[8], hv[8]; unpack8(wa[i], a); unpack8(wg[i], g);
#pragma unroll
                for (int e2 = 0; e2 < 8; ++e2) hv[e2] = a[e2] * sigmoidf_(g[e2]);
                float* d = lds + rr * 256 + c8 * 8;
                *(f32x4*)d = (f32x4){hv[0], hv[1], hv[2], hv[3]}; *(f32x4*)(d + 4) = (f32x4){hv[4], hv[5], hv[6], hv[7]};
            }
        }
    }
    __syncthreads();
    const int c = tid & 255, th = tid >> 8;
    float w[31];
#pragma unroll
    for (int k = 0; k < 31; ++k) w[k] = dw_w[(size_t)(l * 31 + k) * 256 + c];
    const float bias = dw_b[l * 256 + c];
    float outv[32];
#pragma unroll
    for (int ch = 0; ch < 2; ++ch) {
        float hv[46];
#pragma unroll
        for (int i = 0; i < 46; ++i) hv[i] = lds[(th * 32 + ch * 16 + i) * 256 + c];
#pragma unroll
        for (int o = 0; o < 16; ++o) {
            float s = bias;
#pragma unroll
            for (int k = 0; k < 31; ++k) s += hv[o + k] * w[k];
            outv[ch * 16 + o] = s;
        }
    }
    __syncthreads();
#pragma unroll
    for (int o = 0; o < 32; ++o) lds[(th * 32 + o) * 256 + c] = outv[o];
    __syncthreads();
    const int wave = tid >> 6, lane = tid & 63;
    const f32x4 g4 = *(const f32x4*)(ln_g + l * 256 + 4 * lane), b4 = *(const f32x4*)(ln_b + l * 256 + 4 * lane);
#pragma unroll
    for (int i = 0; i < 8; ++i) {
        const int tk = wave * 8 + i;
        const f32x4 v = *(const f32x4*)(lds + tk * 256 + 4 * lane);
        const float mean = wave_sum((v.x + v.y) + (v.z + v.w)) * (1.f / 256.f);
        const f32x4 dv = v - mean;
        const float var = wave_sum((dv.x * dv.x + dv.y * dv.y) + (dv.z * dv.z + dv.w * dv.w)) * (1.f / 256.f);
        const float rstd = rsqrtf(var + EPS);
        f32x4 y = dv * rstd * g4 + b4;
        y.x *= sigmoidf_(y.x); y.y *= sigmoidf_(y.y); y.z *= sigmoidf_(y.z); y.w *= sigmoidf_(y.w);
        u32x2 o; o.x = pk2(y.x, y.y); o.y = pk2(y.z, y.w);
        *(u32x2*)(ATT + (size_t)(row0 + tk) * D + 4 * lane) = o;
    }
    __syncthreads();
}

struct PrepP { const bf16_t* RAW; bf16_t* Q; bf16_t* K; bf16_t* VT; float* out; const float *aqg, *akg, *nqg, *nkg; };
DI void qkv_unit(int ct, int l, const PrepP& P, bf16_t* ldsv, int tid) {
    const int row0 = ct * 64;
    const bool prompt = row0 < MP;
    int seq0, L, sb;
    if (prompt) { seq0 = row0 & ~255; L = 256; sb = row0 >> 8; } else { seq0 = MP + ((row0 - MP) & ~2047); L = 2048; sb = (row0 - MP) >> 11; }
    const int t0 = row0 - seq0;
    {
    const int lane = tid & 63, wave = __builtin_amdgcn_readfirstlane(tid >> 6), half = lane >> 5;
    for (int wi = wave; wi < 40; wi += 8) {
        const int hd = wi >> 1, tok = (wi & 1) * 32 + (lane & 31);
        const int row = row0 + tok, t = t0 + tok;
        int rcol; const float* gw; bool isq;
        if (hd < 6) { rcol = 512 + 64 * hd; gw = P.aqg; isq = true; }
        else if (hd < 8) { rcol = 896 + 64 * (hd - 6); gw = P.akg; isq = false; }
        else if (hd < 14) { rcol = 1152 + 64 * (hd - 8); gw = P.nqg; isq = true; }
        else { rcol = 1536 + 64 * (hd - 14); gw = P.nkg; isq = false; }
        float v[32];
        const bf16_t* rp = P.RAW + (size_t)row * INW + rcol + 32 * half;
#pragma unroll
        for (int c = 0; c < 4; ++c) { const u32x4 wv = *(const u32x4*)(rp + 8 * c); float tmp[8]; unpack8(wv, tmp);
#pragma unroll
            for (int e2 = 0; e2 < 8; ++e2) v[8 * c + e2] = tmp[e2]; }
        float ss = 0.f;
#pragma unroll
        for (int d = 0; d < 32; ++d) ss += v[d] * v[d];
        ss += __shfl_xor(ss, 32);
        const float rstd = rsqrtf(ss * (1.f / 64.f) + EPS);
        const float* gp = gw + l * 64 + 32 * half;
#pragma unroll
        for (int c4 = 0; c4 < 8; ++c4) { const f32x4 g4 = *(const f32x4*)(gp + 4 * c4); v[4 * c4] *= rstd * g4.x; v[4 * c4 + 1] *= rstd * g4.y; v[4 * c4 + 2] *= rstd * g4.z; v[4 * c4 + 3] *= rstd * g4.w; }
        if ((!prompt) && (hd < 8)) {
            const float pos = (float)(half ? (t & 63) : (t >> 6));
#pragma unroll
            for (int j = 0; j < 16; ++j) {
                const float inv = exp2f(-(float)j * 0.8304820237218406f);
                float sn, cs; __sincosf(pos * inv, &sn, &cs);
                const float a = v[j], b = v[16 + j];
                v[j] = a * cs - b * sn; v[16 + j] = b * cs + a * sn;
            }
        }
        if (isq) {
            const int qh = (hd < 6) ? hd : 6 + (hd - 8);
            bf16_t* qp = P.Q + (prompt ? ((size_t)(sb * 12 + qh) * 8 + (t >> 5)) * 2048 : (size_t)MP * 768 + ((size_t)(sb * 12 + qh) * 64 + (t >> 5)) * 2048) + (t & 31) * 8 + half * 1024;
#pragma unroll
            for (int c = 0; c < 4; ++c) {
                u32x4 o; o.x = pk2(v[8 * c] * QSCALE, v[8 * c + 1] * QSCALE); o.y = pk2(v[8 * c + 2] * QSCALE, v[8 * c + 3] * QSCALE);
                o.z = pk2(v[8 * c + 4] * QSCALE, v[8 * c + 5] * QSCALE); o.w = pk2(v[8 * c + 6] * QSCALE, v[8 * c + 7] * QSCALE);
                *(u32x4*)(qp + c * 256) = o;
            }
        } else {
            const int kh = (hd < 8) ? (hd - 6) : 2 + (hd - 14);
            bf16_t* kp = P.K + (prompt ? ((size_t)(sb * 8 + kh) * 8 + (t >> 5)) * 2048 : (size_t)MP * 512 + ((size_t)(sb * 8 + kh) * 64 + (t >> 5)) * 2048) + (t & 31) * 8 + half * 1024;
#pragma unroll
            for (int c = 0; c < 4; ++c) {
                u32x4 o; o.x = pk2(v[8 * c], v[8 * c + 1]); o.y = pk2(v[8 * c + 2], v[8 * c + 3]); o.z = pk2(v[8 * c + 4], v[8 * c + 5]); o.w = pk2(v[8 * c + 6], v[8 * c + 7]);
                *(u32x4*)(kp + c * 256) = o;
            }
            if (prompt) {
                float* op;
                if (hd < 8) op = P.out + OFF_AK + ((((size_t)sb * 4 + l) * 256 + t) * 2 + (hd - 6)) * 64 + 32 * half;
                else        op = P.out + OFF_NK + ((((size_t)sb * 4 + l) * 256 + t) * 6 + (hd - 14)) * 64 + 32 * half;
#pragma unroll
                for (int c4 = 0; c4 < 8; ++c4) *(f32x4*)(op + 4 * c4) = (f32x4){v[4 * c4], v[4 * c4 + 1], v[4 * c4 + 2], v[4 * c4 + 3]};
            }
        }
    }
    }
    {
        u32x4 wv8[8];
#pragma unroll
        for (int i = 0; i < 8; ++i) {
            const int it = tid + 512 * i, tok = it >> 6, cc = (it & 63) * 8, rcol = (cc < 128) ? 1024 + cc : 1920 + (cc - 128);
            wv8[i] = *(const u32x4*)(P.RAW + (size_t)(row0 + tok) * INW + rcol);
        }
#pragma unroll
        for (int i = 0; i < 8; ++i) {
            const int it = tid + 512 * i, tok = it >> 6, cc = (it & 63) * 8;
            const u32x4 wv = wv8[i];
            *(u32x4*)(ldsv + tok * 512 + cc) = wv;
            if (prompt) {
                float v[8]; unpack8(wv, v);
                const int t = t0 + tok; float* op;
                if (cc < 128) op = P.out + OFF_AV + (((size_t)sb * 4 + l) * 256 + t) * 128 + cc;
                else          op = P.out + OFF_NV + (((size_t)sb * 4 + l) * 256 + t) * 384 + (cc - 128);
                *(f32x4*)op = (f32x4){v[0], v[1], v[2], v[3]}; *(f32x4*)(op + 4) = (f32x4){v[4], v[5], v[6], v[7]};
            }
        }
    }
    __syncthreads();
    for (int it = tid; it < 512 * 8; it += 512) {
        const int hd_d = it & 511, g = it >> 9;
        unsigned short e[8];
#pragma unroll
        for (int jj = 0; jj < 8; ++jj) { const int p = 8 * g + jj; const int key = (p & ~31) + permkey(p & 31); e[jj] = ldsv[key * 512 + hd_d]; }
        u32x4 o; o.x = e[0] | ((unsigned)e[1] << 16); o.y = e[2] | ((unsigned)e[3] << 16); o.z = e[4] | ((unsigned)e[5] << 16); o.w = e[6] | ((unsigned)e[7] << 16);
        const int vh = hd_d >> 6, dd = hd_d & 63, tile = (t0 >> 5) + (g >> 2);
        const size_t base = prompt ? ((size_t)(sb * 8 + vh) * 8 + tile) * 2048 : (size_t)MP * 512 + ((size_t)(sb * 8 + vh) * 64 + tile) * 2048;
        *(u32x4*)(P.VT + base + ((((dd >> 5) * 2 + ((g >> 1) & 1)) * 2 + (g & 1)) * 32 + (dd & 31)) * 8) = o;
    }
    __syncthreads();
}

struct Seg { const bf16_t* k; const bf16_t* v; int nt; };
#define MFMA32(a, b, c) __builtin_amdgcn_mfma_f32_32x32x16_bf16((a), (b), (c), 0, 0, 0)
DI void issue_tile(const Seg& A, const Seg& B, int t, int lane, LAS unsigned char* slot) {
    const bf16_t* kp = (t < A.nt) ? A.k + (size_t)t * 2048 : B.k + (size_t)(t - A.nt) * 2048;
    const bf16_t* vp = (t < A.nt) ? A.v + (size_t)t * 2048 : B.v + (size_t)(t - A.nt) * 2048;
#pragma unroll
    for (int i = 0; i < 4; ++i) __builtin_amdgcn_global_load_lds((const unsigned*)(kp + i * 512 + lane * 8), (LAS unsigned*)(slot + i * 1024), 16, 0, 0);
#pragma unroll
    for (int i = 0; i < 4; ++i) __builtin_amdgcn_global_load_lds((const unsigned*)(vp + i * 512 + lane * 8), (LAS unsigned*)(slot + 4096 + i * 1024), 16, 0, 0);
}
template <bool NA, int NQB> DI void attn_wave(const bf16_t* Qp, const Seg A, const Seg B, bf16_t* Op, const float* rpbh, int r, int rs, int lane_, LAS unsigned char* ring, LAS float* biasl, int qoff) {
    int lane = lane_; asm volatile("" : "+v"(lane));
    const int r32 = lane & 31, hi = lane >> 5;
    const int nt = A.nt + B.nt;
    issue_tile(A, B, 0, lane, ring);
    issue_tile(A, B, 1, lane, ring + 8192);
    if (NA) { for (int i = lane; i < 15 * 31; i += 64) biasl[i] = rpbh[i] * LOG2E; }
    bf16x8 qf[NQB][4];
#pragma unroll
    for (int qb = 0; qb < NQB; ++qb)
#pragma unroll
        for (int kk = 0; kk < 4; ++kk) qf[qb][kk] = *(const bf16x8*)(Qp + (qoff + qb) * 2048 + kk * 512 + lane * 8);
    f32x16 o[NQB][2];
#pragma unroll
    for (int a = 0; a < NQB; ++a)
#pragma unroll
        for (int b = 0; b < 2; ++b)
#pragma unroll
            for (int i = 0; i < 16; ++i) o[a][b][i] = 0.f;
    float mrun[NQB], lrun[NQB];
#pragma unroll
    for (int a = 0; a < NQB; ++a) { mrun[a] = -1e30f; lrun[a] = 0.f; }
    asm volatile("s_waitcnt vmcnt(0)" ::: "memory");
#pragma nounroll
    for (int t = 0; t < nt; ++t) {
        LAS unsigned char* slot = ring + (t & 1) * 8192;
        if (t + 1 < nt) asm volatile("s_waitcnt vmcnt(8)" ::: "memory"); else asm volatile("s_waitcnt vmcnt(0)" ::: "memory");
        bf16x8 kf[4], vf[2][2];
#pragma unroll
        for (int kk = 0; kk < 4; ++kk) kf[kk] = *(const LAS bf16x8*)(slot + kk * 1024 + lane * 16);
#pragma unroll
        for (int db = 0; db < 2; ++db)
#pragma unroll
            for (int s2 = 0; s2 < 2; ++s2) vf[db][s2] = *(const LAS bf16x8*)(slot + 4096 + (db * 2 + s2) * 1024 + lane * 16);
        asm volatile("s_waitcnt lgkmcnt(0)" ::: "memory");
        if (t + 2 < nt) issue_tile(A, B, t + 2, lane, slot);
#pragma unroll
        for (int qb = 0; qb < NQB; ++qb) {
            f32x16 s;
#pragma unroll
            for (int i = 0; i < 16; ++i) s[i] = 0.f;
#pragma unroll
            for (int kk = 0; kk < 4; ++kk) s = MFMA32(kf[kk], qf[qb][kk], s);
            if (NA) {
                if (t < A.nt) {
                    const int a = t >> 1, half = t & 1;
                    const int qc = 32 * (qoff + qb) + r32, cs = min(max(qc - 8, 0), 48);
                    const int kc0 = 32 * half + 4 * hi;
                    const LAS float* bp = biasl + (rs + a - r + 7) * 31 + (kc0 - qc + 15);
                    const unsigned u0 = (unsigned)(kc0 - cs);
                    float bia[16];
#pragma unroll
                    for (int i = 0; i < 16; ++i) bia[i] = bp[(i & 3) + 8 * (i >> 2)];
                    asm volatile("" : "+v"(bia[0]), "+v"(bia[1]), "+v"(bia[2]), "+v"(bia[3]), "+v"(bia[4]), "+v"(bia[5]), "+v"(bia[6]), "+v"(bia[7]),
                                      "+v"(bia[8]), "+v"(bia[9]), "+v"(bia[10]), "+v"(bia[11]), "+v"(bia[12]), "+v"(bia[13]), "+v"(bia[14]), "+v"(bia[15]));
#pragma unroll
                    for (int i = 0; i < 16; ++i) {
                        const bool valid = (u0 + (unsigned)((i & 3) + 8 * (i >> 2))) < 16u;
                        s[i] = valid ? s[i] + bia[i] : -1e30f;
                    }
                }
            }
            float ps = 0.f;
#pragma unroll
            for (int i = 0; i < 16; ++i) { const float p = __builtin_amdgcn_exp2f(fminf(s[i], 96.0f)); s[i] = p; ps += p; }
            lrun[qb] += ps;
            u32x4 p0, p1;
            p0.x = pk2(s[0], s[1]); p0.y = pk2(s[2], s[3]); p0.z = pk2(s[4], s[5]); p0.w = pk2(s[6], s[7]);
            p1.x = pk2(s[8], s[9]); p1.y = pk2(s[10], s[11]); p1.z = pk2(s[12], s[13]); p1.w = pk2(s[14], s[15]);
            const bf16x8 P0 = __builtin_bit_cast(bf16x8, p0), P1 = __builtin_bit_cast(bf16x8, p1);
#pragma unroll
            for (int db = 0; db < 2; ++db) { o[qb][db] = MFMA32(vf[db][0], P0, o[qb][db]); o[qb][db] = MFMA32(vf[db][1], P1, o[qb][db]); }
        }
    }
#pragma unroll
    for (int qb = 0; qb < NQB; ++qb) {
        const float lt = lrun[qb] + __shfl_xor(lrun[qb], 32);
        const float inv = 1.f / lt;
        bf16_t* orow = Op + (size_t)(32 * (qoff + qb) + r32) * D;
#pragma unroll
        for (int db = 0; db < 2; ++db)
#pragma unroll
            for (int g = 0; g < 4; ++g) {
                u32x2 w; w.x = pk2(o[qb][db][4 * g] * inv, o[qb][db][4 * g + 1] * inv); w.y = pk2(o[qb][db][4 * g + 2] * inv, o[qb][db][4 * g + 3] * inv);
                *(u32x2*)(orow + 32 * db + 8 * g + 4 * hi) = w;
            }
    }
}

DI void attn_wave_shared(const bf16_t* Qp, const Seg A, const Seg B, bf16_t* Op, int lane_, int wave, LAS unsigned char* ring) {
    int lane = lane_; asm volatile("" : "+v"(lane));
    const int r32 = lane & 31, hi = lane >> 5;
    const int nt = A.nt + B.nt;
    const bool isk = wave < 4;
    const int poff = (isk ? wave : wave - 4) * 512;
    const int loff = isk ? wave * 1024 : 4096 + (wave - 4) * 1024;
    const bf16_t* srcA = (isk ? A.k : A.v) + poff + lane * 8;
    const bf16_t* srcB = (isk ? B.k : B.v) + poff + lane * 8;
#define ISSUE_PIECE(tt) do { const int t_ = (tt); const bf16_t* src_ = (t_ < A.nt) ? srcA + (size_t)t_ * 2048 : srcB + (size_t)(t_ - A.nt) * 2048; \
        __builtin_amdgcn_global_load_lds((const unsigned*)src_, (LAS unsigned*)(ring + (t_ & 15) * 8192 + loff), 16, 0, 0); } while (0)
    bf16x8 qf[2][4];
#pragma unroll
    for (int qb = 0; qb < 2; ++qb)
#pragma unroll
        for (int kk = 0; kk < 4; ++kk) qf[qb][kk] = *(const bf16x8*)(Qp + qb * 2048 + kk * 512 + lane * 8);
    asm volatile("s_waitcnt vmcnt(0) lgkmcnt(0)" ::: "memory");
#pragma unroll
    for (int tt = 0; tt < 8; ++tt) ISSUE_PIECE(tt);
    f32x16 o[2][2];
#pragma unroll
    for (int a = 0; a < 2; ++a)
#pragma unroll
        for (int b = 0; b < 2; ++b)
#pragma unroll
            for (int i = 0; i < 16; ++i) o[a][b][i] = 0.f;
    float mrun[2] = {-1e30f, -1e30f}, lrun[2] = {0.f, 0.f};
#pragma nounroll
    for (int t = 0; t < nt; ++t) {
        if ((t & 7) == 0) {
            asm volatile("s_waitcnt vmcnt(0) lgkmcnt(0)\n\ts_barrier" ::: "memory");
            if (t + 8 < nt) {
#pragma unroll
                for (int tt = 0; tt < 8; ++tt) ISSUE_PIECE(t + 8 + tt);
            }
            if (((wave ^ (wave >> 2)) & 1) != 0) __builtin_amdgcn_s_sleep(19);
        }
        LAS unsigned char* slot = ring + (t & 15) * 8192;
        bf16x8 kf[4], vf[2][2];
#pragma unroll
        for (int kk = 0; kk < 4; ++kk) kf[kk] = *(const LAS bf16x8*)(slot + kk * 1024 + lane * 16);
#pragma unroll
        for (int db = 0; db < 2; ++db)
#pragma unroll
            for (int s2 = 0; s2 < 2; ++s2) vf[db][s2] = *(const LAS bf16x8*)(slot + 4096 + (db * 2 + s2) * 1024 + lane * 16);
        asm volatile("s_waitcnt lgkmcnt(0)" ::: "memory");
#pragma unroll
        for (int qb = 0; qb < 2; ++qb) {
            f32x16 s;
#pragma unroll
            for (int i = 0; i < 16; ++i) s[i] = 0.f;
#pragma unroll
            for (int kk = 0; kk < 4; ++kk) s = MFMA32(kf[kk], qf[qb][kk], s);
            float ps = 0.f;
#pragma unroll
            for (int i = 0; i < 16; ++i) { const float p = __builtin_amdgcn_exp2f(fminf(s[i], 96.0f)); s[i] = p; ps += p; }
            lrun[qb] += ps;
            u32x4 p0, p1;
            p0.x = pk2(s[0], s[1]); p0.y = pk2(s[2], s[3]); p0.z = pk2(s[4], s[5]); p0.w = pk2(s[6], s[7]);
            p1.x = pk2(s[8], s[9]); p1.y = pk2(s[10], s[11]); p1.z = pk2(s[12], s[13]); p1.w = pk2(s[14], s[15]);
            const bf16x8 P0 = __builtin_bit_cast(bf16x8, p0), P1 = __builtin_bit_cast(bf16x8, p1);
#pragma unroll
            for (int db = 0; db < 2; ++db) { o[qb][db] = MFMA32(vf[db][0], P0, o[qb][db]); o[qb][db] = MFMA32(vf[db][1], P1, o[qb][db]); }
        }
    }
#undef ISSUE_PIECE
#pragma unroll
    for (int qb = 0; qb < 2; ++qb) {
        const float lt = lrun[qb] + __shfl_xor(lrun[qb], 32);
        const float inv = 1.f / lt;
        bf16_t* orow = Op + (size_t)(32 * qb + r32) * D;
#pragma unroll
        for (int db = 0; db < 2; ++db)
#pragma unroll
            for (int g = 0; g < 4; ++g) {
                u32x2 w; w.x = pk2(o[qb][db][4 * g] * inv, o[qb][db][4 * g + 1] * inv); w.y = pk2(o[qb][db][4 * g + 2] * inv, o[qb][db][4 * g + 3] * inv);
                *(u32x2*)(orow + 32 * db + 8 * g + 4 * hi) = w;
            }
    }
    asm volatile("s_waitcnt vmcnt(0) lgkmcnt(0)\n\ts_barrier" ::: "memory");
}

struct AttnP { const bf16_t *Q, *K, *VT, *KCA, *VCA, *KCN, *VCN; bf16_t* ATT; const float* rpb; };
DI void attn_run_unit(int uid, int qsel, int l, const AttnP& P, int lane, LAS unsigned char* ring, LAS float* biasl, bool shared, int wave, LAS unsigned char* lds0) {
    const size_t QS = (size_t)MP * 768, KS = (size_t)MP * 512;
    Seg A, B{nullptr, nullptr, 0}; const bf16_t* Qp; bf16_t* Op; const float* rp = nullptr; int r = 0, rs = 0; bool na = false;
    if (uid < 1536) {
        const int qc = uid & 31, bh = uid >> 5, b = bh / 6, h = bh - 6 * b, kvh = h / 3;
        const int row0 = MP + b * 2048;
        A = Seg{P.K + KS + (size_t)(b * 8 + kvh) * 64 * 2048, P.VT + KS + (size_t)(b * 8 + kvh) * 64 * 2048, 64};
        B = Seg{P.KCA + (size_t)((b * 4 + l) * 2 + kvh) * 16384, P.VCA + (size_t)((b * 4 + l) * 2 + kvh) * 16384, 8};
        Qp = P.Q + QS + ((size_t)(b * 12 + h) * 64 + 2 * qc) * 2048; Op = P.ATT + (size_t)(row0 + qc * 64) * D + 256 + h * 64;
    } else if (uid < 3072) {
        const int u = uid - 1536, bh = u >> 5, b = bh / 6, h = bh - 6 * b;
        r = u & 31; rs = min(max(r - 4, 0), 24); na = true;
        const int row0 = MP + b * 2048;
        A = Seg{P.K + KS + ((size_t)(b * 8 + 2 + h) * 64 + 2 * rs) * 2048, P.VT + KS + ((size_t)(b * 8 + 2 + h) * 64 + 2 * rs) * 2048, 16};
        B = Seg{P.KCN + (size_t)((b * 4 + l) * 6 + h) * 16384, P.VCN + (size_t)((b * 4 + l) * 6 + h) * 16384, 8};
        Qp = P.Q + QS + ((size_t)(b * 12 + 6 + h) * 64 + 2 * r) * 2048; Op = P.ATT + (size_t)(row0 + r * 64) * D + 640 + h * 64;
        rp = P.rpb + (size_t)(l * 6 + h) * 15 * 31;
    } else {
        const int nah = uid >= 3840;
        const int u = uid - (nah ? 3840 : 3072), qc = u & 3, bh = u >> 2, b = bh / 6, h = bh - 6 * b, kh = nah ? 2 + h : h / 3;
        const int row0 = b * 256;
        A = Seg{P.K + (size_t)(b * 8 + kh) * 8 * 2048, P.VT + (size_t)(b * 8 + kh) * 8 * 2048, 8};
        Qp = P.Q + ((size_t)(b * 12 + (nah ? 6 : 0) + h) * 8 + 2 * qc) * 2048; Op = P.ATT + (size_t)(row0 + qc * 64) * D + (nah ? 640 : 256) + h * 64;
    }
    if (na) { if (qsel == 2) attn_wave<true, 2>(Qp, A, B, Op, rp, r, rs, lane, ring, biasl, 0); else attn_wave<true, 1>(Qp, A, B, Op, rp, r, rs, lane, ring, biasl, qsel); }
    else if (shared) attn_wave_shared(Qp, A, B, Op, lane, wave, lds0);
    else attn_wave<false, 2>(Qp, A, B, Op, rp, r, rs, lane, ring, biasl, 0);
}

struct Args {
    const float* in[25]; float* out; unsigned char* ws; int ph_lo, ph_hi;
};
#define XB_TMO      128
#define XB_XCNT(j)  (256  + 64 * (j))
#define XB_XSUB(j)  (1280 + 64 * (j))
#define XB_XGEN(j)  (2304 + 64 * (j))
#define XB_TOP      3328
#define XB_TOPGEN   3392
#define XCD_BAR_WORDS 3456
#define XB_SPIN_CAP (1u << 18)

__device__ __forceinline__ unsigned xb_ld(unsigned* p)              { return __hip_atomic_load(p, __ATOMIC_RELAXED, __HIP_MEMORY_SCOPE_AGENT); }
__device__ __forceinline__ unsigned xb_add(unsigned* p, unsigned v) { return __hip_atomic_fetch_add(p, v, __ATOMIC_RELAXED, __HIP_MEMORY_SCOPE_AGENT); }
__device__ __forceinline__ unsigned xb_xcc_id() { return (unsigned)__builtin_amdgcn_s_getreg((3 << 11) | 20) & 0xFu; }
#define XB_SPIN(cond, bar) do { unsigned _sp = 0; while (cond) { __builtin_amdgcn_s_sleep(1); \
    if ((++_sp & 255u) == 0u) { if (xb_ld(&(bar)[XB_TMO])) break; if (_sp > XB_SPIN_CAP) { atomicAdd(&(bar)[XB_TMO], 1u); break; } } } } while (0)

struct XcdBarrier {
    unsigned* bar; unsigned x;
    volatile LAS unsigned* st;
};

__device__ __forceinline__ XcdBarrier xcd_barrier_post(unsigned* bar, volatile LAS unsigned* st) {
    XcdBarrier b; b.bar = bar; b.x = xb_xcc_id(); b.st = st;
    if (threadIdx.x == 0) { const unsigned old_ = xb_add(&bar[XB_XCNT(b.x)], 1u); st[2] = old_; st[3] = b.x; }
    return b;
}
__device__ __forceinline__ void xcd_barrier_complete(unsigned* bar, unsigned x, unsigned& nloc, unsigned& nx) {
    const unsigned G = gridDim.x * gridDim.y * gridDim.z;
    unsigned sum, cnt, mine, sp = 0u;
    for (;;) {
        sum = 0u; cnt = 0u; mine = 0u;
#pragma unroll
        for (unsigned j = 0; j < 16; ++j) { const unsigned c = xb_ld(&bar[XB_XCNT(j)]); sum += c; cnt += (c > 0u) ? 1u : 0u; mine = (j == x) ? c : mine; }
        if (sum == G) break;
        __builtin_amdgcn_s_sleep(1);
        if ((++sp & 255u) == 0u) { if (xb_ld(&bar[XB_TMO])) break; if (sp > XB_SPIN_CAP) { atomicAdd(&bar[XB_TMO], 1u); break; } }
    }
    nloc = mine > 0u ? mine : 1u; nx = cnt > 0u ? cnt : 1u;
}

__device__ __forceinline__ void xcd_barrier(const XcdBarrier& b) {
    asm volatile("s_waitcnt vmcnt(0)" ::: "memory");
    __syncthreads();
    if (threadIdx.x == 0) {
        unsigned* bar = b.bar; asm volatile("" : "+v"(bar));
        __builtin_amdgcn_s_waitcnt(0);
        unsigned nloc = b.st[0], nx = b.st[1];
        if (nloc == 0u) { xcd_barrier_complete(bar, b.x, nloc, nx); b.st[0] = nloc; b.st[1] = nx; }
        const unsigned old = xb_add(&bar[XB_XSUB(b.x)], 1u);
        const unsigned gen = old / nloc;
        if (old + 1u == (gen + 1u) * nloc) {
            __builtin_amdgcn_fence(__ATOMIC_RELEASE, "agent");
            asm volatile("s_waitcnt vmcnt(0)" ::: "memory");
            const unsigned og = xb_add(&bar[XB_TOP], 1u);
            const unsigned tg = og / nx;
            if (og + 1u == (tg + 1u) * nx) xb_add(&bar[XB_TOPGEN], 1u);
            else XB_SPIN(xb_ld(&bar[XB_TOPGEN]) == tg, bar);
            __builtin_amdgcn_fence(__ATOMIC_ACQUIRE, "agent");
            xb_add(&bar[XB_XGEN(b.x)], 1u);
            asm volatile("s_waitcnt vmcnt(0)" ::: "memory");
        } else {
            XB_SPIN(xb_ld(&bar[XB_XGEN(b.x)]) == gen, bar);
            __builtin_amdgcn_fence(__ATOMIC_ACQUIRE, "agent");
            asm volatile("s_waitcnt vmcnt(0)" ::: "memory");
        }
    }
    __syncthreads();
}

typedef const __attribute__((address_space(4))) char* kargp_t;
DI const float* ldin(int i) { kargp_t kp = (kargp_t)__builtin_amdgcn_kernarg_segment_ptr(); asm volatile("" : "+s"(kp)); return (const float*)(*(const __attribute__((address_space(4))) unsigned long long*)(kp + 8 * i)); }
DI float* ldout() { return (float*)ldin(25); }
DI unsigned char* ldws() { return (unsigned char*)ldin(26); }
DI int opq_tid() { int t = threadIdx.x; asm volatile("" : "+v"(t)); return t; }

__global__ void __launch_bounds__(512, 2) fwd_kernel(Args a) {
    extern __shared__ __attribute__((aligned(16))) unsigned char lds[];
    cg::grid_group grid = cg::this_grid();
    const int G = gridDim.x, bx = blockIdx.x, NGW = G * 8;
    const int lo = a.ph_lo, hi = a.ph_hi;
#define IN(k) (lo <= (k) && (k) < hi)
    volatile LAS unsigned* MISC = (volatile LAS unsigned*)((LAS unsigned char*)lds + 146432);
    if (threadIdx.x < 16) MISC[threadIdx.x] = 0u;
    __syncthreads();
    XcdBarrier xbar; xbar.bar = (unsigned*)ldws(); xbar.x = 0; xbar.st = nullptr;
    if (hi - lo > 1) xbar = xcd_barrier_post((unsigned*)ldws(), MISC + 8);
    if (hi < 0) grid.sync();
#define SEAM(k) do { if (IN(k) && (k) + 1 < hi) xcd_barrier(xbar); } while (0)
#define WSP(T, off) ((T*)(ws + (off)))

    for (int sx_ = 0; sx_ < SYNCX; ++sx_) xcd_barrier(xbar);
    if (IN(0)) for (int rep_ = 0; rep_ < REP_P; ++rep_) {
        if (rep_) xcd_barrier(xbar);
        const int tid = opq_tid(), lane = tid & 63, wave = __builtin_amdgcn_readfirstlane(tid >> 6), gw = bx * 8 + wave;
        unsigned char* ws = ldws();
        {
            const float *cvec = ldin(6), *c_ctx = ldin(7), *ada_w = ldin(8), *ada_b = ldin(9);
            float* mod = WSP(float, WS_MOD);
            for (int u = bx; u < DEPTH * 96; u += G) {
                const int l = u / 96, nb = u - l * 96;
                gemv9_unit(ada_w + (size_t)l * D * 6144, 6144, nb * 64, c_ctx, cvec, D, true, ada_b + l * 6144, mod + (size_t)l * NMOD * 6144, 6144, (float*)lds, tid);
            }
        }
        {
            const float *w_in = ldin(12), *w1 = ldin(23);
            bf16_t *WIN = WSP(bf16_t, WS_WIN), *W1T = WSP(bf16_t, WS_W1);
            LAS float* scr = (LAS float*)((LAS unsigned char*)lds + wave * 17408);
            constexpr int I_IN = 16 * 36, I_1 = 16 * 64, I_L = I_IN + I_1;
            for (int it = gw; it < 1 * I_L; it += NGW) {
                const int l = it / I_L; int r = it - l * I_L;
                if (r < I_IN) transpose_item(w_in + (size_t)l * D * INW, D, INW, WIN + (size_t)l * INW * D, scr, r, lane);
                else transpose_item(w1 + (size_t)l * D * FF, D, FF, W1T + (size_t)l * FF * D, scr, r - I_IN, lane);
            }
        }
        {
            const float *cache_ak = ldin(2), *cache_av = ldin(3), *cache_nk = ldin(4), *cache_nv = ldin(5);
            bf16_t *KCA = WSP(bf16_t, WS_KCA), *VCA = WSP(bf16_t, WS_VCA), *KCN = WSP(bf16_t, WS_KCN), *VCN = WSP(bf16_t, WS_VCN);
            const int gt = bx * 512 + tid, NGT = G * 512;
            for (int e = gt; e < 8 * 4 * 256 * 8 * 8; e += NGT) {
                const int c8 = e & 7, hh = (e >> 3) & 7, key = (e >> 6) & 255, bl = e >> 14;
                const float* src; bf16_t* dst;
                if (hh < 2) { src = cache_ak + (((size_t)bl * 256 + key) * 2 + hh) * 64 + 8 * c8; dst = KCA + (((size_t)bl * 2 + hh) * 8 + (key >> 5)) * 2048 + (c8 * 32 + (key & 31)) * 8; }
                else { src = cache_nk + (((size_t)bl * 256 + key) * 6 + (hh - 2)) * 64 + 8 * c8; dst = KCN + (((size_t)bl * 6 + (hh - 2)) * 8 + (key >> 5)) * 2048 + (c8 * 32 + (key & 31)) * 8; }
                const f32x4 v0 = *(const f32x4*)src, v1 = *(const f32x4*)(src + 4);
                u32x4 o; o.x = pk2(v0.x, v0.y); o.y = pk2(v0.z, v0.w); o.z = pk2(v1.x, v1.y); o.w = pk2(v1.z, v1.w);
                *(u32x4*)dst = o;
            }
            for (int e = gt; e < 8 * 4 * 8 * 32 * 64; e += NGT) {
                const int d = e & 63, g = (e >> 6) & 31, hh = (e >> 11) & 7, bl = e >> 14;
                unsigned short q[8];
#pragma unroll
                for (int jj = 0; jj < 8; ++jj) {
                    const int p = 8 * g + jj, key = (p & ~31) + permkey(p & 31);
                    const float v = (hh < 2) ? cache_av[(((size_t)bl * 256 + key) * 2 + hh) * 64 + d] : cache_nv[(((size_t)bl * 256 + key) * 6 + (hh - 2)) * 64 + d];
                    q[jj] = (unsigned short)(pk2(v, 0.f) & 0xffffu);
                }
                u32x4 o; o.x = q[0] | ((unsigned)q[1] << 16); o.y = q[2] | ((unsigned)q[3] << 16); o.z = q[4] | ((unsigned)q[5] << 16); o.w = q[6] | ((unsigned)q[7] << 16);
                const int voff = (g >> 2) * 2048 + ((((d >> 5) * 2 + ((g >> 1) & 1)) * 2 + (g & 1)) * 32 + (d & 31)) * 8;
                bf16_t* dst = (hh < 2) ? VCA + ((size_t)bl * 2 + hh) * 16384 + voff : VCN + ((size_t)bl * 6 + (hh - 2)) * 16384 + voff;
                *(u32x4*)dst = o;
            }
        }
    }
    SEAM(0);
    if (IN(1)) for (int rep_ = 0; rep_ < REP_P; ++rep_) {
        if (rep_) xcd_barrier(xbar);
        const int tid = opq_tid(), lane = tid & 63, wave = __builtin_amdgcn_readfirstlane(tid >> 6), gw = bx * 8 + wave;
        unsigned char* ws = ldws();
        float* mod = WSP(float, WS_MOD);
        {
            const float *w_in = ldin(12), *w1 = ldin(23);
            float *bias1 = WSP(float, WS_BIAS1), *bias2 = WSP(float, WS_BIAS2);
            for (int u = bx; u < DEPTH * 100; u += G) {
                const int l = u / 100; int r = u - l * 100;
                const float* ml = mod + (size_t)l * NMOD * 6144;
                if (r < 36) gemv9_unit(w_in + (size_t)l * D * INW, INW, r * 64, ml, ml + 6144, 6144, false, nullptr, bias1 + (size_t)l * NMOD * INW, INW, (float*)lds, tid);
                else { r -= 36; gemv9_unit(w1 + (size_t)l * D * FF, FF, r * 64, ml + 3072, ml + 6144 + 3072, 6144, false, nullptr, bias2 + (size_t)l * NMOD * FF, FF, (float*)lds, tid); }
            }
        }
        {
            const float *w_out = ldin(22), *w2 = ldin(24);
            bf16_t *WOUT = WSP(bf16_t, WS_WOUT), *W2T = WSP(bf16_t, WS_W2);
            LAS float* scr = (LAS float*)((LAS unsigned char*)lds + wave * 17408);
            constexpr int I_OUT = 16 * 16, I_2 = 64 * 16, I_L = I_OUT + I_2;
            for (int it = gw; it < 1 * I_L; it += NGW) {
                const int l = it / I_L; int r = it - l * I_L;
                if (r < I_OUT) transpose_item(w_out + (size_t)l * D * D, D, D, WOUT + (size_t)l * D * D, scr, r, lane);
                else transpose_item(w2 + (size_t)l * FF * D, FF, D, W2T + (size_t)l * D * FF, scr, r - I_OUT, lane);
            }
        }
        {
            const float *x_prompt = ldin(0), *x_sample = ldin(1), *norm1_g = ldin(10);
            bf16_t* XG = WSP(bf16_t, WS_XG); float* ssq = WSP(float, WS_SSQ);
            for (int row = gw; row < M; row += NGW) {
                const float* xr = (row < MP) ? x_prompt + (size_t)row * D : x_sample + (size_t)(row - MP) * D;
                const float* scp = mod + (size_t)modidx(row) * 6144 + 1024;
                float s = 0.f;
#pragma unroll
                for (int j = 0; j < 4; ++j) {
                    const int c = 256 * j + 4 * lane;
                    const f32x4 v = *(const f32x4*)(xr + c);
                    s += (v.x * v.x + v.y * v.y) + (v.z * v.z + v.w * v.w);
                    const f32x4 y = v * (*(const f32x4*)(norm1_g + c)) * (*(const f32x4*)(scp + c) + 1.0f);
                    u32x2 w; w.x = pk2(y.x, y.y); w.y = pk2(y.z, y.w);
                    *(u32x2*)(XG + (size_t)row * D + c) = w;
                }
                s = wave_sum(s);
                if (lane < 16) ssq[(size_t)row * 16 + lane] = (lane == 0) ? s : 0.f;
            }
        }
    }
    SEAM(1);
#pragma nounroll
    for (int l_ = 0; l_ < DEPTH; ++l_) {
        int l = l_; asm volatile("" : "+s"(l));
        const int p0 = 2 + 6 * l;
        if (IN(p0)) for (int rep_ = 0; rep_ < REP_G1; ++rep_) {
            unsigned char* ws = ldws();
            pg8::Gemm g{WSP(bf16_t, WS_XG), WSP(bf16_t, WS_WIN) + (size_t)l * INW * D, M, INW, D, D}; pg8::StaticOrder S; S.init(M, INW, G, bx);
            EpiLin<0> E{WSP(bf16_t, WS_RAW), INW, WSP(float, WS_BIAS1) + (size_t)l * NMOD * INW, INW, WSP(float, WS_SSQ)};
            pg8::gemm_phase<EpiLin<0>, pg8::StaticOrder, true, true>((LAS unsigned char*)lds, g, S, E);
        }
        SEAM(p0);
        if (IN(p0 + 1)) for (int rep_ = 0; rep_ < REP_PREP; ++rep_) {
            const int tid = opq_tid();
            unsigned char* ws = ldws();
            for (int u = bx; u < 768; u += G) {
                if (u < 384) conv_unit(u, l, WSP(bf16_t, WS_RAW), WSP(bf16_t, WS_ATT), ldin(13), ldin(14), ldin(15), ldin(16), (float*)lds, tid);
                else { PrepP P{WSP(bf16_t, WS_RAW), WSP(bf16_t, WS_Q), WSP(bf16_t, WS_K), WSP(bf16_t, WS_VT), ldout(), ldin(17), ldin(18), ldin(19), ldin(20)}; qkv_unit(u - 384, l, P, (bf16_t*)lds, tid); }
            }
        }
        SEAM(p0 + 1);
        if (IN(p0 + 2)) for (int rep_ = 0; rep_ < REP_ATTN; ++rep_) {
            const int tid = opq_tid(), lane = tid & 63, wave = __builtin_amdgcn_readfirstlane(tid >> 6), gw = bx * 8 + wave;
            unsigned char* ws = ldws();
            AttnP P{WSP(bf16_t, WS_Q), WSP(bf16_t, WS_K), WSP(bf16_t, WS_VT), WSP(bf16_t, WS_KCA), WSP(bf16_t, WS_VCA), WSP(bf16_t, WS_KCN), WSP(bf16_t, WS_VCN), WSP(bf16_t, WS_ATT), ldin(21)};
            bool bal = (NGW == 2048) && (hi - lo > 1);
            int xcd = bx & 7, slot = bx >> 3;
            if (bal) {
                unsigned okc = 1u;
                for (unsigned j = 0; j < 16; ++j) okc &= (xb_ld(&xbar.bar[XB_XCNT(j)]) == (j < 8 ? 32u : 0u)) ? 1u : 0u;
                xcd = __builtin_amdgcn_readfirstlane((int)MISC[11]); slot = __builtin_amdgcn_readfirstlane((int)MISC[10]);
                bal = (__builtin_amdgcn_readfirstlane((int)okc) != 0) && xcd < 8 && slot < 32;
            }
            const int idx = slot * 8 + wave;
            const int nu = bal ? (slot < 24 ? (idx < 64 ? 4 : 2) : 2) : (4608 - gw + NGW - 1) / NGW;
            for (int k = 0; k < nu; ++k) {
#ifdef ATTN_PROBE
                if (rep_ == 1 && ((ATTN_PROBE == 1) ? (slot >= 24) : (ATTN_PROBE == 2) ? (slot < 24) : (slot >= 24 || k > 0))) break;
#endif
                int uid, qsel = 2; bool cshared = false;
                if (!bal) uid = gw + k * NGW;
                else if (slot < 24) {
                    if (k == 0) { uid = (xcd * 6 + (idx >> 5)) * 32 + (idx & 31); cshared = true; }
                    else if (idx < 64) { const int p = (k - 1) * 64 + idx; const int pb = 4 * xcd + p / 48, r = p % 48, kind = r / 24, rr = r % 24; uid = (kind ? 3840 : 3072) + (pb * 6 + (rr >> 2)) * 4 + (rr & 3); }
                    else { uid = 1536 + xcd * 192 + 128 + ((idx - 64) >> 1); qsel = (idx - 64) & 1; }
                } else uid = 1536 + xcd * 192 + k * 64 + (slot - 24) * 8 + wave;
                attn_run_unit(uid, qsel, l, P, lane, (LAS unsigned char*)lds + wave * 16384, (LAS float*)((LAS unsigned char*)lds + 131072 + wave * 1920), cshared, wave, (LAS unsigned char*)lds);
            }
        }
        SEAM(p0 + 2);
        if (IN(p0 + 3)) {
            unsigned char* ws = ldws(); float* X = ldout();
            const float* ml = WSP(float, WS_MOD) + (size_t)l * NMOD * 6144;
            const bool split = false;
#pragma nounroll
            for (int rnd = 0; rnd < (split ? 2 : 1); ++rnd) {
                const int kh = (rnd == 1) ? (bx >> 7) : 0, koff = kh * (D / 2);
                pg8::Gemm g{WSP(bf16_t, WS_ATT) + koff, WSP(bf16_t, WS_WOUT) + (size_t)l * D * D + koff, M, D, D, (rnd == 1) ? D / 2 : D};
                RangeOrder S; S.init(M, D, G, bx); S.lo = 0; S.hi = split ? 256 : 384; S.fix = (rnd == 1) ? 256 + (bx & 127) : -1;
                unsigned* flag = (unsigned*)(ws + 16384) + (size_t)((l * 2 + 0) * 128 + (bx & 127)) * 64;
                f32x4* part = (f32x4*)(ws + WS_RAW) + (size_t)(bx & 127) * 16384;
                EpiRes E{l == 0 ? ldin(0) : X, l == 0 ? ldin(1) : X + (size_t)MP * D, X, ml + 2048, ldin(11) + l * D, ml + 4096, WSP(bf16_t, WS_XG), WSP(float, WS_SSQ), 1, (rnd == 1) ? 1 + kh : 0, part, flag};
                pg8::gemm_phase<EpiRes, RangeOrder, true, true>((LAS unsigned char*)lds, g, S, E);
                if (rnd == 1 && kh == 1) {
                    asm volatile("s_waitcnt vmcnt(0)" ::: "memory"); __syncthreads();
                    if (threadIdx.x == 0) { __builtin_amdgcn_fence(__ATOMIC_RELEASE, "agent"); asm volatile("s_waitcnt vmcnt(0)" ::: "memory"); __hip_atomic_store(flag, 1u, __ATOMIC_RELAXED, __HIP_MEMORY_SCOPE_AGENT); }
                }
            }
            SEAM(p0 + 3);
        }
        if (IN(p0 + 4)) for (int rep_ = 0; rep_ < REP_G3; ++rep_) {
            unsigned char* ws = ldws();
            pg8::Gemm g{WSP(bf16_t, WS_XG), WSP(bf16_t, WS_W1) + (size_t)l * FF * D, M, FF, D, D}; pg8::StaticOrder S; S.init(M, FF, G, bx);
            EpiLin<1> E{WSP(bf16_t, WS_H1), FF, WSP(float, WS_BIAS2) + (size_t)l * NMOD * FF, FF, WSP(float, WS_SSQ)};
            pg8::gemm_phase<EpiLin<1>, pg8::StaticOrder, true, true>((LAS unsigned char*)lds, g, S, E);
        }
        SEAM(p0 + 4);
        if (IN(p0 + 5)) {
            unsigned char* ws = ldws(); float* X = ldout();
            const float* ml = WSP(float, WS_MOD) + (size_t)l * NMOD * 6144;
            const int nx = (l + 1 < DEPTH) ? 1 : 0; const int ln = nx ? l + 1 : l;
            const bool split = false;
#pragma nounroll
            for (int rnd = 0; rnd < (split ? 2 : 1); ++rnd) {
                const int kh = (rnd == 1) ? (bx >> 7) : 0, koff = kh * (FF / 2);
                pg8::Gemm g{WSP(bf16_t, WS_H1) + koff, WSP(bf16_t, WS_W2) + (size_t)l * D * FF + koff, M, D, FF, (rnd == 1) ? FF / 2 : FF};
                RangeOrder S; S.init(M, D, G, bx); S.lo = 0; S.hi = split ? 256 : 384; S.fix = (rnd == 1) ? 256 + (bx & 127) : -1;
                unsigned* flag = (unsigned*)(ws + 16384) + (size_t)((l * 2 + 1) * 128 + (bx & 127)) * 64;
                f32x4* part = (f32x4*)(ws + WS_ATT) + (size_t)(bx & 127) * 16384;
                EpiRes E{X, X + (size_t)MP * D, X, ml + 5120, ldin(10) + ln * D, WSP(float, WS_MOD) + (size_t)ln * NMOD * 6144 + 1024, WSP(bf16_t, WS_XG), WSP(float, WS_SSQ), nx, (rnd == 1) ? 1 + kh : 0, part, flag};
                pg8::gemm_phase<EpiRes, RangeOrder, true, true>((LAS unsigned char*)lds, g, S, E);
                if (rnd == 1 && kh == 1) {
                    asm volatile("s_waitcnt vmcnt(0)" ::: "memory"); __syncthreads();
                    if (threadIdx.x == 0) { __builtin_amdgcn_fence(__ATOMIC_RELEASE, "agent"); asm volatile("s_waitcnt vmcnt(0)" ::: "memory"); __hip_atomic_store(flag, 1u, __ATOMIC_RELAXED, __HIP_MEMORY_SCOPE_AGENT); }
                }
            }
            if (l + 1 < DEPTH) {
                const int first = (G == 256) ? 128 : 0, nwg_t = G - first;
                if (bx >= first) {
                    const int tid = opq_tid(), lane = tid & 63, wave = __builtin_amdgcn_readfirstlane(tid >> 6);
                    const int l2 = l + 1;
                    const float *w_in = ldin(12), *w_out = ldin(22), *w1 = ldin(23), *w2 = ldin(24);
                    LAS float* scr = (LAS float*)((LAS unsigned char*)lds + wave * 17408);
                    constexpr int I_IN = 16 * 36, I_1 = 16 * 64, I_OUT = 16 * 16, I_2 = 64 * 16, I_L = I_IN + I_1 + I_OUT + I_2;
                    for (int it = (bx - first) * 8 + wave; it < I_L; it += nwg_t * 8) {
                        int r = it;
                        if (r < I_IN) { transpose_item(w_in + (size_t)l2 * D * INW, D, INW, WSP(bf16_t, WS_WIN) + (size_t)l2 * INW * D, scr, r, lane); continue; } r -= I_IN;
                        if (r < I_1) { transpose_item(w1 + (size_t)l2 * D * FF, D, FF, WSP(bf16_t, WS_W1) + (size_t)l2 * FF * D, scr, r, lane); continue; } r -= I_1;
                        if (r < I_OUT) { transpose_item(w_out + (size_t)l2 * D * D, D, D, WSP(bf16_t, WS_WOUT) + (size_t)l2 * D * D, scr, r, lane); continue; } r -= I_OUT;
                        transpose_item(w2 + (size_t)l2 * FF * D, FF, D, WSP(bf16_t, WS_W2) + (size_t)l2 * D * FF, scr, r, lane);
                    }
                }
            }
            SEAM(p0 + 5);
        }
    }
#undef IN
#undef SEAM
#undef WSP
}

extern "C" void kernel_launch(void* const* d_in, const int* in_sizes, int n_in, void* d_out, int out_size, void* d_ws, size_t ws_size, hipStream_t stream) {
    static int grid = 0;
    if (grid == 0) {
        if (n_in != 25 || ws_size < WS_END) { fprintf(stderr, "kernel_launch: need 25 inputs and >= %zu bytes of workspace; got %d, %zu\n", (size_t)WS_END, n_in, ws_size); grid = -1; return; }
        int dev = 0, cus = 0, per_cu = 0;
        hipGetDevice(&dev);
        hipDeviceGetAttribute(&cus, hipDeviceAttributeMultiprocessorCount, dev);
        if (hipFuncSetAttribute((const void*)fwd_kernel, hipFuncAttributeMaxDynamicSharedMemorySize, LDS_BYTES) != hipSuccess) { fprintf(stderr, "kernel_launch: hipFuncSetAttribute failed\n"); grid = -1; return; }
        if (hipOccupancyMaxActiveBlocksPerMultiprocessor(&per_cu, (const void*)fwd_kernel, 512, LDS_BYTES) != hipSuccess || per_cu < 1) { fprintf(stderr, "kernel_launch: occupancy query says %d\n", per_cu); per_cu = 1; }
        (void)hipGetLastError();
        grid = cus * per_cu;
    }
    if (grid < 0) return;
    if (hipMemsetAsync(d_ws, 0, 16384, stream) != hipSuccess) { fprintf(stderr, "kernel_launch: memset failed\n"); return; }
    Args a{};
    for (int i = 0; i < 25; ++i) a.in[i] = (const float*)d_in[i];
    a.out = (float*)d_out; a.ws = (unsigned char*)d_ws;
#if MK_SINGLE
    a.ph_lo = 0; a.ph_hi = NPH;
    void* args[] = {&a};
    hipError_t e = hipLaunchCooperativeKernel((const void*)fwd_kernel, dim3(grid), dim3(512), args, LDS_BYTES, stream);
    if (e != hipSuccess) fprintf(stderr, "cooperative launch failed: %s (grid %d)\n", hipGetErrorString(e), grid);
#else
    for (int ph = 0; ph < NPH; ++ph) {
        a.ph_lo = ph; a.ph_hi = ph + 1;
        hipLaunchKernelGGL(fwd_kernel, dim3(grid), dim3(512), LDS_BYTES, stream, a);
    }
#endif
}
```

```cpp
#include <hip/hip_runtime.h>
#include <hip/hip_cooperative_groups.h>
#include <cstdio>
#include <cstdint>
namespace cg = cooperative_groups;
namespace pg8 {
#define PG8_LAS __attribute__((address_space(3)))
typedef unsigned short bf16_t;
typedef short bf16x8 __attribute__((ext_vector_type(8)));
typedef float f32x4 __attribute__((ext_vector_type(4)));
typedef unsigned u32x4 __attribute__((ext_vector_type(4)));
constexpr int BM = 256, BK = 64, HALF = 128, HTB = HALF * BK * 2  , STAGE_BYTES = 8 * HTB, NXCD = 8, WGM = 8;

__host__ __device__ __forceinline__ int lds_byte(int r, int c) { const int st = (r >> 4) * 2 + (c >> 5), rr = r & 15, cc = c & 31, ob = rr * 64 + cc * 2; return st * 1024 + (ob ^ (((ob >> 9) & 1) << 5)); }
__host__ __device__ __forceinline__ void stage_rc(int b, int& R, int& C) { const int st = b / 1024, sb = b % 1024, swz = sb ^ (((sb >> 9) & 1) << 5); R = (st >> 1) * 16 + swz / 64; C = (st & 1) * 32 + (swz % 64) / 2; }
__host__ __device__ __forceinline__ int perm32(int rho) { const int n = rho >> 4, i = rho & 15; return 8 * (i >> 2) + 4 * n + (i & 3); }

struct Unit { int pm, pn; };
struct Gemm { const bf16_t* A; const bf16_t* Bt; int M, N, K, Kl; };

struct StaticOrder {
    int nM, nN, nwg, G, c;
    __host__ __device__ void init(int M, int N, int G_, int c_) { nM = M / BM; nN = N / BM; nwg = nM * nN; G = G_; c = c_; }
    __host__ __device__ bool next(int i, Unit& u) const {
        const long L = (long)i * G + c; if (L >= nwg) return false;
        int wgid = (int)L; { const int q = nwg / NXCD, r = nwg % NXCD, xcd = wgid % NXCD, off = wgid / NXCD; wgid = (xcd < r ? xcd * (q + 1) : r * (q + 1) + (xcd - r) * q) + off; }
        const int nig = WGM * nN, gid = wgid / nig, fm = gid * WGM, gsz = (nM - fm) < WGM ? (nM - fm) : WGM;
        u.pm = fm + ((wgid % nig) % gsz); u.pn = (wgid % nig) / gsz; return true;
    }
    __device__ __forceinline__ void a_ready(const Unit&) const {}
    __device__ __forceinline__ void done(const Unit&) const {}
};
__device__ __forceinline__ unsigned cvt_pk_bf16(float lo, float hi) { unsigned r; asm volatile("v_cvt_pk_bf16_f32 %0, %1, %2" : "=v"(r) : "v"(lo), "v"(hi)); return r; }
template <class Epi, class Sched, bool ALIGN_EPI = false, bool SP2 = false>
__device__ __forceinline__ void gemm_phase(PG8_LAS unsigned char* lds, const Gemm g, const Sched& S, const Epi& E) {
    int tid_ = threadIdx.x; asm volatile("" : "+v"(tid_));
    const int tid = tid_, wid = __builtin_amdgcn_readfirstlane(tid >> 6), lane = tid & 63, wr = wid >> 2, wc = wid & 3, fr = lane & 15, fq = lane >> 4;
    const int K = g.K, nt = g.Kl / BK;
    unsigned voffA[2], voffB[2];
#pragma unroll
    for (int i = 0; i < 2; ++i) { int R, C; stage_rc(tid * 16 + i * 8192, R, C); const int Rb = Epi::PERM ? ((R & ~31) + perm32(R & 31)) : R;
        voffA[i] = (unsigned)(R * K + C) * 2u; voffB[i] = (unsigned)(Rb * K + C) * 2u; }
    const size_t kstep = (size_t)(BK * 2);
    const size_t hstep = (size_t)HALF * K * 2;
    const size_t tstep = 2 * hstep;
    const unsigned ldsw = (unsigned)wid * 1024u;
    const int aoff = lds_byte(wr * 64 + fr, fq * 8), boff = lds_byte(wc * 32 + fr, fq * 8);
#define PG8_SA(b, h) (((b) * 2 + (h)) * HTB)
#define PG8_SB(b, h) ((4 + (b) * 2 + (h)) * HTB)
#define PG8_STAGE(bufoff, gbase, voff) do { _Pragma("unroll") for (int _i = 0; _i < 2; ++_i) \
        __builtin_amdgcn_global_load_lds((const unsigned*)((const char*)(gbase) + (voff)[_i]), (PG8_LAS unsigned*)(lds + (bufoff) + ldsw + _i * 8192), 16, 0, 0); } while (0)
#define PG8_LDA(dst, b, h) do { _Pragma("unroll") for (int m = 0; m < 4; ++m) _Pragma("unroll") for (int k = 0; k < 2; ++k) dst[m][k] = *(const PG8_LAS bf16x8*)(lds + PG8_SA(b, h) + aoff + m * 2048 + k * 1024); } while (0)
#define PG8_LDB(dst, b, h) do { _Pragma("unroll") for (int n = 0; n < 2; ++n) _Pragma("unroll") for (int k = 0; k < 2; ++k) dst[n][k] = *(const PG8_LAS bf16x8*)(lds + PG8_SB(b, h) + boff + n * 2048 + k * 1024); } while (0)
#define PG8_MMA(ai, bj, At, Bt) do { __builtin_amdgcn_s_setprio(1); _Pragma("unroll") for (int m = 0; m < 4; ++m) _Pragma("unroll") for (int n = 0; n < 2; ++n) _Pragma("unroll") for (int k = 0; k < 2; ++k) \
        acc[ai][bj][m][n] = __builtin_amdgcn_mfma_f32_16x16x32_bf16(Bt[n][k], At[m][k], acc[ai][bj][m][n], 0, 0, 0); __builtin_amdgcn_s_setprio(0); } while (0)
#define PG8_WAIT_V(n) asm volatile("s_waitcnt vmcnt(" #n ")" ::: "memory")
#define PG8_WAIT_L(n) asm volatile("s_waitcnt lgkmcnt(" #n ")" ::: "memory")
#define PG8_BAR __builtin_amdgcn_s_barrier()
#define PG8_SCHED __builtin_amdgcn_sched_barrier(0)
    Unit cur, nxt; int ui = 0;
    if (!S.next(0, cur)) return;
    f32x4 acc[2][2][4][2];
#pragma unroll
    for (int a = 0; a < 2; ++a)
#pragma unroll
        for (int b = 0; b < 2; ++b)
#pragma unroll
            for (int m = 0; m < 4; ++m)
#pragma unroll
                for (int n = 0; n < 2; ++n) acc[a][b][m][n] = (f32x4){0.f, 0.f, 0.f, 0.f};
    bf16x8 At[4][2], B0[2][2], B1[2][2];
    const char* cA = (const char*)g.A + (size_t)cur.pm * tstep; const char* cB = (const char*)g.Bt + (size_t)cur.pn * tstep;
    S.a_ready(cur);
    if constexpr (SP2) {
        PG8_STAGE(PG8_SB(0, 0), cB, voffB); PG8_STAGE(PG8_SB(0, 1), cB + hstep, voffB); PG8_STAGE(PG8_SA(0, 0), cA, voffA); PG8_STAGE(PG8_SA(0, 1), cA + hstep, voffA);
        if (wr == 1) PG8_BAR;
        PG8_WAIT_V(2); PG8_BAR;
        PG8_STAGE(PG8_SB(1, 0), cB + kstep, voffB); PG8_STAGE(PG8_SA(1, 0), cA + kstep, voffA); PG8_STAGE(PG8_SB(1, 1), cB + hstep + kstep, voffB);
        PG8_WAIT_V(6); PG8_BAR;
    } else {
        PG8_STAGE(PG8_SB(0, 0), cB, voffB); PG8_STAGE(PG8_SA(0, 0), cA, voffA); PG8_STAGE(PG8_SB(0, 1), cB + hstep, voffB); PG8_STAGE(PG8_SA(0, 1), cA + hstep, voffA);
        if (wr == 1) PG8_BAR;
        PG8_WAIT_V(4); PG8_BAR;
        PG8_STAGE(PG8_SB(1, 0), cB + kstep, voffB); PG8_STAGE(PG8_SA(1, 0), cA + kstep, voffA); PG8_STAGE(PG8_SB(1, 1), cB + hstep + kstep, voffB);
        PG8_WAIT_V(6); PG8_BAR;
    }
    for (;;) {
        const bool has_next = S.next(ui + 1, nxt);
        const char* nA = has_next ? (const char*)g.A + (size_t)nxt.pm * tstep : cA; const char* nB = has_next ? (const char*)g.Bt + (size_t)nxt.pn * tstep : cB;
        for (int t = 0; t < nt; t += 2) {
            const bool last = (t == nt - 2);
            const char* a1 = cA + (size_t)(t + 1) * kstep;
            const char* a2 = last ? nA : cA + (size_t)(t + 2) * kstep; const char* b2 = last ? nB : cB + (size_t)(t + 2) * kstep;
            const char* a3 = a2 + kstep; const char* b3 = b2 + kstep;
            if (last && has_next) S.a_ready(nxt);
            if constexpr (SP2) {
            PG8_LDB(B0, 0, 0); PG8_LDB(B1, 0, 1); PG8_SCHED; PG8_LDA(At, 0, 0); PG8_STAGE(PG8_SA(1, 1), a1 + hstep, voffA);
            PG8_WAIT_V(8); PG8_WAIT_L(0); PG8_BAR; PG8_MMA(0, 0, At, B0); PG8_MMA(0, 1, At, B1); PG8_BAR; PG8_SCHED;
            PG8_LDA(At, 0, 1); PG8_STAGE(PG8_SB(0, 0), b2, voffB); PG8_STAGE(PG8_SB(0, 1), b2 + hstep, voffB); PG8_STAGE(PG8_SA(0, 0), a2, voffA);
            PG8_WAIT_V(8); PG8_WAIT_L(0); PG8_BAR; PG8_MMA(1, 0, At, B0); PG8_MMA(1, 1, At, B1); PG8_BAR; PG8_SCHED;
            PG8_LDB(B0, 1, 0); PG8_LDB(B1, 1, 1); PG8_SCHED; PG8_LDA(At, 1, 0); PG8_STAGE(PG8_SA(0, 1), a2 + hstep, voffA);
            PG8_WAIT_V(8); PG8_WAIT_L(0); PG8_BAR; PG8_MMA(0, 0, At, B0); PG8_MMA(0, 1, At, B1); PG8_BAR; PG8_SCHED;
            PG8_LDA(At, 1, 1); PG8_STAGE(PG8_SB(1, 0), b3, voffB); PG8_STAGE(PG8_SB(1, 1), b3 + hstep, voffB); PG8_STAGE(PG8_SA(1, 0), a3, voffA);
            PG8_WAIT_V(8); PG8_WAIT_L(0); PG8_BAR; PG8_MMA(1, 0, At, B0); PG8_MMA(1, 1, At, B1); PG8_BAR; PG8_SCHED;
            } else {
            PG8_LDB(B0, 0, 0); PG8_SCHED; PG8_LDA(At, 0, 0); PG8_STAGE(PG8_SA(1, 1), a1 + hstep, voffA);
            PG8_WAIT_L(8); PG8_BAR; PG8_WAIT_L(0); PG8_MMA(0, 0, At, B0); PG8_BAR; PG8_SCHED;
            PG8_LDB(B1, 0, 1); PG8_STAGE(PG8_SB(0, 0), b2, voffB);
            PG8_BAR; PG8_WAIT_L(0); PG8_MMA(0, 1, At, B1); PG8_BAR;
            PG8_LDA(At, 0, 1); PG8_STAGE(PG8_SA(0, 0), a2, voffA);
            PG8_BAR; PG8_WAIT_L(0); PG8_MMA(1, 0, At, B0); PG8_BAR; PG8_SCHED;
            PG8_STAGE(PG8_SB(0, 1), b2 + hstep, voffB);
            PG8_WAIT_V(6); PG8_BAR; PG8_MMA(1, 1, At, B1); PG8_BAR;
            PG8_LDB(B0, 1, 0); PG8_SCHED; PG8_LDA(At, 1, 0); PG8_STAGE(PG8_SA(0, 1), a2 + hstep, voffA);
            PG8_WAIT_L(8); PG8_BAR; PG8_WAIT_L(0); PG8_MMA(0, 0, At, B0); PG8_BAR; PG8_SCHED;
            PG8_LDB(B1, 1, 1); PG8_STAGE(PG8_SB(1, 0), b3, voffB);
            PG8_BAR; PG8_WAIT_L(0); PG8_MMA(0, 1, At, B1); PG8_BAR;
            PG8_LDA(At, 1, 1); PG8_STAGE(PG8_SA(1, 0), a3, voffA);
            PG8_BAR; PG8_WAIT_L(0); PG8_MMA(1, 0, At, B0); PG8_BAR; PG8_SCHED;
            PG8_STAGE(PG8_SB(1, 1), b3 + hstep, voffB);
            PG8_WAIT_V(6); PG8_BAR; PG8_MMA(1, 1, At, B1); PG8_BAR;
            }
        }
        if constexpr (ALIGN_EPI) { if (wr == 0) PG8_BAR; }
        if constexpr (!Epi::AFTER_DRAIN) { E(acc, cur, wr, wc, fr, fq); S.done(cur); }
        if (!has_next) break;
#pragma unroll
        for (int a = 0; a < 2; ++a)
#pragma unroll
            for (int b = 0; b < 2; ++b)
#pragma unroll
                for (int m = 0; m < 4; ++m)
#pragma unroll
                    for (int n = 0; n < 2; ++n) acc[a][b][m][n] = (f32x4){0.f, 0.f, 0.f, 0.f};
        cur = nxt; cA = nA; cB = nB; ++ui;
        if constexpr (ALIGN_EPI) { if (wr == 1) PG8_BAR; }
    }
    PG8_WAIT_V(0);
    if constexpr (!ALIGN_EPI) { if (wr == 0) PG8_BAR; }
    PG8_BAR;
    if constexpr (Epi::AFTER_DRAIN) { E.fused(acc, cur, wr, wc, fr, fq, lds, wid, lane); S.done(cur); }
#undef PG8_SA
#undef PG8_SB
#undef PG8_STAGE
#undef PG8_LDA
#undef PG8_LDB
#undef PG8_MMA
#undef PG8_WAIT_V
#undef PG8_WAIT_L
#undef PG8_BAR
#undef PG8_SCHED
}
}

#define DI __device__ __forceinline__
#define LAS __attribute__((address_space(3)))
typedef unsigned short bf16_t;
typedef short bf16x8 __attribute__((ext_vector_type(8)));
typedef float f32x4 __attribute__((ext_vector_type(4)));
typedef float f32x16 __attribute__((ext_vector_type(16)));
typedef unsigned u32x4 __attribute__((ext_vector_type(4)));
typedef unsigned u32x2 __attribute__((ext_vector_type(2)));
typedef float f32x2_t __attribute__((ext_vector_type(2)));
typedef __bf16 bf16x2_t __attribute__((ext_vector_type(2)));

#ifndef REP_P
#define REP_P 1
#endif
#ifndef REP_G1
#define REP_G1 1
#endif
#ifndef REP_PREP
#define REP_PREP 1
#endif
#ifndef REP_ATTN
#define REP_ATTN 1
#endif
#ifndef REP_G3
#define REP_G3 1
#endif
#ifndef SYNCX
#define SYNCX 0
#endif
#ifndef MK_SINGLE
#define MK_SINGLE 1
#endif

constexpr int D = 1024, MP = 8192, MS = 16384, M = MP + MS, DEPTH = 4, NMOD = 9, INW = 2304, FF = 4096;
constexpr int NPH = 2 + 6 * DEPTH;
constexpr float QSCALE = 0.125f * 1.4426950408889634f, LOG2E = 1.4426950408889634f, EPS = 1e-6f;
constexpr size_t OFF_AK = 25165824, OFF_AV = 29360128, OFF_NK = 33554432, OFF_NV = 46137344;
constexpr size_t MiB = 1u << 20;
constexpr size_t WS_MOD = 1 * MiB, WS_BIAS1 = 2 * MiB, WS_BIAS2 = 3 * MiB, WS_SSQ = 4 * MiB;
constexpr size_t WS_KCA = 6 * MiB, WS_VCA = 8 * MiB, WS_KCN = 10 * MiB, WS_VCN = 16 * MiB;
constexpr size_t WS_WIN = 22 * MiB, WS_WOUT = 40 * MiB, WS_W1 = 48 * MiB, WS_W2 = 80 * MiB;
constexpr size_t WS_XG = 112 * MiB, WS_H1 = 160 * MiB, WS_RAW = 160 * MiB, WS_Q = 268 * MiB, WS_K = 304 * MiB, WS_VT = 328 * MiB, WS_ATT = 352 * MiB, WS_END = 400 * MiB;
constexpr int LDS_BYTES = 147456;

DI unsigned pk2(float lo, float hi) { f32x2_t v = {lo, hi}; bf16x2_t b = __builtin_convertvector(v, bf16x2_t); return __builtin_bit_cast(unsigned, b); }
DI float bflo(unsigned w) { return __uint_as_float(w << 16); }
DI float bfhi(unsigned w) { return __uint_as_float(w & 0xffff0000u); }
DI void unpack8(const u32x4 w, float (&v)[8]) { v[0] = bflo(w.x); v[1] = bfhi(w.x); v[2] = bflo(w.y); v[3] = bfhi(w.y); v[4] = bflo(w.z); v[5] = bfhi(w.z); v[6] = bflo(w.w); v[7] = bfhi(w.w); }
DI int modidx(int row) { return row < MP ? 0 : 1 + ((row - MP) >> 11); }
DI float wave_sum(float v) {
#pragma unroll
    for (int o = 1; o < 64; o <<= 1) v += __shfl_xor(v, o);
    return v;
}
DI float sigmoidf_(float x) { return 1.f / (1.f + __expf(-x)); }
DI int crow(int i, int hi) { return (i & 3) + 8 * (i >> 2) + 4 * hi; }
DI int permkey(int p) { const int s = p >> 4, hh = (p >> 3) & 1, jj = p & 7; return 16 * s + 8 * (jj >> 2) + 4 * hh + (jj & 3); }

template <int ACT> struct EpiLin {
    static constexpr bool PERM = true, AFTER_DRAIN = false;
    bf16_t* O; int ldc; const float* bias; int ldb; const float* ssq;
    DI void operator()(const f32x4 (&acc)[2][2][4][2], const pg8::Unit& u, int wr, int wc, int fr, int fq) const {
        const int row0 = u.pm * 256 + wr * 64 + fr, col0 = u.pn * 256 + wc * 32 + 8 * fq;
        const float* bp = bias + (size_t)modidx(u.pm * 256) * ldb + col0;
        f32x4 bv[2][2];
#pragma unroll
        for (int bj = 0; bj < 2; ++bj)
#pragma unroll
            for (int n = 0; n < 2; ++n) bv[bj][n] = *(const f32x4*)(bp + bj * 128 + 4 * n);
        float rs8[8];
        {
            f32x4 s4[8];
#pragma unroll
            for (int k = 0; k < 8; ++k) s4[k] = *(const f32x4*)(ssq + (size_t)(row0 + (k >> 2) * 128 + (k & 3) * 16) * 16 + 4 * fq);
#pragma unroll
            for (int k = 0; k < 8; ++k) { float s = (s4[k].x + s4[k].y) + (s4[k].z + s4[k].w); s += __shfl_xor(s, 16); s += __shfl_xor(s, 32); rs8[k] = rsqrtf(s * (1.f / 1024.f) + EPS); }
        }
#pragma unroll
        for (int ai = 0; ai < 2; ++ai)
#pragma unroll
            for (int m = 0; m < 4; ++m) {
                const int row = row0 + ai * 128 + m * 16;
                const float rstd = rs8[ai * 4 + m];
                bf16_t* rowp = O + (size_t)row * ldc + col0;
#pragma unroll
                for (int bj = 0; bj < 2; ++bj) {
                    f32x4 v0 = acc[ai][bj][m][0] * rstd + bv[bj][0], v1 = acc[ai][bj][m][1] * rstd + bv[bj][1];
                    if (ACT == 1) {
#pragma unroll
                        for (int e = 0; e < 4; ++e) { const float a = fmaxf(v0[e], 0.f), b = fmaxf(v1[e], 0.f); v0[e] = a * a; v1[e] = b * b; }
                    }
                    u32x4 w; w.x = pk2(v0[0], v0[1]); w.y = pk2(v0[2], v0[3]); w.z = pk2(v1[0], v1[1]); w.w = pk2(v1[2], v1[3]);
                    *(u32x4*)(rowp + bj * 128) = w;
                }
            }
    }
};
struct EpiRes {
    static constexpr bool PERM = false, AFTER_DRAIN = false;
    const float* baseP; const float* baseS; float* out; const float* gate; const float* nw; const float* sc; bf16_t* xg; float* ssq; int has_next;
    int mode; f32x4* part; unsigned* flag;
    DI void operator()(f32x4 (&acc)[2][2][4][2], const pg8::Unit& u, int wr, int wc, int fr, int fq) const {
        f32x4* pp = part + threadIdx.x; asm volatile("" : "+v"(pp));
        if (mode == 2) {
#pragma unroll
            for (int ai = 0; ai < 2; ++ai)
#pragma unroll
                for (int bj = 0; bj < 2; ++bj)
#pragma unroll
                    for (int m = 0; m < 4; ++m)
#pragma unroll
                        for (int n = 0; n < 2; ++n) pp[(size_t)((((ai * 2 + bj) * 4 + m) * 2 + n) * 512)] = acc[ai][bj][m][n];
            return;
        }
        if (mode == 1) {
            const unsigned long long t0 = __builtin_amdgcn_s_memrealtime();
            while ((unsigned)__builtin_amdgcn_readfirstlane(__hip_atomic_load(flag, __ATOMIC_RELAXED, __HIP_MEMORY_SCOPE_AGENT)) == 0u) {
                if (__builtin_amdgcn_s_memrealtime() - t0 > 2000000ull) break;
                __builtin_amdgcn_s_sleep(2); }
            __builtin_amdgcn_fence(__ATOMIC_ACQUIRE, "agent");
            asm volatile("s_waitcnt vmcnt(0)" ::: "memory");
#pragma unroll
            for (int ai = 0; ai < 2; ++ai)
#pragma unroll
                for (int bj = 0; bj < 2; ++bj) {
#pragma unroll
                    for (int m = 0; m < 4; ++m) {
#pragma unroll
                        for (int n = 0; n < 2; ++n) acc[ai][bj][m][n] += pp[(size_t)((((ai * 2 + bj) * 4 + m) * 2 + n) * 512)];
                        if (m & 1) asm volatile("" ::: "memory");
                    }
                }
        }
        const int col0 = u.pn * 256 + wc * 32 + 4 * fq, j = modidx(u.pm * 256);
        const float* gp = gate + (size_t)j * 6144 + col0;
        f32x4 gv[2][2], gn[2][2];
#pragma unroll
        for (int bj = 0; bj < 2; ++bj)
#pragma unroll
            for (int n = 0; n < 2; ++n) {
                gv[bj][n] = *(const f32x4*)(gp + bj * 128 + n * 16);
                if (has_next) gn[bj][n] = *(const f32x4*)(nw + col0 + bj * 128 + n * 16) * (*(const f32x4*)(sc + (size_t)j * 6144 + col0 + bj * 128 + n * 16) + 1.0f);
                else gn[bj][n] = (f32x4){0.f, 0.f, 0.f, 0.f};
            }
#pragma unroll
        for (int hp = 0; hp < 4; ++hp) {
            const int ai = hp >> 1, m0 = (hp & 1) * 2;
            f32x4 pre[2][2][2];
#pragma unroll
            for (int mm = 0; mm < 2; ++mm) {
                const int row = u.pm * 256 + ai * 128 + wr * 64 + (m0 + mm) * 16 + fr;
                const float* b = (row < MP) ? baseP + (size_t)row * D : baseS + (size_t)(row - MP) * D;
#pragma unroll
                for (int bj = 0; bj < 2; ++bj)
#pragma unroll
                    for (int n = 0; n < 2; ++n) pre[mm][bj][n] = *(const f32x4*)(b + col0 + bj * 128 + n * 16);
            }
#pragma unroll
            for (int mm = 0; mm < 2; ++mm) {
                const int m = m0 + mm;
                const int row = u.pm * 256 + ai * 128 + wr * 64 + m * 16 + fr;
                float q = 0.f;
#pragma unroll
                for (int bj = 0; bj < 2; ++bj)
#pragma unroll
                    for (int n = 0; n < 2; ++n) {
                        const int c = col0 + bj * 128 + n * 16;
                        const f32x4 x = pre[mm][bj][n] + gv[bj][n] * acc[ai][bj][m][n];
                        __builtin_nontemporal_store(x, (f32x4*)(out + (size_t)row * D + c));
                        q += (x.x * x.x + x.y * x.y) + (x.z * x.z + x.w * x.w);
                        if (has_next) { const f32x4 y = x * gn[bj][n]; u32x2 w; w.x = pk2(y.x, y.y); w.y = pk2(y.z, y.w); *(u32x2*)(xg + (size_t)row * D + c) = w; }
                    }
                q += __shfl_xor(q, 16); q += __shfl_xor(q, 32);
                if (fq == 0 && has_next) ssq[(size_t)row * 16 + u.pn * 4 + wc] = q;
            }
        }
    }
};

struct RangeOrder : pg8::StaticOrder {
    int lo, hi, fix;
    __host__ __device__ bool next(int i, pg8::Unit& u) const {
        long L;
        if (fix >= 0) { if (i > 0) return false; L = fix; } else { L = (long)lo + (long)i * G + c; if (L >= hi) return false; }
        int wgid = (int)L; { const int q = nwg / pg8::NXCD, r = nwg % pg8::NXCD, xcd = wgid % pg8::NXCD, off = wgid / pg8::NXCD; wgid = (xcd < r ? xcd * (q + 1) : r * (q + 1) + (xcd - r) * q) + off; }
        const int nig = pg8::WGM * nN, gid = wgid / nig, fm = gid * pg8::WGM, gsz = (nM - fm) < pg8::WGM ? (nM - fm) : pg8::WGM;
        u.pm = fm + ((wgid % nig) % gsz); u.pn = (wgid % nig) / gsz; return true;
    }
};

DI void transpose_item(const float* W, int K, int N, bf16_t* WT, LAS float* scr, int item, int lane) {
    const int nblk = N / 64, kb = item / nblk, nb = item - kb * nblk, k0 = 64 * kb, n0 = 64 * nb;
    const int kr = lane >> 4, nq = lane & 15;
    f32x4 v[16];
#pragma unroll
    for (int i = 0; i < 16; ++i) v[i] = *(const f32x4*)(W + (size_t)(k0 + 4 * i + kr) * N + n0 + 4 * nq);
#pragma unroll
    for (int i = 0; i < 16; ++i) { LAS float* d = scr + (4 * i + kr) * 65 + 4 * nq; d[0] = v[i].x; d[1] = v[i].y; d[2] = v[i].z; d[3] = v[i].w; }
    asm volatile("s_waitcnt lgkmcnt(0)" ::: "memory");
    const int c = lane & 7;
#pragma unroll
    for (int j = 0; j < 8; ++j) { const int n = (lane >> 3) + 8 * j; const LAS float* s = scr + (8 * c) * 65 + n;
        u32x4 o; o.x = pk2(s[0 * 65], s[1 * 65]); o.y = pk2(s[2 * 65], s[3 * 65]); o.z = pk2(s[4 * 65], s[5 * 65]); o.w = pk2(s[6 * 65], s[7 * 65]);
        *(u32x4*)(WT + (size_t)(n0 + n) * K + k0 + 8 * c) = o; }
    asm volatile("s_waitcnt lgkmcnt(0)" ::: "memory");
}
DI void gemv9_unit(const float* W, int N, int n0, const float* v0, const float* v1, int vs, bool do_silu, const float* badd, float* out, int ostride, float* scr, int tid) {
    const int wave = __builtin_amdgcn_readfirstlane(tid >> 6), lane = tid & 63;
    float* sv = scr; float* red = scr + NMOD * 1024;
    for (int idx = tid; idx < NMOD * 1024; idx += 512) {
        const int j = idx >> 10, k = idx & 1023;
        float v = (j == 0) ? v0[k] : v1[(size_t)(j - 1) * vs + k];
        if (do_silu) v = v * sigmoidf_(v);
        sv[idx] = v;
    }
    __syncthreads();
    float acc[NMOD];
#pragma unroll
    for (int j = 0; j < NMOD; ++j) acc[j] = 0.f;
    const float* wp = W + (size_t)(wave * 128) * N + n0 + lane;
#pragma unroll 2
    for (int k = 0; k < 128; k += 4) {
        const float w0 = wp[(size_t)k * N], w1 = wp[(size_t)(k + 1) * N], w2 = wp[(size_t)(k + 2) * N], w3 = wp[(size_t)(k + 3) * N];
#pragma unroll
        for (int j = 0; j < NMOD; ++j) {
            const f32x4 s = *(const f32x4*)(sv + j * 1024 + wave * 128 + k);
            acc[j] += (s.x * w0 + s.y * w1) + (s.z * w2 + s.w * w3);
        }
    }
#pragma unroll
    for (int j = 0; j < NMOD; ++j) red[(wave * NMOD + j) * 64 + lane] = acc[j];
    __syncthreads();
    for (int idx = tid; idx < NMOD * 64; idx += 512) {
        const int j = idx >> 6, ln = idx & 63; float s = 0.f;
#pragma unroll
        for (int w = 0; w < 8; ++w) s += red[(w * NMOD + j) * 64 + ln];
        if (badd) s += badd[n0 + ln];
        out[(size_t)j * ostride + n0 + ln] = s;
    }
    __syncthreads();
}

DI void conv_unit(int ct, int l, const bf16_t* RAW, bf16_t* ATT, const float* dw_w, const float* dw_b, const float* ln_g, const float* ln_b, float* lds, int tid) {
    const int row0 = ct * 64;
    int seq0, L;
    if (row0 < MP) { seq0 = row0 & ~255; L = 256; } else { seq0 = MP + ((row0 - MP) & ~2047); L = 2048; }
    const int t0 = row0 - seq0;
    {
        u32x4 wa[6], wg[6];
#pragma unroll
        for (int i = 0; i < 6; ++i) {
            const int it = tid + 512 * i, rr = it >> 5, c8 = it & 31, t = t0 - 15 + rr;
            if (it < 94 * 32 && t >= 0 && t < L) { const bf16_t* p = RAW + (size_t)(seq0 + t) * INW + c8 * 8; wa[i] = *(const u32x4*)p; wg[i] = *(const u32x4*)(p + 256); }
            else { wa[i] = (u32x4){0u, 0u, 0u, 0u}; wg[i] = (u32x4){0u, 0u, 0u, 0u}; }
        }
#pragma unroll
        for (int i = 0; i < 6; ++i) {
            const int it = tid + 512 * i, rr = it >> 5, c8 = it & 31;
            if (it < 94 * 32) {
                float a[8], g[8], hv[8]; unpack8(wa[i], a); unpack8(wg[i], g);
#pragma unroll
                for (int e2 = 0; e2 < 8; ++e2) hv[e2] = a[e2] * sigmoidf_(g[e2]);
                float* d = lds + rr * 256 + c8 * 8;
                *(f32x4*)d = (f32x4){hv[0], hv[1], hv[2], hv[3]}; *(f32x4*)(d + 4) = (f32x4){hv[4], hv[5], hv[6], hv[7]};
            }
        }
    }
    __syncthreads();
    const int c = tid & 255, th = tid >> 8;
    float w[31];
#pragma unroll
    for (int k = 0; k < 31; ++k) w[k] = dw_w[(size_t)(l * 31 + k) * 256 + c];
    const float bias = dw_b[l * 256 + c];
    float outv[32];
#pragma unroll
    for (int ch = 0; ch < 2; ++ch) {
        float hv[46];
#pragma unroll
        for (int i = 0; i < 46; ++i) hv[i] = lds[(th * 32 + ch * 16 + i) * 256 + c];
#pragma unroll
        for (int o = 0; o < 16; ++o) {
            float s = bias;
#pragma unroll
            for (int k = 0; k < 31; ++k) s += hv[o + k] * w[k];
            outv[ch * 16 + o] = s;
        }
    }
    __syncthreads();
#pragma unroll
    for (int o = 0; o < 32; ++o) lds[(th * 32 + o) * 256 + c] = outv[o];
    __syncthreads();
    const int wave = tid >> 6, lane = tid & 63;
    const f32x4 g4 = *(const f32x4*)(ln_g + l * 256 + 4 * lane), b4 = *(const f32x4*)(ln_b + l * 256 + 4 * lane);
#pragma unroll
    for (int i = 0; i < 8; ++i) {
        const int tk = wave * 8 + i;
        const f32x4 v = *(const f32x4*)(lds + tk * 256 + 4 * lane);
        const float mean = wave_sum((v.x + v.y) + (v.z + v.w)) * (1.f / 256.f);
        const f32x4 dv = v - mean;
        const float var = wave_sum((dv.x * dv.x + dv.y * dv.y) + (dv.z * dv.z + dv.w * dv.w)) * (1.f / 256.f);
        const float rstd = rsqrtf(var + EPS);
        f32x4 y = dv * rstd * g4 + b4;
        y.x *= sigmoidf_(y.x); y.y *= sigmoidf_(y.y); y.z *= sigmoidf_(y.z); y.w *= sigmoidf_(y.w);
        u32x2 o; o.x = pk2(y.x, y.y); o.y = pk2(y.z, y.w);
        *(u32x2*)(ATT + (size_t)(row0 + tk) * D + 4 * lane) = o;
    }
    __syncthreads();
}

struct PrepP { const bf16_t* RAW; bf16_t* Q; bf16_t* K; bf16_t* VT; float* out; const float *aqg, *akg, *nqg, *nkg; };
DI void qkv_unit(int ct, int l, const PrepP& P, bf16_t* ldsv, int tid) {
    const int row0 = ct * 64;
    const bool prompt = row0 < MP;
    int seq0, L, sb;
    if (prompt) { seq0 = row0 & ~255; L = 256; sb = row0 >> 8; } else { seq0 = MP + ((row0 - MP) & ~2047); L = 2048; sb = (row0 - MP) >> 11; }
    const int t0 = row0 - seq0;
    {
    const int lane = tid & 63, wave = __builtin_amdgcn_readfirstlane(tid >> 6), half = lane >> 5;
    for (int wi = wave; wi < 40; wi += 8) {
        const int hd = wi >> 1, tok = (wi & 1) * 32 + (lane & 31);
        const int row = row0 + tok, t = t0 + tok;
        int rcol; const float* gw; bool isq;
        if (hd < 6) { rcol = 512 + 64 * hd; gw = P.aqg; isq = true; }
        else if (hd < 8) { rcol = 896 + 64 * (hd - 6); gw = P.akg; isq = false; }
        else if (hd < 14) { rcol = 1152 + 64 * (hd - 8); gw = P.nqg; isq = true; }
        else { rcol = 1536 + 64 * (hd - 14); gw = P.nkg; isq = false; }
        float v[32];
        const bf16_t* rp = P.RAW + (size_t)row * INW + rcol + 32 * half;
#pragma unroll
        for (int c = 0; c < 4; ++c) { const u32x4 wv = *(const u32x4*)(rp + 8 * c); float tmp[8]; unpack8(wv, tmp);
#pragma unroll
            for (int e2 = 0; e2 < 8; ++e2) v[8 * c + e2] = tmp[e2]; }
        float ss = 0.f;
#pragma unroll
        for (int d = 0; d < 32; ++d) ss += v[d] * v[d];
        ss += __shfl_xor(ss, 32);
        const float rstd = rsqrtf(ss * (1.f / 64.f) + EPS);
        const float* gp = gw + l * 64 + 32 * half;
#pragma unroll
        for (int c4 = 0; c4 < 8; ++c4) { const f32x4 g4 = *(const f32x4*)(gp + 4 * c4); v[4 * c4] *= rstd * g4.x; v[4 * c4 + 1] *= rstd * g4.y; v[4 * c4 + 2] *= rstd * g4.z; v[4 * c4 + 3] *= rstd * g4.w; }
        if ((!prompt) && (hd < 8)) {
            const float pos = (float)(half ? (t & 63) : (t >> 6));
#pragma unroll
            for (int j = 0; j < 16; ++j) {
                const float inv = exp2f(-(float)j * 0.8304820237218406f);
                float sn, cs; __sincosf(pos * inv, &sn, &cs);
                const float a = v[j], b = v[16 + j];
                v[j] = a * cs - b * sn; v[16 + j] = b * cs + a * sn;
            }
        }
        if (isq) {
            const int qh = (hd < 6) ? hd : 6 + (hd - 8);
            bf16_t* qp = P.Q + (prompt ? ((size_t)(sb * 12 + qh) * 8 + (t >> 5)) * 2048 : (size_t)MP * 768 + ((size_t)(sb * 12 + qh) * 64 + (t >> 5)) * 2048) + (t & 31) * 8 + half * 1024;
#pragma unroll
            for (int c = 0; c < 4; ++c) {
                u32x4 o; o.x = pk2(v[8 * c] * QSCALE, v[8 * c + 1] * QSCALE); o.y = pk2(v[8 * c + 2] * QSCALE, v[8 * c + 3] * QSCALE);
                o.z = pk2(v[8 * c + 4] * QSCALE, v[8 * c + 5] * QSCALE); o.w = pk2(v[8 * c + 6] * QSCALE, v[8 * c + 7] * QSCALE);
                *(u32x4*)(qp + c * 256) = o;
            }
        } else {
            const int kh = (hd < 8) ? (hd - 6) : 2 + (hd - 14);
            bf16_t* kp = P.K + (prompt ? ((size_t)(sb * 8 + kh) * 8 + (t >> 5)) * 2048 : (size_t)MP * 512 + ((size_t)(sb * 8 + kh) * 64 + (t >> 5)) * 2048) + (t & 31) * 8 + half * 1024;
#pragma unroll
            for (int c = 0; c < 4; ++c) {
                u32x4 o; o.x = pk2(v[8 * c], v[8 * c + 1]); o.y = pk2(v[8 * c + 2], v[8 * c + 3]); o.z = pk2(v[8 * c + 4], v[8 * c + 5]); o.w = pk2(v[8 * c + 6], v[8 * c + 7]);
                *(u32x4*)(kp + c * 256) = o;
            }
            if (prompt) {
                float* op;
                if (hd < 8) op = P.out + OFF_AK + ((((size_t)sb * 4 + l) * 256 + t) * 2 + (hd - 6)) * 64 + 32 * half;
                else        op = P.out + OFF_NK + ((((size_t)sb * 4 + l) * 256 + t) * 6 + (hd - 14)) * 64 + 32 * half;
#pragma unroll
                for (int c4 = 0; c4 < 8; ++c4) *(f32x4*)(op + 4 * c4) = (f32x4){v[4 * c4], v[4 * c4 + 1], v[4 * c4 + 2], v[4 * c4 + 3]};
            }
        }
    }
    }
    {
        u32x4 wv8[8];
#pragma unroll
        for (int i = 0; i < 8; ++i) {
            const int it = tid + 512 * i, tok = it >> 6, cc = (it & 63) * 8, rcol = (cc < 128) ? 1024 + cc : 1920 + (cc - 128);
            wv8[i] = *(const u32x4*)(P.RAW + (size_t)(row0 + tok) * INW + rcol);
        }
#pragma unroll
        for (int i = 0; i < 8; ++i) {
            const int it = tid + 512 * i, tok = it >> 6, cc = (it & 63) * 8;
            const u32x4 wv = wv8[i];
            *(u32x4*)(ldsv + tok * 512 + cc) = wv;
            if (prompt) {
                float v[8]; unpack8(wv, v);
                const int t = t0 + tok; float* op;
                if (cc < 128) op = P.out + OFF_AV + (((size_t)sb * 4 + l) * 256 + t) * 128 + cc;
                else          op = P.out + OFF_NV + (((size_t)sb * 4 + l) * 256 + t) * 384 + (cc - 128);
                *(f32x4*)op = (f32x4){v[0], v[1], v[2], v[3]}; *(f32x4*)(op + 4) = (f32x4){v[4], v[5], v[6], v[7]};
            }
        }
    }
    __syncthreads();
    for (int it = tid; it < 512 * 8; it += 512) {
        const int hd_d = it & 511, g = it >> 9;
        unsigned short e[8];
#pragma unroll
        for (int jj = 0; jj < 8; ++jj) { const int p = 8 * g + jj; const int key = (p & ~31) + permkey(p & 31); e[jj] = ldsv[key * 512 + hd_d]; }
        u32x4 o; o.x = e[0] | ((unsigned)e[1] << 16); o.y = e[2] | ((unsigned)e[3] << 16); o.z = e[4] | ((unsigned)e[5] << 16); o.w = e[6] | ((unsigned)e[7] << 16);
        const int vh = hd_d >> 6, dd = hd_d & 63, tile = (t0 >> 5) + (g >> 2);
        const size_t base = prompt ? ((size_t)(sb * 8 + vh) * 8 + tile) * 2048 : (size_t)MP * 512 + ((size_t)(sb * 8 + vh) * 64 + tile) * 2048;
        *(u32x4*)(P.VT + base + ((((dd >> 5) * 2 + ((g >> 1) & 1)) * 2 + (g & 1)) * 32 + (dd & 31)) * 8) = o;
    }
    __syncthreads();
}

struct Seg { const bf16_t* k; const bf16_t* v; int nt; };
#define MFMA32(a, b, c) __builtin_amdgcn_mfma_f32_32x32x16_bf16((a), (b), (c), 0, 0, 0)
DI void issue_tile(const Seg& A, const Seg& B, int t, int lane, LAS unsigned char* slot) {
    const bf16_t* kp = (t < A.nt) ? A.k + (size_t)t * 2048 : B.k + (size_t)(t - A.nt) * 2048;
    const bf16_t* vp = (t < A.nt) ? A.v + (size_t)t * 2048 : B.v + (size_t)(t - A.nt) * 2048;
#pragma unroll
    for (int i = 0; i < 4; ++i) __builtin_amdgcn_global_load_lds((const unsigned*)(kp + i * 512 + lane * 8), (LAS unsigned*)(slot + i * 1024), 16, 0, 0);
#pragma unroll
    for (int i = 0; i < 4; ++i) __builtin_amdgcn_global_load_lds((const unsigned*)(vp + i * 512 + lane * 8), (LAS unsigned*)(slot + 4096 + i * 1024), 16, 0, 0);
}
template <bool NA, int NQB> DI void attn_wave(const bf16_t* Qp, const Seg A, const Seg B, bf16_t* Op, const float* rpbh, int r, int rs, int lane_, LAS unsigned char* ring, LAS float* biasl, int qoff) {
    int lane = lane_; asm volatile("" : "+v"(lane));
    const int r32 = lane & 31, hi = lane >> 5;
    const int nt = A.nt + B.nt;
    issue_tile(A, B, 0, lane, ring);
    issue_tile(A, B, 1, lane, ring + 8192);
    if (NA) { for (int i = lane; i < 15 * 31; i += 64) biasl[i] = rpbh[i] * LOG2E; }
    bf16x8 qf[NQB][4];
#pragma unroll
    for (int qb = 0; qb < NQB; ++qb)
#pragma unroll
        for (int kk = 0; kk < 4; ++kk) qf[qb][kk] = *(const bf16x8*)(Qp + (qoff + qb) * 2048 + kk * 512 + lane * 8);
    f32x16 o[NQB][2];
#pragma unroll
    for (int a = 0; a < NQB; ++a)
#pragma unroll
        for (int b = 0; b < 2; ++b)
#pragma unroll
            for (int i = 0; i < 16; ++i) o[a][b][i] = 0.f;
    float mrun[NQB], lrun[NQB];
#pragma unroll
    for (int a = 0; a < NQB; ++a) { mrun[a] = -1e30f; lrun[a] = 0.f; }
    asm volatile("s_waitcnt vmcnt(0)" ::: "memory");
#pragma nounroll
    for (int t = 0; t < nt; ++t) {
        LAS unsigned char* slot = ring + (t & 1) * 8192;
        if (t + 1 < nt) asm volatile("s_waitcnt vmcnt(8)" ::: "memory"); else asm volatile("s_waitcnt vmcnt(0)" ::: "memory");
        bf16x8 kf[4], vf[2][2];
#pragma unroll
        for (int kk = 0; kk < 4; ++kk) kf[kk] = *(const LAS bf16x8*)(slot + kk * 1024 + lane * 16);
#pragma unroll
        for (int db = 0; db < 2; ++db)
#pragma unroll
            for (int s2 = 0; s2 < 2; ++s2) vf[db][s2] = *(const LAS bf16x8*)(slot + 4096 + (db * 2 + s2) * 1024 + lane * 16);
        asm volatile("s_waitcnt lgkmcnt(0)" ::: "memory");
        if (t + 2 < nt) issue_tile(A, B, t + 2, lane, slot);
#pragma unroll
        for (int qb = 0; qb < NQB; ++qb) {
            f32x16 s;
#pragma unroll
            for (int i = 0; i < 16; ++i) s[i] = 0.f;
#pragma unroll
            for (int kk = 0; kk < 4; ++kk) s = MFMA32(kf[kk], qf[qb][kk], s);
            if (NA) {
                if (t < A.nt) {
                    const int a = t >> 1, half = t & 1;
                    const int qc = 32 * (qoff + qb) + r32, cs = min(max(qc - 8, 0), 48);
                    const int kc0 = 32 * half + 4 * hi;
                    const LAS float* bp = biasl + (rs + a - r + 7) * 31 + (kc0 - qc + 15);
                    const unsigned u0 = (unsigned)(kc0 - cs);
                    float bia[16];
#pragma unroll
                    for (int i = 0; i < 16; ++i) bia[i] = bp[(i & 3) + 8 * (i >> 2)];
                    asm volatile("" : "+v"(bia[0]), "+v"(bia[1]), "+v"(bia[2]), "+v"(bia[3]), "+v"(bia[4]), "+v"(bia[5]), "+v"(bia[6]), "+v"(bia[7]),
                                      "+v"(bia[8]), "+v"(bia[9]), "+v"(bia[10]), "+v"(bia[11]), "+v"(bia[12]), "+v"(bia[13]), "+v"(bia[14]), "+v"(bia[15]));
#pragma unroll
                    for (int i = 0; i < 16; ++i) {
                        const bool valid = (u0 + (unsigned)((i & 3) + 8 * (i >> 2))) < 16u;
                        s[i] = valid ? s[i] + bia[i] : -1e30f;
                    }
                }
            }
            float ps = 0.f;
#pragma unroll
            for (int i = 0; i < 16; ++i) { const float p = __builtin_amdgcn_exp2f(s[i]); s[i] = p; ps += p; }
            lrun[qb] += ps;
            u32x4 p0, p1;
            p0.x = pk2(s[0], s[1]); p0.y = pk2(s[2], s[3]); p0.z = pk2(s[4], s[5]); p0.w = pk2(s[6], s[7]);
            p1.x = pk2(s[8], s[9]); p1.y = pk2(s[10], s[11]); p1.z = pk2(s[12], s[13]); p1.w = pk2(s[14], s[15]);
            const bf16x8 P0 = __builtin_bit_cast(bf16x8, p0), P1 = __builtin_bit_cast(bf16x8, p1);
#pragma unroll
            for (int db = 0; db < 2; ++db) { o[qb][db] = MFMA32(vf[db][0], P0, o[qb][db]); o[qb][db] = MFMA32(vf[db][1], P1, o[qb][db]); }
        }
    }
#pragma unroll
    for (int qb = 0; qb < NQB; ++qb) {
        const float lt = lrun[qb] + __shfl_xor(lrun[qb], 32);
        const float inv = 1.f / lt;
        bf16_t* orow = Op + (size_t)(32 * (qoff + qb) + r32) * D;
#pragma unroll
        for (int db = 0; db < 2; ++db)
#pragma unroll
            for (int g = 0; g < 4; ++g) {
                u32x2 w; w.x = pk2(o[qb][db][4 * g] * inv, o[qb][db][4 * g + 1] * inv); w.y = pk2(o[qb][db][4 * g + 2] * inv, o[qb][db][4 * g + 3] * inv);
                *(u32x2*)(orow + 32 * db + 8 * g + 4 * hi) = w;
            }
    }
}

DI void attn_wave_shared(const bf16_t* Qp, const Seg A, const Seg B, bf16_t* Op, int lane_, int wave, LAS unsigned char* ring) {
    int lane = lane_; asm volatile("" : "+v"(lane));
    const int r32 = lane & 31, hi = lane >> 5;
    const int nt = A.nt + B.nt;
    const bool isk = wave < 4;
    const int poff = (isk ? wave : wave - 4) * 512;
    const int loff = isk ? wave * 1024 : 4096 + (wave - 4) * 1024;
    const bf16_t* srcA = (isk ? A.k : A.v) + poff + lane * 8;
    const bf16_t* srcB = (isk ? B.k : B.v) + poff + lane * 8;
#define ISSUE_PIECE(tt) do { const int t_ = (tt); const bf16_t* src_ = (t_ < A.nt) ? srcA + (size_t)t_ * 2048 : srcB + (size_t)(t_ - A.nt) * 2048; \
        __builtin_amdgcn_global_load_lds((const unsigned*)src_, (LAS unsigned*)(ring + (t_ & 15) * 8192 + loff), 16, 0, 0); } while (0)
    bf16x8 qf[2][4];
#pragma unroll
    for (int qb = 0; qb < 2; ++qb)
#pragma unroll
        for (int kk = 0; kk < 4; ++kk) qf[qb][kk] = *(const bf16x8*)(Qp + qb * 2048 + kk * 512 + lane * 8);
    asm volatile("s_waitcnt vmcnt(0) lgkmcnt(0)" ::: "memory");
#pragma unroll
    for (int tt = 0; tt < 8; ++tt) ISSUE_PIECE(tt);
    f32x16 o[2][2];
#pragma unroll
    for (int a = 0; a < 2; ++a)
#pragma unroll
        for (int b = 0; b < 2; ++b)
#pragma unroll
            for (int i = 0; i < 16; ++i) o[a][b][i] = 0.f;
    float mrun[2] = {-1e30f, -1e30f}, lrun[2] = {0.f, 0.f};
#pragma nounroll
    for (int t = 0; t < nt; ++t) {
        if ((t & 7) == 0) {
            asm volatile("s_waitcnt vmcnt(0) lgkmcnt(0)\n\ts_barrier" ::: "memory");
            if (t + 8 < nt) {
#pragma unroll
                for (int tt = 0; tt < 8; ++tt) ISSUE_PIECE(t + 8 + tt);
            }
            if (((wave ^ (wave >> 2)) & 1) != 0) __builtin_amdgcn_s_sleep(19);
        }
        LAS unsigned char* slot = ring + (t & 15) * 8192;
        bf16x8 kf[4], vf[2][2];
#pragma unroll
        for (int kk = 0; kk < 4; ++kk) kf[kk] = *(const LAS bf16x8*)(slot + kk * 1024 + lane * 16);
#pragma unroll
        for (int db = 0; db < 2; ++db)
#pragma unroll
            for (int s2 = 0; s2 < 2; ++s2) vf[db][s2] = *(const LAS bf16x8*)(slot + 4096 + (db * 2 + s2) * 1024 + lane * 16);
        asm volatile("s_waitcnt lgkmcnt(0)" ::: "memory");
#pragma unroll
        for (int qb = 0; qb < 2; ++qb) {
            f32x16 s;
#pragma unroll
            for (int i = 0; i < 16; ++i) s[i] = 0.f;
#pragma unroll
            for (int kk = 0; kk < 4; ++kk) s = MFMA32(kf[kk], qf[qb][kk], s);
            float ps = 0.f;
#pragma unroll
            for (int i = 0; i < 16; ++i) { const float p = __builtin_amdgcn_exp2f(s[i]); s[i] = p; ps += p; }
            lrun[qb] += ps;
            u32x4 p0, p1;
            p0.x = pk2(s[0], s[1]); p0.y = pk2(s[2], s[3]); p0.z = pk2(s[4], s[5]); p0.w = pk2(s[6], s[7]);
            p1.x = pk2(s[8], s[9]); p1.y = pk2(s[10], s[11]); p1.z = pk2(s[12], s[13]); p1.w = pk2(s[14], s[15]);
            const bf16x8 P0 = __builtin_bit_cast(bf16x8, p0), P1 = __builtin_bit_cast(bf16x8, p1);
#pragma unroll
            for (int db = 0; db < 2; ++db) { o[qb][db] = MFMA32(vf[db][0], P0, o[qb][db]); o[qb][db] = MFMA32(vf[db][1], P1, o[qb][db]); }
        }
    }
#undef ISSUE_PIECE
#pragma unroll
    for (int qb = 0; qb < 2; ++qb) {
        const float lt = lrun[qb] + __shfl_xor(lrun[qb], 32);
        const float inv = 1.f / lt;
        bf16_t* orow = Op + (size_t)(32 * qb + r32) * D;
#pragma unroll
        for (int db = 0; db < 2; ++db)
#pragma unroll
            for (int g = 0; g < 4; ++g) {
                u32x2 w; w.x = pk2(o[qb][db][4 * g] * inv, o[qb][db][4 * g + 1] * inv); w.y = pk2(o[qb][db][4 * g + 2] * inv, o[qb][db][4 * g + 3] * inv);
                *(u32x2*)(orow + 32 * db + 8 * g + 4 * hi) = w;
            }
    }
    asm volatile("s_waitcnt vmcnt(0) lgkmcnt(0)\n\ts_barrier" ::: "memory");
}

struct AttnP { const bf16_t *Q, *K, *VT, *KCA, *VCA, *KCN, *VCN; bf16_t* ATT; const float* rpb; };
DI void attn_run_unit(int uid, int qsel, int l, const AttnP& P, int lane, LAS unsigned char* ring, LAS float* biasl, bool shared, int wave, LAS unsigned char* lds0) {
    const size_t QS = (size_t)MP * 768, KS = (size_t)MP * 512;
    Seg A, B{nullptr, nullptr, 0}; const bf16_t* Qp; bf16_t* Op; const float* rp = nullptr; int r = 0, rs = 0; bool na = false;
    if (uid < 1536) {
        const int qc = uid & 31, bh = uid >> 5, b = bh / 6, h = bh - 6 * b, kvh = h / 3;
        const int row0 = MP + b * 2048;
        A = Seg{P.K + KS + (size_t)(b * 8 + kvh) * 64 * 2048, P.VT + KS + (size_t)(b * 8 + kvh) * 64 * 2048, 64};
        B = Seg{P.KCA + (size_t)((b * 4 + l) * 2 + kvh) * 16384, P.VCA + (size_t)((b * 4 + l) * 2 + kvh) * 16384, 8};
        Qp = P.Q + QS + ((size_t)(b * 12 + h) * 64 + 2 * qc) * 2048; Op = P.ATT + (size_t)(row0 + qc * 64) * D + 256 + h * 64;
    } else if (uid < 3072) {
        const int u = uid - 1536, bh = u >> 5, b = bh / 6, h = bh - 6 * b;
        r = u & 31; rs = min(max(r - 4, 0), 24); na = true;
        const int row0 = MP + b * 2048;
        A = Seg{P.K + KS + ((size_t)(b * 8 + 2 + h) * 64 + 2 * rs) * 2048, P.VT + KS + ((size_t)(b * 8 + 2 + h) * 64 + 2 * rs) * 2048, 16};
        B = Seg{P.KCN + (size_t)((b * 4 + l) * 6 + h) * 16384, P.VCN + (size_t)((b * 4 + l) * 6 + h) * 16384, 8};
        Qp = P.Q + QS + ((size_t)(b * 12 + 6 + h) * 64 + 2 * r) * 2048; Op = P.ATT + (size_t)(row0 + r * 64) * D + 640 + h * 64;
        rp = P.rpb + (size_t)(l * 6 + h) * 15 * 31;
    } else {
        const int nah = uid >= 3840;
        const int u = uid - (nah ? 3840 : 3072), qc = u & 3, bh = u >> 2, b = bh / 6, h = bh - 6 * b, kh = nah ? 2 + h : h / 3;
        const int row0 = b * 256;
        A = Seg{P.K + (size_t)(b * 8 + kh) * 8 * 2048, P.VT + (size_t)(b * 8 + kh) * 8 * 2048, 8};
        Qp = P.Q + ((size_t)(b * 12 + (nah ? 6 : 0) + h) * 8 + 2 * qc) * 2048; Op = P.ATT + (size_t)(row0 + qc * 64) * D + (nah ? 640 : 256) + h * 64;
    }
    if (na) { if (qsel == 2) attn_wave<true, 2>(Qp, A, B, Op, rp, r, rs, lane, ring, biasl, 0); else attn_wave<true, 1>(Qp, A, B, Op, rp, r, rs, lane, ring, biasl, qsel); }
    else if (shared) attn_wave_shared(Qp, A, B, Op, lane, wave, lds0);
    else attn_wave<false, 2>(Qp, A, B, Op, rp, r, rs, lane, ring, biasl, 0);
}

struct Args {
    const float* in[25]; float* out; unsigned char* ws; int ph_lo, ph_hi;
};
#define XB_TMO      128
#define XB_XCNT(j)  (256  + 64 * (j))
#define XB_XSUB(j)  (1280 + 64 * (j))
#define XB_XGEN(j)  (2304 + 64 * (j))
#define XB_TOP      3328
#define XB_TOPGEN   3392
#define XCD_BAR_WORDS 3456
#define XB_SPIN_CAP (1u << 18)

__device__ __forceinline__ unsigned xb_ld(unsigned* p)              { return __hip_atomic_load(p, __ATOMIC_RELAXED, __HIP_MEMORY_SCOPE_AGENT); }
__device__ __forceinline__ unsigned xb_add(unsigned* p, unsigned v) { return __hip_atomic_fetch_add(p, v, __ATOMIC_RELAXED, __HIP_MEMORY_SCOPE_AGENT); }
__device__ __forceinline__ unsigned xb_xcc_id() { return (unsigned)__builtin_amdgcn_s_getreg((3 << 11) | 20) & 0xFu; }
#define XB_SPIN(cond, bar) do { unsigned _sp = 0; while (cond) { __builtin_amdgcn_s_sleep(1); \
    if ((++_sp & 255u) == 0u) { if (xb_ld(&(bar)[XB_TMO])) break; if (_sp > XB_SPIN_CAP) { atomicAdd(&(bar)[XB_TMO], 1u); break; } } } } while (0)

struct XcdBarrier {
    unsigned* bar; unsigned x;
    volatile LAS unsigned* st;
};

__device__ __forceinline__ XcdBarrier xcd_barrier_post(unsigned* bar, volatile LAS unsigned* st) {
    XcdBarrier b; b.bar = bar; b.x = xb_xcc_id(); b.st = st;
    if (threadIdx.x == 0) { const unsigned old_ = xb_add(&bar[XB_XCNT(b.x)], 1u); st[2] = old_; st[3] = b.x; }
    return b;
}
__device__ __forceinline__ void xcd_barrier_complete(unsigned* bar, unsigned x, unsigned& nloc, unsigned& nx) {
    const unsigned G = gridDim.x * gridDim.y * gridDim.z;
    unsigned sum, cnt, mine, sp = 0u;
    for (;;) {
        sum = 0u; cnt = 0u; mine = 0u;
#pragma unroll
        for (unsigned j = 0; j < 16; ++j) { const unsigned c = xb_ld(&bar[XB_XCNT(j)]); sum += c; cnt += (c > 0u) ? 1u : 0u; mine = (j == x) ? c : mine; }
        if (sum == G) break;
        __builtin_amdgcn_s_sleep(1);
        if ((++sp & 255u) == 0u) { if (xb_ld(&bar[XB_TMO])) break; if (sp > XB_SPIN_CAP) { atomicAdd(&bar[XB_TMO], 1u); break; } }
    }
    nloc = mine > 0u ? mine : 1u; nx = cnt > 0u ? cnt : 1u;
}

__device__ __forceinline__ void xcd_barrier(const XcdBarrier& b) {
    asm volatile("s_waitcnt vmcnt(0)" ::: "memory");
    __syncthreads();
    if (threadIdx.x == 0) {
        unsigned* bar = b.bar; asm volatile("" : "+v"(bar));
        __builtin_amdgcn_s_waitcnt(0);
        unsigned nloc = b.st[0], nx = b.st[1];
        if (nloc == 0u) { xcd_barrier_complete(bar, b.x, nloc, nx); b.st[0] = nloc; b.st[1] = nx; }
        const unsigned old = xb_add(&bar[XB_XSUB(b.x)], 1u);
        const unsigned gen = old / nloc;
        if (old + 1u == (gen + 1u) * nloc) {
            __builtin_amdgcn_fence(__ATOMIC_RELEASE, "agent");
            asm volatile("s_waitcnt vmcnt(0)" ::: "memory");
            const unsigned og = xb_add(&bar[XB_TOP], 1u);
            const unsigned tg = og / nx;
            if (og + 1u == (tg + 1u) * nx) xb_add(&bar[XB_TOPGEN], 1u);
            else XB_SPIN(xb_ld(&bar[XB_TOPGEN]) == tg, bar);
            __builtin_amdgcn_fence(__ATOMIC_ACQUIRE, "agent");
            xb_add(&bar[XB_XGEN(b.x)], 1u);
            asm volatile("s_waitcnt vmcnt(0)" ::: "memory");
        } else {
            XB_SPIN(xb_ld(&bar[XB_XGEN(b.x)]) == gen, bar);
            __builtin_amdgcn_fence(__ATOMIC_ACQUIRE, "agent");
            asm volatile("s_waitcnt vmcnt(0)" ::: "memory");
        }
    }
    __syncthreads();
}

typedef const __attribute__((address_space(4))) char* kargp_t;
DI const float* ldin(int i) { kargp_t kp = (kargp_t)__builtin_amdgcn_kernarg_segment_ptr(); asm volatile("" : "+s"(kp)); return (const float*)(*(const __attribute__((address_space(4))) unsigned long long*)(kp + 8 * i)); }
DI float* ldout() { return (float*)ldin(25); }
DI unsigned char* ldws() { return (unsigned char*)ldin(26); }
DI int opq_tid() { int t = threadIdx.x; asm volatile("" : "+v"(t)); return t; }

__global__ void __launch_bounds__(512, 2) fwd_kernel(Args a) {
    extern __shared__ __attribute__((aligned(16))) unsigned char lds[];
    cg::grid_group grid = cg::this_grid();
    const int G = gridDim.x, bx = blockIdx.x, NGW = G * 8;
    const int lo = a.ph_lo, hi = a.ph_hi;
#define IN(k) (lo <= (k) && (k) < hi)
    volatile LAS unsigned* MISC = (volatile LAS unsigned*)((LAS unsigned char*)lds + 146432);
    if (threadIdx.x < 16) MISC[threadIdx.x] = 0u;
    __syncthreads();
    XcdBarrier xbar; xbar.bar = (unsigned*)ldws(); xbar.x = 0; xbar.st = nullptr;
    if (hi - lo > 1) xbar = xcd_barrier_post((unsigned*)ldws(), MISC + 8);
    if (hi < 0) grid.sync();
#define SEAM(k) do { if (IN(k) && (k) + 1 < hi) xcd_barrier(xbar); } while (0)
#define WSP(T, off) ((T*)(ws + (off)))

    for (int sx_ = 0; sx_ < SYNCX; ++sx_) xcd_barrier(xbar);
    if (IN(0)) for (int rep_ = 0; rep_ < REP_P; ++rep_) {
        if (rep_) xcd_barrier(xbar);
        const int tid = opq_tid(), lane = tid & 63, wave = __builtin_amdgcn_readfirstlane(tid >> 6), gw = bx * 8 + wave;
        unsigned char* ws = ldws();
        {
            const float *cvec = ldin(6), *c_ctx = ldin(7), *ada_w = ldin(8), *ada_b = ldin(9);
            float* mod = WSP(float, WS_MOD);
            for (int u = bx; u < DEPTH * 96; u += G) {
                const int l = u / 96, nb = u - l * 96;
                gemv9_unit(ada_w + (size_t)l * D * 6144, 6144, nb * 64, c_ctx, cvec, D, true, ada_b + l * 6144, mod + (size_t)l * NMOD * 6144, 6144, (float*)lds, tid);
            }
        }
        {
            const float *w_in = ldin(12), *w1 = ldin(23);
            bf16_t *WIN = WSP(bf16_t, WS_WIN), *W1T = WSP(bf16_t, WS_W1);
            LAS float* scr = (LAS float*)((LAS unsigned char*)lds + wave * 17408);
            constexpr int I_IN = 16 * 36, I_1 = 16 * 64, I_L = I_IN + I_1;
            for (int it = gw; it < 1 * I_L; it += NGW) {
                const int l = it / I_L; int r = it - l * I_L;
                if (r < I_IN) transpose_item(w_in + (size_t)l * D * INW, D, INW, WIN + (size_t)l * INW * D, scr, r, lane);
                else transpose_item(w1 + (size_t)l * D * FF, D, FF, W1T + (size_t)l * FF * D, scr, r - I_IN, lane);
            }
        }
        {
            const float *cache_ak = ldin(2), *cache_av = ldin(3), *cache_nk = ldin(4), *cache_nv = ldin(5);
            bf16_t *KCA = WSP(bf16_t, WS_KCA), *VCA = WSP(bf16_t, WS_VCA), *KCN = WSP(bf16_t, WS_KCN), *VCN = WSP(bf16_t, WS_VCN);
            const int gt = bx * 512 + tid, NGT = G * 512;
            for (int e = gt; e < 8 * 4 * 256 * 8 * 8; e += NGT) {
                const int c8 = e & 7, hh = (e >> 3) & 7, key = (e >> 6) & 255, bl = e >> 14;
                const float* src; bf16_t* dst;
                if (hh < 2) { src = cache_ak + (((size_t)bl * 256 + key) * 2 + hh) * 64 + 8 * c8; dst = KCA + (((size_t)bl * 2 + hh) * 8 + (key >> 5)) * 2048 + (c8 * 32 + (key & 31)) * 8; }
                else { src = cache_nk + (((size_t)bl * 256 + key) * 6 + (hh - 2)) * 64 + 8 * c8; dst = KCN + (((size_t)bl * 6 + (hh - 2)) * 8 + (key >> 5)) * 2048 + (c8 * 32 + (key & 31)) * 8; }
                const f32x4 v0 = *(const f32x4*)src, v1 = *(const f32x4*)(src + 4);
                u32x4 o; o.x = pk2(v0.x, v0.y); o.y = pk2(v0.z, v0.w); o.z = pk2(v1.x, v1.y); o.w = pk2(v1.z, v1.w);
                *(u32x4*)dst = o;
            }
            for (int e = gt; e < 8 * 4 * 8 * 32 * 64; e += NGT) {
                const int d = e & 63, g = (e >> 6) & 31, hh = (e >> 11) & 7, bl = e >> 14;
                unsigned short q[8];
#pragma unroll
                for (int jj = 0; jj < 8; ++jj) {
                    const int p = 8 * g + jj, key = (p & ~31) + permkey(p & 31);
                    const float v = (hh < 2) ? cache_av[(((size_t)bl * 256 + key) * 2 + hh) * 64 + d] : cache_nv[(((size_t)bl * 256 + key) * 6 + (hh - 2)) * 64 + d];
                    q[jj] = (unsigned short)(pk2(v, 0.f) & 0xffffu);
                }
                u32x4 o; o.x = q[0] | ((unsigned)q[1] << 16); o.y = q[2] | ((unsigned)q[3] << 16); o.z = q[4] | ((unsigned)q[5] << 16); o.w = q[6] | ((unsigned)q[7] << 16);
                const int voff = (g >> 2) * 2048 + ((((d >> 5) * 2 + ((g >> 1) & 1)) * 2 + (g & 1)) * 32 + (d & 31)) * 8;
                bf16_t* dst = (hh < 2) ? VCA + ((size_t)bl * 2 + hh) * 16384 + voff : VCN + ((size_t)bl * 6 + (hh - 2)) * 16384 + voff;
                *(u32x4*)dst = o;
            }
        }
    }
    SEAM(0);
    if (IN(1)) for (int rep_ = 0; rep_ < REP_P; ++rep_) {
        if (rep_) xcd_barrier(xbar);
        const int tid = opq_tid(), lane = tid & 63, wave = __builtin_amdgcn_readfirstlane(tid >> 6), gw = bx * 8 + wave;
        unsigned char* ws = ldws();
        float* mod = WSP(float, WS_MOD);
        {
            const float *w_in = ldin(12), *w1 = ldin(23);
            float *bias1 = WSP(float, WS_BIAS1), *bias2 = WSP(float, WS_BIAS2);
            for (int u = bx; u < DEPTH * 100; u += G) {
                const int l = u / 100; int r = u - l * 100;
                const float* ml = mod + (size_t)l * NMOD * 6144;
                if (r < 36) gemv9_unit(w_in + (size_t)l * D * INW, INW, r * 64, ml, ml + 6144, 6144, false, nullptr, bias1 + (size_t)l * NMOD * INW, INW, (float*)lds, tid);
                else { r -= 36; gemv9_unit(w1 + (size_t)l * D * FF, FF, r * 64, ml + 3072, ml + 6144 + 3072, 6144, false, nullptr, bias2 + (size_t)l * NMOD * FF, FF, (float*)lds, tid); }
            }
        }
        {
            const float *w_out = ldin(22), *w2 = ldin(24);
            bf16_t *WOUT = WSP(bf16_t, WS_WOUT), *W2T = WSP(bf16_t, WS_W2);
            LAS float* scr = (LAS float*)((LAS unsigned char*)lds + wave * 17408);
            constexpr int I_OUT = 16 * 16, I_2 = 64 * 16, I_L = I_OUT + I_2;
            for (int it = gw; it < 1 * I_L; it += NGW) {
                const int l = it / I_L; int r = it - l * I_L;
                if (r < I_OUT) transpose_item(w_out + (size_t)l * D * D, D, D, WOUT + (size_t)l * D * D, scr, r, lane);
                else transpose_item(w2 + (size_t)l * FF * D, FF, D, W2T + (size_t)l * D * FF, scr, r - I_OUT, lane);
            }
        }
        {
            const float *x_prompt = ldin(0), *x_sample = ldin(1), *norm1_g = ldin(10);
            bf16_t* XG = WSP(bf16_t, WS_XG); float* ssq = WSP(float, WS_SSQ);
            for (int row = gw; row < M; row += NGW) {
                const float* xr = (row < MP) ? x_prompt + (size_t)row * D : x_sample + (size_t)(row - MP) * D;
                const float* scp = mod + (size_t)modidx(row) * 6144 + 1024;
                float s = 0.f;
#pragma unroll
                for (int j = 0; j < 4; ++j) {
                    const int c = 256 * j + 4 * lane;
                    const f32x4 v = *(const f32x4*)(xr + c);
                    s += (v.x * v.x + v.y * v.y) + (v.z * v.z + v.w * v.w);
                    const f32x4 y = v * (*(const f32x4*)(norm1_g + c)) * (*(const f32x4*)(scp + c) + 1.0f);
                    u32x2 w; w.x = pk2(y.x, y.y); w.y = pk2(y.z, y.w);
                    *(u32x2*)(XG + (size_t)row * D + c) = w;
                }
                s = wave_sum(s);
                if (lane < 16) ssq[(size_t)row * 16 + lane] = (lane == 0) ? s : 0.f;
            }
        }
    }
    SEAM(1);
#pragma nounroll
    for (int l_ = 0; l_ < DEPTH; ++l_) {
        int l = l_; asm volatile("" : "+s"(l));
        const int p0 = 2 + 6 * l;
        if (IN(p0)) for (int rep_ = 0; rep_ < REP_G1; ++rep_) {
            unsigned char* ws = ldws();
            pg8::Gemm g{WSP(bf16_t, WS_XG), WSP(bf16_t, WS_WIN) + (size_t)l * INW * D, M, INW, D, D}; pg8::StaticOrder S; S.init(M, INW, G, bx);
            EpiLin<0> E{WSP(bf16_t, WS_RAW), INW, WSP(float, WS_BIAS1) + (size_t)l * NMOD * INW, INW, WSP(float, WS_SSQ)};
            pg8::gemm_phase<EpiLin<0>, pg8::StaticOrder, true, true>((LAS unsigned char*)lds, g, S, E);
        }
        SEAM(p0);
        if (IN(p0 + 1)) for (int rep_ = 0; rep_ < REP_PREP; ++rep_) {
            const int tid = opq_tid();
            unsigned char* ws = ldws();
            for (int u = bx; u < 768; u += G) {
                if (u < 384) conv_unit(u, l, WSP(bf16_t, WS_RAW), WSP(bf16_t, WS_ATT), ldin(13), ldin(14), ldin(15), ldin(16), (float*)lds, tid);
                else { PrepP P{WSP(bf16_t, WS_RAW), WSP(bf16_t, WS_Q), WSP(bf16_t, WS_K), WSP(bf16_t, WS_VT), ldout(), ldin(17), ldin(18), ldin(19), ldin(20)}; qkv_unit(u - 384, l, P, (bf16_t*)lds, tid); }
            }
        }
        SEAM(p0 + 1);
        if (IN(p0 + 2)) for (int rep_ = 0; rep_ < REP_ATTN; ++rep_) {
            const int tid = opq_tid(), lane = tid & 63, wave = __builtin_amdgcn_readfirstlane(tid >> 6), gw = bx * 8 + wave;
            unsigned char* ws = ldws();
            AttnP P{WSP(bf16_t, WS_Q), WSP(bf16_t, WS_K), WSP(bf16_t, WS_VT), WSP(bf16_t, WS_KCA), WSP(bf16_t, WS_VCA), WSP(bf16_t, WS_KCN), WSP(bf16_t, WS_VCN), WSP(bf16_t, WS_ATT), ldin(21)};
            bool bal = (NGW == 2048) && (hi - lo > 1);
            int xcd = bx & 7, slot = bx >> 3;
            if (bal) {
                unsigned okc = 1u;
                for (unsigned j = 0; j < 16; ++j) okc &= (xb_ld(&xbar.bar[XB_XCNT(j)]) == (j < 8 ? 32u : 0u)) ? 1u : 0u;
                xcd = __builtin_amdgcn_readfirstlane((int)MISC[11]); slot = __builtin_amdgcn_readfirstlane((int)MISC[10]);
                bal = (__builtin_amdgcn_readfirstlane((int)okc) != 0) && xcd < 8 && slot < 32;
            }
            const int idx = slot * 8 + wave;
            const int nu = bal ? (slot < 24 ? (idx < 64 ? 4 : 2) : 2) : (4608 - gw + NGW - 1) / NGW;
            for (int k = 0; k < nu; ++k) {
#ifdef ATTN_PROBE
                if (rep_ == 1 && ((ATTN_PROBE == 1) ? (slot >= 24) : (ATTN_PROBE == 2) ? (slot < 24) : (slot >= 24 || k > 0))) break;
#endif
                int uid, qsel = 2; bool cshared = false;
                if (!bal) uid = gw + k * NGW;
                else if (slot < 24) {
                    if (k == 0) { uid = (xcd * 6 + (idx >> 5)) * 32 + (idx & 31); cshared = true; }
                    else if (idx < 64) { const int p = (k - 1) * 64 + idx; const int pb = 4 * xcd + p / 48, r = p % 48, kind = r / 24, rr = r % 24; uid = (kind ? 3840 : 3072) + (pb * 6 + (rr >> 2)) * 4 + (rr & 3); }
                    else { uid = 1536 + xcd * 192 + 128 + ((idx - 64) >> 1); qsel = (idx - 64) & 1; }
                } else uid = 1536 + xcd * 192 + k * 64 + (slot - 24) * 8 + wave;
                attn_run_unit(uid, qsel, l, P, lane, (LAS unsigned char*)lds + wave * 16384, (LAS float*)((LAS unsigned char*)lds + 131072 + wave * 1920), cshared, wave, (LAS unsigned char*)lds);
            }
        }
        SEAM(p0 + 2);
        if (IN(p0 + 3)) {
            unsigned char* ws = ldws(); float* X = ldout();
            const float* ml = WSP(float, WS_MOD) + (size_t)l * NMOD * 6144;
            const bool split = false;
#pragma nounroll
            for (int rnd = 0; rnd < (split ? 2 : 1); ++rnd) {
                const int kh = (rnd == 1) ? (bx >> 7) : 0, koff = kh * (D / 2);
                pg8::Gemm g{WSP(bf16_t, WS_ATT) + koff, WSP(bf16_t, WS_WOUT) + (size_t)l * D * D + koff, M, D, D, (rnd == 1) ? D / 2 : D};
                RangeOrder S; S.init(M, D, G, bx); S.lo = 0; S.hi = split ? 256 : 384; S.fix = (rnd == 1) ? 256 + (bx & 127) : -1;
                unsigned* flag = (unsigned*)(ws + 16384) + (size_t)((l * 2 + 0) * 128 + (bx & 127)) * 64;
                f32x4* part = (f32x4*)(ws + WS_RAW) + (size_t)(bx & 127) * 16384;
                EpiRes E{l == 0 ? ldin(0) : X, l == 0 ? ldin(1) : X + (size_t)MP * D, X, ml + 2048, ldin(11) + l * D, ml + 4096, WSP(bf16_t, WS_XG), WSP(float, WS_SSQ), 1, (rnd == 1) ? 1 + kh : 0, part, flag};
                pg8::gemm_phase<EpiRes, RangeOrder, true, true>((LAS unsigned char*)lds, g, S, E);
                if (rnd == 1 && kh == 1) {
                    asm volatile("s_waitcnt vmcnt(0)" ::: "memory"); __syncthreads();
                    if (threadIdx.x == 0) { __builtin_amdgcn_fence(__ATOMIC_RELEASE, "agent"); asm volatile("s_waitcnt vmcnt(0)" ::: "memory"); __hip_atomic_store(flag, 1u, __ATOMIC_RELAXED, __HIP_MEMORY_SCOPE_AGENT); }
                }
            }
            SEAM(p0 + 3);
        }
        if (IN(p0 + 4)) for (int rep_ = 0; rep_ < REP_G3; ++rep_) {
            unsigned char* ws = ldws();
            pg8::Gemm g{WSP(bf16_t, WS_XG), WSP(bf16_t, WS_W1) + (size_t)l * FF * D, M, FF, D, D}; pg8::StaticOrder S; S.init(M, FF, G, bx);
            EpiLin<1> E{WSP(bf16_t, WS_H1), FF, WSP(float, WS_BIAS2) + (size_t)l * NMOD * FF, FF, WSP(float, WS_SSQ)};
            pg8::gemm_phase<EpiLin<1>, pg8::StaticOrder, true, true>((LAS unsigned char*)lds, g, S, E);
        }
        SEAM(p0 + 4);
        if (IN(p0 + 5)) {
            unsigned char* ws = ldws(); float* X = ldout();
            const float* ml = WSP(float, WS_MOD) + (size_t)l * NMOD * 6144;
            const int nx = (l + 1 < DEPTH) ? 1 : 0; const int ln = nx ? l + 1 : l;
            const bool split = false;
#pragma nounroll
            for (int rnd = 0; rnd < (split ? 2 : 1); ++rnd) {
                const int kh = (rnd == 1) ? (bx >> 7) : 0, koff = kh * (FF / 2);
                pg8::Gemm g{WSP(bf16_t, WS_H1) + koff, WSP(bf16_t, WS_W2) + (size_t)l * D * FF + koff, M, D, FF, (rnd == 1) ? FF / 2 : FF};
                RangeOrder S; S.init(M, D, G, bx); S.lo = 0; S.hi = split ? 256 : 384; S.fix = (rnd == 1) ? 256 + (bx & 127) : -1;
                unsigned* flag = (unsigned*)(ws + 16384) + (size_t)((l * 2 + 1) * 128 + (bx & 127)) * 64;
                f32x4* part = (f32x4*)(ws + WS_ATT) + (size_t)(bx & 127) * 16384;
                EpiRes E{X, X + (size_t)MP * D, X, ml + 5120, ldin(10) + ln * D, WSP(float, WS_MOD) + (size_t)ln * NMOD * 6144 + 1024, WSP(bf16_t, WS_XG), WSP(float, WS_SSQ), nx, (rnd == 1) ? 1 + kh : 0, part, flag};
                pg8::gemm_phase<EpiRes, RangeOrder, true, true>((LAS unsigned char*)lds, g, S, E);
                if (rnd == 1 && kh == 1) {
                    asm volatile("s_waitcnt vmcnt(0)" ::: "memory"); __syncthreads();
                    if (threadIdx.x == 0) { __builtin_amdgcn_fence(__ATOMIC_RELEASE, "agent"); asm volatile("s_waitcnt vmcnt(0)" ::: "memory"); __hip_atomic_store(flag, 1u, __ATOMIC_RELAXED, __HIP_MEMORY_SCOPE_AGENT); }
                }
            }
            if (l + 1 < DEPTH) {
                const int first = (G == 256) ? 128 : 0, nwg_t = G - first;
                if (bx >= first) {
                    const int tid = opq_tid(), lane = tid & 63, wave = __builtin_amdgcn_readfirstlane(tid >> 6);
                    const int l2 = l + 1;
                    const float *w_in = ldin(12), *w_out = ldin(22), *w1 = ldin(23), *w2 = ldin(24);
                    LAS float* scr = (LAS float*)((LAS unsigned char*)lds + wave * 17408);
                    constexpr int I_IN = 16 * 36, I_1 = 16 * 64, I_OUT = 16 * 16, I_2 = 64 * 16, I_L = I_IN + I_1 + I_OUT + I_2;
                    for (int it = (bx - first) * 8 + wave; it < I_L; it += nwg_t * 8) {
                        int r = it;
                        if (r < I_IN) { transpose_item(w_in + (size_t)l2 * D * INW, D, INW, WSP(bf16_t, WS_WIN) + (size_t)l2 * INW * D, scr, r, lane); continue; } r -= I_IN;
                        if (r < I_1) { transpose_item(w1 + (size_t)l2 * D * FF, D, FF, WSP(bf16_t, WS_W1) + (size_t)l2 * FF * D, scr, r, lane); continue; } r -= I_1;
                        if (r < I_OUT) { transpose_item(w_out + (size_t)l2 * D * D, D, D, WSP(bf16_t, WS_WOUT) + (size_t)l2 * D * D, scr, r, lane); continue; } r -= I_OUT;
                        transpose_item(w2 + (size_t)l2 * FF * D, FF, D, WSP(bf16_t, WS_W2) + (size_t)l2 * D * FF, scr, r, lane);
                    }
                }
            }
            SEAM(p0 + 5);
        }
    }
#undef IN
#undef SEAM
#undef WSP
}

extern "C" void kernel_launch(void* const* d_in, const int* in_sizes, int n_in, void* d_out, int out_size, void* d_ws, size_t ws_size, hipStream_t stream) {
    static int grid = 0;
    if (grid == 0) {
        if (n_in != 25 || ws_size < WS_END) { fprintf(stderr, "kernel_launch: need 25 inputs and >= %zu bytes of workspace; got %d, %zu\n", (size_t)WS_END, n_in, ws_size); grid = -1; return; }
        int dev = 0, cus = 0, per_cu = 0;
        hipGetDevice(&dev);
        hipDeviceGetAttribute(&cus, hipDeviceAttributeMultiprocessorCount, dev);
        if (hipFuncSetAttribute((const void*)fwd_kernel, hipFuncAttributeMaxDynamicSharedMemorySize, LDS_BYTES) != hipSuccess) { fprintf(stderr, "kernel_launch: hipFuncSetAttribute failed\n"); grid = -1; return; }
        if (hipOccupancyMaxActiveBlocksPerMultiprocessor(&per_cu, (const void*)fwd_kernel, 512, LDS_BYTES) != hipSuccess || per_cu < 1) { fprintf(stderr, "kernel_launch: occupancy query says %d\n", per_cu); per_cu = 1; }
        (void)hipGetLastError();
        grid = cus * per_cu;
    }
    if (grid < 0) return;
    if (hipMemsetAsync(d_ws, 0, 16384, stream) != hipSuccess) { fprintf(stderr, "kernel_launch: memset failed\n"); return; }
    Args a{};
    for (int i = 0; i < 25; ++i) a.in[i] = (const float*)d_in[i];
    a.out = (float*)d_out; a.ws = (unsigned char*)d_ws;
#if MK_SINGLE
    a.ph_lo = 0; a.ph_hi = NPH;
    void* args[] = {&a};
    hipError_t e = hipLaunchCooperativeKernel((const void*)fwd_kernel, dim3(grid), dim3(512), args, LDS_BYTES, stream);
    if (e != hipSuccess) fprintf(stderr, "cooperative launch failed: %s (grid %d)\n", hipGetErrorString(e), grid);
#else
    for (int ph = 0; ph < NPH; ++ph) {
        a.ph_lo = ph; a.ph_hi = ph + 1;
        hipLaunchKernelGGL(fwd_kernel, dim3(grid), dim3(512), LDS_BYTES, stream, a);
    }
#endif
}
```

```cpp
#include <hip/hip_runtime.h>
#include <hip/hip_cooperative_groups.h>
#include <cstdio>
#include <cstdint>
namespace cg = cooperative_groups;
namespace pg8 {
#define PG8_LAS __attribute__((address_space(3)))
typedef unsigned short bf16_t;
typedef short bf16x8 __attribute__((ext_vector_type(8)));
typedef float f32x4 __attribute__((ext_vector_type(4)));
typedef unsigned u32x4 __attribute__((ext_vector_type(4)));
constexpr int BM = 256, BK = 64, HALF = 128, HTB = HALF * BK * 2  , STAGE_BYTES = 8 * HTB, NXCD = 8, WGM = 8;

__host__ __device__ __forceinline__ int lds_byte(int r, int c) { const int st = (r >> 4) * 2 + (c >> 5), rr = r & 15, cc = c & 31, ob = rr * 64 + cc * 2; return st * 1024 + (ob ^ (((ob >> 9) & 1) << 5)); }
__host__ __device__ __forceinline__ void stage_rc(int b, int& R, int& C) { const int st = b / 1024, sb = b % 1024, swz = sb ^ (((sb >> 9) & 1) << 5); R = (st >> 1) * 16 + swz / 64; C = (st & 1) * 32 + (swz % 64) / 2; }
__host__ __device__ __forceinline__ int perm32(int rho) { const int n = rho >> 4, i = rho & 15; return 8 * (i >> 2) + 4 * n + (i & 3); }

struct Unit { int pm, pn; };
struct Gemm { const bf16_t* A; const bf16_t* Bt; int M, N, K, Kl; };

struct StaticOrder {
    int nM, nN, nwg, G, c;
    __host__ __device__ void init(int M, int N, int G_, int c_) { nM = M / BM; nN = N / BM; nwg = nM * nN; G = G_; c = c_; }
    __host__ __device__ bool next(int i, Unit& u) const {
        const long L = (long)i * G + c; if (L >= nwg) return false;
        int wgid = (int)L; { const int q = nwg / NXCD, r = nwg % NXCD, xcd = wgid % NXCD, off = wgid / NXCD; wgid = (xcd < r ? xcd * (q + 1) : r * (q + 1) + (xcd - r) * q) + off; }
        const int nig = WGM * nN, gid = wgid / nig, fm = gid * WGM, gsz = (nM - fm) < WGM ? (nM - fm) : WGM;
        u.pm = fm + ((wgid % nig) % gsz); u.pn = (wgid % nig) / gsz; return true;
    }
    __device__ __forceinline__ void a_ready(const Unit&) const {}
    __device__ __forceinline__ void done(const Unit&) const {}
};
__device__ __forceinline__ unsigned cvt_pk_bf16(float lo, float hi) { unsigned r; asm volatile("v_cvt_pk_bf16_f32 %0, %1, %2" : "=v"(r) : "v"(lo), "v"(hi)); return r; }
template <class Epi, class Sched, bool ALIGN_EPI = false, bool SP2 = false>
__device__ __forceinline__ void gemm_phase(PG8_LAS unsigned char* lds, const Gemm g, const Sched& S, const Epi& E) {
    int tid_ = threadIdx.x; asm volatile("" : "+v"(tid_));
    const int tid = tid_, wid = __builtin_amdgcn_readfirstlane(tid >> 6), lane = tid & 63, wr = wid >> 2, wc = wid & 3, fr = lane & 15, fq = lane >> 4;
    const int K = g.K, nt = g.Kl / BK;
    unsigned voffA[2], voffB[2];
#pragma unroll
    for (int i = 0; i < 2; ++i) { int R, C; stage_rc(tid * 16 + i * 8192, R, C); const int Rb = Epi::PERM ? ((R & ~31) + perm32(R & 31)) : R;
        voffA[i] = (unsigned)(R * K + C) * 2u; voffB[i] = (unsigned)(Rb * K + C) * 2u; }
    const size_t kstep = (size_t)(BK * 2);
    const size_t hstep = (size_t)HALF * K * 2;
    const size_t tstep = 2 * hstep;
    const unsigned ldsw = (unsigned)wid * 1024u;
    const int aoff = lds_byte(wr * 64 + fr, fq * 8), boff = lds_byte(wc * 32 + fr, fq * 8);
#define PG8_SA(b, h) (((b) * 2 + (h)) * HTB)
#define PG8_SB(b, h) ((4 + (b) * 2 + (h)) * HTB)
#define PG8_STAGE(bufoff, gbase, voff) do { _Pragma("unroll") for (int _i = 0; _i < 2; ++_i) \
        __builtin_amdgcn_global_load_lds((const unsigned*)((const char*)(gbase) + (voff)[_i]), (PG8_LAS unsigned*)(lds + (bufoff) + ldsw + _i * 8192), 16, 0, 0); } while (0)
#define PG8_LDA(dst, b, h) do { _Pragma("unroll") for (int m = 0; m < 4; ++m) _Pragma("unroll") for (int k = 0; k < 2; ++k) dst[m][k] = *(const PG8_LAS bf16x8*)(lds + PG8_SA(b, h) + aoff + m * 2048 + k * 1024); } while (0)
#define PG8_LDB(dst, b, h) do { _Pragma("unroll") for (int n = 0; n < 2; ++n) _Pragma("unroll") for (int k = 0; k < 2; ++k) dst[n][k] = *(const PG8_LAS bf16x8*)(lds + PG8_SB(b, h) + boff + n * 2048 + k * 1024); } while (0)
#define PG8_MMA(ai, bj, At, Bt) do { __builtin_amdgcn_s_setprio(1); _Pragma("unroll") for (int m = 0; m < 4; ++m) _Pragma("unroll") for (int n = 0; n < 2; ++n) _Pragma("unroll") for (int k = 0; k < 2; ++k) \
        acc[ai][bj][m][n] = __builtin_amdgcn_mfma_f32_16x16x32_bf16(Bt[n][k], At[m][k], acc[ai][bj][m][n], 0, 0, 0); __builtin_amdgcn_s_setprio(0); } while (0)
#define PG8_WAIT_V(n) asm volatile("s_waitcnt vmcnt(" #n ")" ::: "memory")
#define PG8_WAIT_L(n) asm volatile("s_waitcnt lgkmcnt(" #n ")" ::: "memory")
#define PG8_BAR __builtin_amdgcn_s_barrier()
#define PG8_SCHED __builtin_amdgcn_sched_barrier(0)
    Unit cur, nxt; int ui = 0;
    if (!S.next(0, cur)) return;
    f32x4 acc[2][2][4][2];
#pragma unroll
    for (int a = 0; a < 2; ++a)
#pragma unroll
        for (int b = 0; b < 2; ++b)
#pragma unroll
            for (int m = 0; m < 4; ++m)
#pragma unroll
                for (int n = 0; n < 2; ++n) acc[a][b][m][n] = (f32x4){0.f, 0.f, 0.f, 0.f};
    bf16x8 At[4][2], B0[2][2], B1[2][2];
    const char* cA = (const char*)g.A + (size_t)cur.pm * tstep; const char* cB = (const char*)g.Bt + (size_t)cur.pn * tstep;
    S.a_ready(cur);
    if constexpr (SP2) {
        PG8_STAGE(PG8_SB(0, 0), cB, voffB); PG8_STAGE(PG8_SB(0, 1), cB + hstep, voffB); PG8_STAGE(PG8_SA(0, 0), cA, voffA); PG8_STAGE(PG8_SA(0, 1), cA + hstep, voffA);
        if (wr == 1) PG8_BAR;
        PG8_WAIT_V(2); PG8_BAR;
        PG8_STAGE(PG8_SB(1, 0), cB + kstep, voffB); PG8_STAGE(PG8_SA(1, 0), cA + kstep, voffA); PG8_STAGE(PG8_SB(1, 1), cB + hstep + kstep, voffB);
        PG8_WAIT_V(6); PG8_BAR;
    } else {
        PG8_STAGE(PG8_SB(0, 0), cB, voffB); PG8_STAGE(PG8_SA(0, 0), cA, voffA); PG8_STAGE(PG8_SB(0, 1), cB + hstep, voffB); PG8_STAGE(PG8_SA(0, 1), cA + hstep, voffA);
        if (wr == 1) PG8_BAR;
        PG8_WAIT_V(4); PG8_BAR;
        PG8_STAGE(PG8_SB(1, 0), cB + kstep, voffB); PG8_STAGE(PG8_SA(1, 0), cA + kstep, voffA); PG8_STAGE(PG8_SB(1, 1), cB + hstep + kstep, voffB);
        PG8_WAIT_V(6); PG8_BAR;
    }
    for (;;) {
        const bool has_next = S.next(ui + 1, nxt);
        const char* nA = has_next ? (const char*)g.A + (size_t)nxt.pm * tstep : cA; const char* nB = has_next ? (const char*)g.Bt + (size_t)nxt.pn * tstep : cB;
        for (int t = 0; t < nt; t += 2) {
            const bool last = (t == nt - 2);
            const char* a1 = cA + (size_t)(t + 1) * kstep;
            const char* a2 = last ? nA : cA + (size_t)(t + 2) * kstep; const char* b2 = last ? nB : cB + (size_t)(t + 2) * kstep;
            const char* a3 = a2 + kstep; const char* b3 = b2 + kstep;
            if (last && has_next) S.a_ready(nxt);
            if constexpr (SP2) {
            PG8_LDB(B0, 0, 0); PG8_LDB(B1, 0, 1); PG8_SCHED; PG8_LDA(At, 0, 0); PG8_STAGE(PG8_SA(1, 1), a1 + hstep, voffA);
            PG8_WAIT_V(8); PG8_WAIT_L(0); PG8_BAR; PG8_MMA(0, 0, At, B0); PG8_MMA(0, 1, At, B1); PG8_BAR; PG8_SCHED;
            PG8_LDA(At, 0, 1); PG8_STAGE(PG8_SB(0, 0), b2, voffB); PG8_STAGE(PG8_SB(0, 1), b2 + hstep, voffB); PG8_STAGE(PG8_SA(0, 0), a2, voffA);
            PG8_WAIT_V(8); PG8_WAIT_L(0); PG8_BAR; PG8_MMA(1, 0, At, B0); PG8_MMA(1, 1, At, B1); PG8_BAR; PG8_SCHED;
            PG8_LDB(B0, 1, 0); PG8_LDB(B1, 1, 1); PG8_SCHED; PG8_LDA(At, 1, 0); PG8_STAGE(PG8_SA(0, 1), a2 + hstep, voffA);
            PG8_WAIT_V(8); PG8_WAIT_L(0); PG8_BAR; PG8_MMA(0, 0, At, B0); PG8_MMA(0, 1, At, B1); PG8_BAR; PG8_SCHED;
            PG8_LDA(At, 1, 1); PG8_STAGE(PG8_SB(1, 0), b3, voffB); PG8_STAGE(PG8_SB(1, 1), b3 + hstep, voffB); PG8_STAGE(PG8_SA(1, 0), a3, voffA);
            PG8_WAIT_V(8); PG8_WAIT_L(0); PG8_BAR; PG8_MMA(1, 0, At, B0); PG8_MMA(1, 1, At, B1); PG8_BAR; PG8_SCHED;
            } else {
            PG8_LDB(B0, 0, 0); PG8_SCHED; PG8_LDA(At, 0, 0); PG8_STAGE(PG8_SA(1, 1), a1 + hstep, voffA);
            PG8_WAIT_L(8); PG8_BAR; PG8_WAIT_L(0); PG8_MMA(0, 0, At, B0); PG8_BAR; PG8_SCHED;
            PG8_LDB(B1, 0, 1); PG8_STAGE(PG8_SB(0, 0), b2, voffB);
            PG8_BAR; PG8_WAIT_L(0); PG8_MMA(0, 1, At, B1); PG8_BAR;
            PG8_LDA(At, 0, 1); PG8_STAGE(PG8_SA(0, 0), a2, voffA);
            PG8_BAR; PG8_WAIT_L(0); PG8_MMA(1, 0, At, B0); PG8_BAR; PG8_SCHED;
            PG8_STAGE(PG8_SB(0, 1), b2 + hstep, voffB);
            PG8_WAIT_V(6); PG8_BAR; PG8_MMA(1, 1, At, B1); PG8_BAR;
            PG8_LDB(B0, 1, 0); PG8_SCHED; PG8_LDA(At, 1, 0); PG8_STAGE(PG8_SA(0, 1), a2 + hstep, voffA);
            PG8_WAIT_L(8); PG8_BAR; PG8_WAIT_L(0); PG8_MMA(0, 0, At, B0); PG8_BAR; PG8_SCHED;
            PG8_LDB(B1, 1, 1); PG8_STAGE(PG8_SB(1, 0), b3, voffB);
            PG8_BAR; PG8_WAIT_L(0); PG8_MMA(0, 1, At, B1); PG8_BAR;
            PG8_LDA(At, 1, 1); PG8_STAGE(PG8_SA(1, 0), a3, voffA);
            PG8_BAR; PG8_WAIT_L(0); PG8_MMA(1, 0, At, B0); PG8_BAR; PG8_SCHED;
            PG8_STAGE(PG8_SB(1, 1), b3 + hstep, voffB);
            PG8_WAIT_V(6); PG8_BAR; PG8_MMA(1, 1, At, B1); PG8_BAR;
            }
        }
        if constexpr (ALIGN_EPI) { if (wr == 0) PG8_BAR; }
        if constexpr (!Epi::AFTER_DRAIN) { E(acc, cur, wr, wc, fr, fq); S.done(cur); }
        if (!has_next) break;
#pragma unroll
        for (int a = 0; a < 2; ++a)
#pragma unroll
            for (int b = 0; b < 2; ++b)
#pragma unroll
                for (int m = 0; m < 4; ++m)
#pragma unroll
                    for (int n = 0; n < 2; ++n) acc[a][b][m][n] = (f32x4){0.f, 0.f, 0.f, 0.f};
        cur = nxt; cA = nA; cB = nB; ++ui;
        if constexpr (ALIGN_EPI) { if (wr == 1) PG8_BAR; }
    }
    PG8_WAIT_V(0);
    if constexpr (!ALIGN_EPI) { if (wr == 0) PG8_BAR; }
    PG8_BAR;
    if constexpr (Epi::AFTER_DRAIN) { E.fused(acc, cur, wr, wc, fr, fq, lds, wid, lane); S.done(cur); }
#undef PG8_SA
#undef PG8_SB
#undef PG8_STAGE
#undef PG8_LDA
#undef PG8_LDB
#undef PG8_MMA
#undef PG8_WAIT_V
#undef PG8_WAIT_L
#undef PG8_BAR
#undef PG8_SCHED
}
}

#define DI __device__ __forceinline__
#define LAS __attribute__((address_space(3)))
typedef unsigned short bf16_t;
typedef short bf16x8 __attribute__((ext_vector_type(8)));
typedef float f32x4 __attribute__((ext_vector_type(4)));
typedef float f32x16 __attribute__((ext_vector_type(16)));
typedef unsigned u32x4 __attribute__((ext_vector_type(4)));
typedef unsigned u32x2 __attribute__((ext_vector_type(2)));
typedef float f32x2_t __attribute__((ext_vector_type(2)));
typedef __bf16 bf16x2_t __attribute__((ext_vector_type(2)));

#ifndef REP_P
#define REP_P 1
#endif
#ifndef REP_G1
#define REP_G1 1
#endif
#ifndef REP_PREP
#define REP_PREP 1
#endif
#ifndef REP_ATTN
#define REP_ATTN 1
#endif
#ifndef REP_G3
#define REP_G3 1
#endif
#ifndef SYNCX
#define SYNCX 0
#endif
#ifndef MK_SINGLE
#define MK_SINGLE 1
#endif

constexpr int D = 1024, MP = 8192, MS = 16384, M = MP + MS, DEPTH = 4, NMOD = 9, INW = 2304, FF = 4096;
constexpr int NPH = 2 + 6 * DEPTH;
constexpr float QSCALE = 0.125f * 1.4426950408889634f, LOG2E = 1.4426950408889634f, EPS = 1e-6f;
constexpr size_t OFF_AK = 25165824, OFF_AV = 29360128, OFF_NK = 33554432, OFF_NV = 46137344;
constexpr size_t MiB = 1u << 20;
constexpr size_t WS_MOD = 1 * MiB, WS_BIAS1 = 2 * MiB, WS_BIAS2 = 3 * MiB, WS_SSQ = 4 * MiB;
constexpr size_t WS_KCA = 6 * MiB, WS_VCA = 8 * MiB, WS_KCN = 10 * MiB, WS_VCN = 16 * MiB;
constexpr size_t WS_WIN = 22 * MiB, WS_WOUT = 40 * MiB, WS_W1 = 48 * MiB, WS_W2 = 80 * MiB;
constexpr size_t WS_XG = 112 * MiB, WS_H1 = 160 * MiB, WS_RAW = 160 * MiB, WS_Q = 268 * MiB, WS_K = 304 * MiB, WS_VT = 328 * MiB, WS_ATT = 352 * MiB, WS_END = 400 * MiB;
constexpr int LDS_BYTES = 147456;

DI unsigned pk2(float lo, float hi) { f32x2_t v = {lo, hi}; bf16x2_t b = __builtin_convertvector(v, bf16x2_t); return __builtin_bit_cast(unsigned, b); }
DI float bflo(unsigned w) { return __uint_as_float(w << 16); }
DI float bfhi(unsigned w) { return __uint_as_float(w & 0xffff0000u); }
DI void unpack8(const u32x4 w, float (&v)[8]) { v[0] = bflo(w.x); v[1] = bfhi(w.x); v[2] = bflo(w.y); v[3] = bfhi(w.y); v[4] = bflo(w.z); v[5] = bfhi(w.z); v[6] = bflo(w.w); v[7] = bfhi(w.w); }
DI int modidx(int row) { return row < MP ? 0 : 1 + ((row - MP) >> 11); }
DI float wave_sum(float v) {
#pragma unroll
    for (int o = 1; o < 64; o <<= 1) v += __shfl_xor(v, o);
    return v;
}
DI float sigmoidf_(float x) { return 1.f / (1.f + __expf(-x)); }
DI int crow(int i, int hi) { return (i & 3) + 8 * (i >> 2) + 4 * hi; }
DI int permkey(int p) { const int s = p >> 4, hh = (p >> 3) & 1, jj = p & 7; return 16 * s + 8 * (jj >> 2) + 4 * hh + (jj & 3); }

template <int ACT> struct EpiLin {
    static constexpr bool PERM = true, AFTER_DRAIN = false;
    bf16_t* O; int ldc; const float* bias; int ldb; const float* ssq;
    DI void operator()(const f32x4 (&acc)[2][2][4][2], const pg8::Unit& u, int wr, int wc, int fr, int fq) const {
        const int row0 = u.pm * 256 + wr * 64 + fr, col0 = u.pn * 256 + wc * 32 + 8 * fq;
        const float* bp = bias + (size_t)modidx(u.pm * 256) * ldb + col0;
        f32x4 bv[2][2];
#pragma unroll
        for (int bj = 0; bj < 2; ++bj)
#pragma unroll
            for (int n = 0; n < 2; ++n) bv[bj][n] = *(const f32x4*)(bp + bj * 128 + 4 * n);
        float rs8[8];
        {
            f32x4 s4[8];
#pragma unroll
            for (int k = 0; k < 8; ++k) s4[k] = *(const f32x4*)(ssq + (size_t)(row0 + (k >> 2) * 128 + (k & 3) * 16) * 16 + 4 * fq);
#pragma unroll
            for (int k = 0; k < 8; ++k) { float s = (s4[k].x + s4[k].y) + (s4[k].z + s4[k].w); s += __shfl_xor(s, 16); s += __shfl_xor(s, 32); rs8[k] = rsqrtf(s * (1.f / 1024.f) + EPS); }
        }
#pragma unroll
        for (int ai = 0; ai < 2; ++ai)
#pragma unroll
            for (int m = 0; m < 4; ++m) {
                const int row = row0 + ai * 128 + m * 16;
                const float rstd = rs8[ai * 4 + m];
                bf16_t* rowp = O + (size_t)row * ldc + col0;
#pragma unroll
                for (int bj = 0; bj < 2; ++bj) {
                    f32x4 v0 = acc[ai][bj][m][0] * rstd + bv[bj][0], v1 = acc[ai][bj][m][1] * rstd + bv[bj][1];
                    if (ACT == 1) {
#pragma unroll
                        for (int e = 0; e < 4; ++e) { const float a = fmaxf(v0[e], 0.f), b = fmaxf(v1[e], 0.f); v0[e] = a * a; v1[e] = b * b; }
                    }
                    u32x4 w; w.x = pk2(v0[0], v0[1]); w.y = pk2(v0[2], v0[3]); w.z = pk2(v1[0], v1[1]); w.w = pk2(v1[2], v1[3]);
                    *(u32x4*)(rowp + bj * 128) = w;
                }
            }
    }
};
struct EpiRes {
    static constexpr bool PERM = false, AFTER_DRAIN = false;
    const float* baseP; const float* baseS; float* out; const float* gate; const float* nw; const float* sc; bf16_t* xg; float* ssq; int has_next;
    int mode; f32x4* part; unsigned* flag;
    DI void operator()(f32x4 (&acc)[2][2][4][2], const pg8::Unit& u, int wr, int wc, int fr, int fq) const {
        f32x4* pp = part + threadIdx.x; asm volatile("" : "+v"(pp));
        if (mode == 2) {
#pragma unroll
            for (int ai = 0; ai < 2; ++ai)
#pragma unroll
                for (int bj = 0; bj < 2; ++bj)
#pragma unroll
                    for (int m = 0; m < 4; ++m)
#pragma unroll
                        for (int n = 0; n < 2; ++n) pp[(size_t)((((ai * 2 + bj) * 4 + m) * 2 + n) * 512)] = acc[ai][bj][m][n];
            return;
        }
        if (mode == 1) {
            const unsigned long long t0 = __builtin_amdgcn_s_memrealtime();
            while ((unsigned)__builtin_amdgcn_readfirstlane(__hip_atomic_load(flag, __ATOMIC_RELAXED, __HIP_MEMORY_SCOPE_AGENT)) == 0u) {
                if (__builtin_amdgcn_s_memrealtime() - t0 > 2000000ull) break;
                __builtin_amdgcn_s_sleep(2); }
            __builtin_amdgcn_fence(__ATOMIC_ACQUIRE, "agent");
            asm volatile("s_waitcnt vmcnt(0)" ::: "memory");
#pragma unroll
            for (int ai = 0; ai < 2; ++ai)
#pragma unroll
                for (int bj = 0; bj < 2; ++bj) {
#pragma unroll
                    for (int m = 0; m < 4; ++m) {
#pragma unroll
                        for (int n = 0; n < 2; ++n) acc[ai][bj][m][n] += pp[(size_t)((((ai * 2 + bj) * 4 + m) * 2 + n) * 512)];
                        if (m & 1) asm volatile("" ::: "memory");
                    }
                }
        }
        const int col0 = u.pn * 256 + wc * 32 + 4 * fq, j = modidx(u.pm * 256);
        const float* gp = gate + (size_t)j * 6144 + col0;
        f32x4 gv[2][2], gn[2][2];
#pragma unroll
        for (int bj = 0; bj < 2; ++bj)
#pragma unroll
            for (int n = 0; n < 2; ++n) {
                gv[bj][n] = *(const f32x4*)(gp + bj * 128 + n * 16);
                if (has_next) gn[bj][n] = *(const f32x4*)(nw + col0 + bj * 128 + n * 16) * (*(const f32x4*)(sc + (size_t)j * 6144 + col0 + bj * 128 + n * 16) + 1.0f);
                else gn[bj][n] = (f32x4){0.f, 0.f, 0.f, 0.f};
            }
#pragma unroll
        for (int hp = 0; hp < 4; ++hp) {
            const int ai = hp >> 1, m0 = (hp & 1) * 2;
            f32x4 pre[2][2][2];
#pragma unroll
            for (int mm = 0; mm < 2; ++mm) {
                const int row = u.pm * 256 + ai * 128 + wr * 64 + (m0 + mm) * 16 + fr;
                const float* b = (row < MP) ? baseP + (size_t)row * D : baseS + (size_t)(row - MP) * D;
#pragma unroll
                for (int bj = 0; bj < 2; ++bj)
#pragma unroll
                    for (int n = 0; n < 2; ++n) pre[mm][bj][n] = *(const f32x4*)(b + col0 + bj * 128 + n * 16);
            }
#pragma unroll
            for (int mm = 0; mm < 2; ++mm) {
                const int m = m0 + mm;
                const int row = u.pm * 256 + ai * 128 + wr * 64 + m * 16 + fr;
                float q = 0.f;
#pragma unroll
                for (int bj = 0; bj < 2; ++bj)
#pragma unroll
                    for (int n = 0; n < 2; ++n) {
                        const int c = col0 + bj * 128 + n * 16;
                        const f32x4 x = pre[mm][bj][n] + gv[bj][n] * acc[ai][bj][m][n];
                        __builtin_nontemporal_store(x, (f32x4*)(out + (size_t)row * D + c));
                        q += (x.x * x.x + x.y * x.y) + (x.z * x.z + x.w * x.w);
                        if (has_next) { const f32x4 y = x * gn[bj][n]; u32x2 w; w.x = pk2(y.x, y.y); w.y = pk2(y.z, y.w); *(u32x2*)(xg + (size_t)row * D + c) = w; }
                    }
                q += __shfl_xor(q, 16); q += __shfl_xor(q, 32);
                if (fq == 0 && has_next) ssq[(size_t)row * 16 + u.pn * 4 + wc] = q;
            }
        }
    }
};

struct RangeOrder : pg8::StaticOrder {
    int lo, hi, fix;
    __host__ __device__ bool next(int i, pg8::Unit& u) const {
        long L;
        if (fix >= 0) { if (i > 0) return false; L = fix; } else { L = (long)lo + (long)i * G + c; if (L >= hi) return false; }
        int wgid = (int)L; { const int q = nwg / pg8::NXCD, r = nwg % pg8::NXCD, xcd = wgid % pg8::NXCD, off = wgid / pg8::NXCD; wgid = (xcd < r ? xcd * (q + 1) : r * (q + 1) + (xcd - r) * q) + off; }
        const int nig = pg8::WGM * nN, gid = wgid / nig, fm = gid * pg8::WGM, gsz = (nM - fm) < pg8::WGM ? (nM - fm) : pg8::WGM;
        u.pm = fm + ((wgid % nig) % gsz); u.pn = (wgid % nig) / gsz; return true;
    }
};

DI void transpose_item(const float* W, int K, int N, bf16_t* WT, LAS float* scr, int item, int lane) {
    const int nblk = N / 64, kb = item / nblk, nb = item - kb * nblk, k0 = 64 * kb, n0 = 64 * nb;
    const int kr = lane >> 4, nq = lane & 15;
    f32x4 v[16];
#pragma unroll
    for (int i = 0; i < 16; ++i) v[i] = *(const f32x4*)(W + (size_t)(k0 + 4 * i + kr) * N + n0 + 4 * nq);
#pragma unroll
    for (int i = 0; i < 16; ++i) { LAS float* d = scr + (4 * i + kr) * 65 + 4 * nq; d[0] = v[i].x; d[1] = v[i].y; d[2] = v[i].z; d[3] = v[i].w; }
    asm volatile("s_waitcnt lgkmcnt(0)" ::: "memory");
    const int c = lane & 7;
#pragma unroll
    for (int j = 0; j < 8; ++j) { const int n = (lane >> 3) + 8 * j; const LAS float* s = scr + (8 * c) * 65 + n;
        u32x4 o; o.x = pk2(s[0 * 65], s[1 * 65]); o.y = pk2(s[2 * 65], s[3 * 65]); o.z = pk2(s[4 * 65], s[5 * 65]); o.w = pk2(s[6 * 65], s[7 * 65]);
        *(u32x4*)(WT + (size_t)(n0 + n) * K + k0 + 8 * c) = o; }
    asm volatile("s_waitcnt lgkmcnt(0)" ::: "memory");
}
DI void gemv9_unit(const float* W, int N, int n0, const float* v0, const float* v1, int vs, bool do_silu, const float* badd, float* out, int ostride, float* scr, int tid) {
    const int wave = __builtin_amdgcn_readfirstlane(tid >> 6), lane = tid & 63;
    float* sv = scr; float* red = scr + NMOD * 1024;
    for (int idx = tid; idx < NMOD * 1024; idx += 512) {
        const int j = idx >> 10, k = idx & 1023;
        float v = (j == 0) ? v0[k] : v1[(size_t)(j - 1) * vs + k];
        if (do_silu) v = v * sigmoidf_(v);
        sv[idx] = v;
    }
    __syncthreads();
    float acc[NMOD];
#pragma unroll
    for (int j = 0; j < NMOD; ++j) acc[j] = 0.f;
    const float* wp = W + (size_t)(wave * 128) * N + n0 + lane;
#pragma unroll 2
    for (int k = 0; k < 128; k += 4) {
        const float w0 = wp[(size_t)k * N], w1 = wp[(size_t)(k + 1) * N], w2 = wp[(size_t)(k + 2) * N], w3 = wp[(size_t)(k + 3) * N];
#pragma unroll
        for (int j = 0; j < NMOD; ++j) {
            const f32x4 s = *(const f32x4*)(sv + j * 1024 + wave * 128 + k);
            acc[j] += (s.x * w0 + s.y * w1) + (s.z * w2 + s.w * w3);
        }
    }
#pragma unroll
    for (int j = 0; j < NMOD; ++j) red[(wave * NMOD + j) * 64 + lane] = acc[j];
    __syncthreads();
    for (int idx = tid; idx < NMOD * 64; idx += 512) {
        const int j = idx >> 6, ln = idx & 63; float s = 0.f;
#pragma unroll
        for (int w = 0; w < 8; ++w) s += red[(w * NMOD + j) * 64 + ln];
        if (badd) s += badd[n0 + ln];
        out[(size_t)j * ostride + n0 + ln] = s;
    }
    __syncthreads();
}

DI void conv_unit(int ct, int l, const bf16_t* RAW, bf16_t* ATT, const float* dw_w, const float* dw_b, const float* ln_g, const float* ln_b, float* lds, int tid) {
    const int row0 = ct * 64;
    int seq0, L;
    if (row0 < MP) { seq0 = row0 & ~255; L = 256; } else { seq0 = MP + ((row0 - MP) & ~2047); L = 2048; }
    const int t0 = row0 - seq0;
    {
        u32x4 wa[6], wg[6];
#pragma unroll
        for (int i = 0; i < 6; ++i) {
            const int it = tid + 512 * i, rr = it >> 5, c8 = it & 31, t = t0 - 15 + rr;
            if (it < 94 * 32 && t >= 0 && t < L) { const bf16_t* p = RAW + (size_t)(seq0 + t) * INW + c8 * 8; wa[i] = *(const u32x4*)p; wg[i] = *(const u32x4*)(p + 256); }
            else { wa[i] = (u32x4){0u, 0u, 0u, 0u}; wg[i] = (u32x4){0u, 0u, 0u, 0u}; }
        }
#pragma unroll
        for (int i = 0; i < 6; ++i) {
            const int it = tid + 512 * i, rr = it >> 5, c8 = it & 31;
            if (it < 94 * 32) {
                float a[8], g[8], hv[8]; unpack8(wa[i], a); unpack8(wg[i], g);
#pragma unroll
                for (int e2 = 0; e2 < 8; ++e2) hv[e2] = a[e2] * sigmoidf_(g[e2]);
                float* d = lds + rr * 256 + c8 * 8;
                *(f32x4*)d = (f32x4){hv[0], hv[1], hv[2], hv[3]}; *(f32x4*)(d + 4) = (f32x4){hv[4], hv[5], hv[6], hv[7]};
            }
        }
    }
    __syncthreads();
    const int c = tid & 255, th = tid >> 8;
    float w[31];
#pragma unroll
    for (int k = 0; k < 31; ++k) w[k] = dw_w[(size_t)(l * 31 + k) * 256 + c];
    const float bias = dw_b[l * 256 + c];
    float outv[32];
#pragma unroll
    for (int ch = 0; ch < 2; ++ch) {
        float hv[46];
#pragma unroll
        for (int i = 0; i < 46; ++i) hv[i] = lds[(th * 32 + ch * 16 + i) * 256 + c];
#pragma unroll
        for (int o = 0; o < 16; ++o) {
            float s = bias;
#pragma unroll
            for (int k = 0; k < 31; ++k) s += hv[o + k] * w[k];
            outv[ch * 16 + o] = s;
        }
    }
    __syncthreads();
#pragma unroll
    for (int o = 0; o < 32; ++o) lds[(th * 32 + o) * 256 + c] = outv[o];
    __syncthreads();
    const int wave = tid >> 6, lane = tid & 63;
    const f32x4 g4 = *(const f32x4*)(ln_g + l * 256 + 4 * lane), b4 = *(const f32x4*)(ln_b + l * 256 + 4 * lane);
#pragma unroll
    for (int i = 0; i < 8; ++i) {
        const int tk = wave * 8 + i;
        const f32x4 v = *(const f32x4*)(lds + tk * 256 + 4 * lane);
        const float mean = wave_sum((v.x + v.y) + (v.z + v.w)) * (1.f / 256.f);
        const f32x4 dv = v - mean;
        const float var = wave_sum((dv.x * dv.x + dv.y * dv.y) + (dv.z * dv.z + dv.w * dv.w)) * (1.f / 256.f);
        const float rstd = rsqrtf(var + EPS);
        f32x4 y = dv * rstd * g4 + b4;
        y.x *= sigmoidf_(y.x); y.y *= sigmoidf_(y.y); y.z *= sigmoidf_(y.z); y.w *= sigmoidf_(y.w);
        u32x2 o; o.x = pk2(y.x, y.y); o.y = pk2(y.z, y.w);
        *(u32x2*)(ATT + (size_t)(row0 + tk) * D + 4 * lane) = o;
    }
    __syncthreads();
}

struct PrepP { const bf16_t* RAW; bf16_t* Q; bf16_t* K; bf16_t* VT; float* out; const float *aqg, *akg, *nqg, *nkg; };
DI void qkv_unit(int ct, int l, const PrepP& P, bf16_t* ldsv, int tid) {
    const int row0 = ct * 64;
    const bool prompt = row0 < MP;
    int seq0, L, sb;
    if (prompt) { seq0 = row0 & ~255; L = 256; sb = row0 >> 8; } else { seq0 = MP + ((row0 - MP) & ~2047); L = 2048; sb = (row0 - MP) >> 11; }
    const int t0 = row0 - seq0;
    {
    const int lane = tid & 63, wave = __builtin_amdgcn_readfirstlane(tid >> 6), half = lane >> 5;
    for (int wi = wave; wi < 40; wi += 8) {
        const int hd = wi >> 1, tok = (wi & 1) * 32 + (lane & 31);
        const int row = row0 + tok, t = t0 + tok;
        int rcol; const float* gw; bool isq;
        if (hd < 6) { rcol = 512 + 64 * hd; gw = P.aqg; isq = true; }
        else if (hd < 8) { rcol = 896 + 64 * (hd - 6); gw = P.akg; isq = false; }
        else if (hd < 14) { rcol = 1152 + 64 * (hd - 8); gw = P.nqg; isq = true; }
        else { rcol = 1536 + 64 * (hd - 14); gw = P.nkg; isq = false; }
        float v[32];
        const bf16_t* rp = P.RAW + (size_t)row * INW + rcol + 32 * half;
#pragma unroll
        for (int c = 0; c < 4; ++c) { const u32x4 wv = *(const u32x4*)(rp + 8 * c); float tmp[8]; unpack8(wv, tmp);
#pragma unroll
            for (int e2 = 0; e2 < 8; ++e2) v[8 * c + e2] = tmp[e2]; }
        float ss = 0.f;
#pragma unroll
        for (int d = 0; d < 32; ++d) ss += v[d] * v[d];
        ss += __shfl_xor(ss, 32);
        const float rstd = rsqrtf(ss * (1.f / 64.f) + EPS);
        const float* gp = gw + l * 64 + 32 * half;
#pragma unroll
        for (int c4 = 0; c4 < 8; ++c4) { const f32x4 g4 = *(const f32x4*)(gp + 4 * c4); v[4 * c4] *= rstd * g4.x; v[4 * c4 + 1] *= rstd * g4.y; v[4 * c4 + 2] *= rstd * g4.z; v[4 * c4 + 3] *= rstd * g4.w; }
        if ((!prompt) && (hd < 8)) {
            const float pos = (float)(half ? (t & 63) : (t >> 6));
#pragma unroll
            for (int j = 0; j < 16; ++j) {
                const float inv = exp2f(-(float)j * 0.8304820237218406f);
                float sn, cs; __sincosf(pos * inv, &sn, &cs);
                const float a = v[j], b = v[16 + j];
                v[j] = a * cs - b * sn; v[16 + j] = b * cs + a * sn;
            }
        }
        if (isq) {
            const int qh = (hd < 6) ? hd : 6 + (hd - 8);
            bf16_t* qp = P.Q + (prompt ? ((size_t)(sb * 12 + qh) * 8 + (t >> 5)) * 2048 : (size_t)MP * 768 + ((size_t)(sb * 12 + qh) * 64 + (t >> 5)) * 2048) + (t & 31) * 8 + half * 1024;
#pragma unroll
            for (int c = 0; c < 4; ++c) {
                u32x4 o; o.x = pk2(v[8 * c] * QSCALE, v[8 * c + 1] * QSCALE); o.y = pk2(v[8 * c + 2] * QSCALE, v[8 * c + 3] * QSCALE);
                o.z = pk2(v[8 * c + 4] * QSCALE, v[8 * c + 5] * QSCALE); o.w = pk2(v[8 * c + 6] * QSCALE, v[8 * c + 7] * QSCALE);
                *(u32x4*)(qp + c * 256) = o;
            }
        } else {
            const int kh = (hd < 8) ? (hd - 6) : 2 + (hd - 14);
            bf16_t* kp = P.K + (prompt ? ((size_t)(sb * 8 + kh) * 8 + (t >> 5)) * 2048 : (size_t)MP * 512 + ((size_t)(sb * 8 + kh) * 64 + (t >> 5)) * 2048) + (t & 31) * 8 + half * 1024;
#pragma unroll
            for (int c = 0; c < 4; ++c) {
                u32x4 o; o.x = pk2(v[8 * c], v[8 * c + 1]); o.y = pk2(v[8 * c + 2], v[8 * c + 3]); o.z = pk2(v[8 * c + 4], v[8 * c + 5]); o.w = pk2(v[8 * c + 6], v[8 * c + 7]);
                *(u32x4*)(kp + c * 256) = o;
            }
            if (prompt) {
                float* op;
                if (hd < 8) op = P.out + OFF_AK + ((((size_t)sb * 4 + l) * 256 + t) * 2 + (hd - 6)) * 64 + 32 * half;
                else        op = P.out + OFF_NK + ((((size_t)sb * 4 + l) * 256 + t) * 6 + (hd - 14)) * 64 + 32 * half;
#pragma unroll
                for (int c4 = 0; c4 < 8; ++c4) *(f32x4*)(op + 4 * c4) = (f32x4){v[4 * c4], v[4 * c4 + 1], v[4 * c4 + 2], v[4 * c4 + 3]};
            }
        }
    }
    }
    {
        u32x4 wv8[8];
#pragma unroll
        for (int i = 0; i < 8; ++i) {
            const int it = tid + 512 * i, tok = it >> 6, cc = (it & 63) * 8, rcol = (cc < 128) ? 1024 + cc : 1920 + (cc - 128);
            wv8[i] = *(const u32x4*)(P.RAW + (size_t)(row0 + tok) * INW + rcol);
        }
#pragma unroll
        for (int i = 0; i < 8; ++i) {
            const int it = tid + 512 * i, tok = it >> 6, cc = (it & 63) * 8;
            const u32x4 wv = wv8[i];
            *(u32x4*)(ldsv + tok * 512 + cc) = wv;
            if (prompt) {
                float v[8]; unpack8(wv, v);
                const int t = t0 + tok; float* op;
                if (cc < 128) op = P.out + OFF_AV + (((size_t)sb * 4 + l) * 256 + t) * 128 + cc;
                else          op = P.out + OFF_NV + (((size_t)sb * 4 + l) * 256 + t) * 384 + (cc - 128);
                *(f32x4*)op = (f32x4){v[0], v[1], v[2], v[3]}; *(f32x4*)(op + 4) = (f32x4){v[4], v[5], v[6], v[7]};
            }
        }
    }
    __syncthreads();
    for (int it = tid; it < 512 * 8; it += 512) {
        const int hd_d = it & 511, g = it >> 9;
        unsigned short e[8];
#pragma unroll
        for (int jj = 0; jj < 8; ++jj) { const int p = 8 * g + jj; const int key = (p & ~31) + permkey(p & 31); e[jj] = ldsv[key * 512 + hd_d]; }
        u32x4 o; o.x = e[0] | ((unsigned)e[1] << 16); o.y = e[2] | ((unsigned)e[3] << 16); o.z = e[4] | ((unsigned)e[5] << 16); o.w = e[6] | ((unsigned)e[7] << 16);
        const int vh = hd_d >> 6, dd = hd_d & 63, tile = (t0 >> 5) + (g >> 2);
        const size_t base = prompt ? ((size_t)(sb * 8 + vh) * 8 + tile) * 2048 : (size_t)MP * 512 + ((size_t)(sb * 8 + vh) * 64 + tile) * 2048;
        *(u32x4*)(P.VT + base + ((((dd >> 5) * 2 + ((g >> 1) & 1)) * 2 + (g & 1)) * 32 + (dd & 31)) * 8) = o;
    }
    __syncthreads();
}

struct Seg { const bf16_t* k; const bf16_t* v; int nt; };
#define MFMA32(a, b, c) __builtin_amdgcn_mfma_f32_32x32x16_bf16((a), (b), (c), 0, 0, 0)
DI void issue_tile(const Seg& A, const Seg& B, int t, int lane, LAS unsigned char* slot) {
    const bf16_t* kp = (t < A.nt) ? A.k + (size_t)t * 2048 : B.k + (size_t)(t - A.nt) * 2048;
    const bf16_t* vp = (t < A.nt) ? A.v + (size_t)t * 2048 : B.v + (size_t)(t - A.nt) * 2048;
#pragma unroll
    for (int i = 0; i < 4; ++i) __builtin_amdgcn_global_load_lds((const unsigned*)(kp + i * 512 + lane * 8), (LAS unsigned*)(slot + i * 1024), 16, 0, 0);
#pragma unroll
    for (int i = 0; i < 4; ++i) __builtin_amdgcn_global_load_lds((const unsigned*)(vp + i * 512 + lane * 8), (LAS unsigned*)(slot + 4096 + i * 1024), 16, 0, 0);
}
template <bool NA, int NQB> DI void attn_wave(const bf16_t* Qp, const Seg A, const Seg B, bf16_t* Op, const float* rpbh, int r, int rs, int lane_, LAS unsigned char* ring, LAS float* biasl, int qoff) {
    int lane = lane_; asm volatile("" : "+v"(lane));
    const int r32 = lane & 31, hi = lane >> 5;
    const int nt = A.nt + B.nt;
    issue_tile(A, B, 0, lane, ring);
    issue_tile(A, B, 1, lane, ring + 8192);
    if (NA) { for (int i = lane; i < 15 * 31; i += 64) biasl[i] = rpbh[i] * LOG2E; }
    bf16x8 qf[NQB][4];
#pragma unroll
    for (int qb = 0; qb < NQB; ++qb)
#pragma unroll
        for (int kk = 0; kk < 4; ++kk) qf[qb][kk] = *(const bf16x8*)(Qp + (qoff + qb) * 2048 + kk * 512 + lane * 8);
    f32x16 o[NQB][2];
#pragma unroll
    for (int a = 0; a < NQB; ++a)
#pragma unroll
        for (int b = 0; b < 2; ++b)
#pragma unroll
            for (int i = 0; i < 16; ++i) o[a][b][i] = 0.f;
    float mrun[NQB], lrun[NQB];
#pragma unroll
    for (int a = 0; a < NQB; ++a) { mrun[a] = -1e30f; lrun[a] = 0.f; }
    asm volatile("s_waitcnt vmcnt(0)" ::: "memory");
#pragma nounroll
    for (int t = 0; t < nt; ++t) {
        LAS unsigned char* slot = ring + (t & 1) * 8192;
        if (t + 1 < nt) asm volatile("s_waitcnt vmcnt(8)" ::: "memory"); else asm volatile("s_waitcnt vmcnt(0)" ::: "memory");
        bf16x8 kf[4], vf[2][2];
#pragma unroll
        for (int kk = 0; kk < 4; ++kk) kf[kk] = *(const LAS bf16x8*)(slot + kk * 1024 + lane * 16);
#pragma unroll
        for (int db = 0; db < 2; ++db)
#pragma unroll
            for (int s2 = 0; s2 < 2; ++s2) vf[db][s2] = *(const LAS bf16x8*)(slot + 4096 + (db * 2 + s2) * 1024 + lane * 16);
        asm volatile("s_waitcnt lgkmcnt(0)" ::: "memory");
        if (t + 2 < nt) issue_tile(A, B, t + 2, lane, slot);
#pragma unroll
        for (int qb = 0; qb < NQB; ++qb) {
            f32x16 s;
#pragma unroll
            for (int i = 0; i < 16; ++i) s[i] = 0.f;
#pragma unroll
            for (int kk = 0; kk < 4; ++kk) s = MFMA32(kf[kk], qf[qb][kk], s);
            if (NA) {
                if (t < A.nt) {
                    const int a = t >> 1, half = t & 1;
                    const int qc = 32 * (qoff + qb) + r32, cs = min(max(qc - 8, 0), 48);
                    const int kc0 = 32 * half + 4 * hi;
                    const LAS float* bp = biasl + (rs + a - r + 7) * 31 + (kc0 - qc + 15);
                    const unsigned u0 = (unsigned)(kc0 - cs);
                    float bia[16];
#pragma unroll
                    for (int i = 0; i < 16; ++i) bia[i] = bp[(i & 3) + 8 * (i >> 2)];
                    asm volatile("" : "+v"(bia[0]), "+v"(bia[1]), "+v"(bia[2]), "+v"(bia[3]), "+v"(bia[4]), "+v"(bia[5]), "+v"(bia[6]), "+v"(bia[7]),
                                      "+v"(bia[8]), "+v"(bia[9]), "+v"(bia[10]), "+v"(bia[11]), "+v"(bia[12]), "+v"(bia[13]), "+v"(bia[14]), "+v"(bia[15]));
#pragma unroll
                    for (int i = 0; i < 16; ++i) {
                        const bool valid = (u0 + (unsigned)((i & 3) + 8 * (i >> 2))) < 16u;
                        s[i] = valid ? s[i] + bia[i] : -1e30f;
                    }
                }
            }
            float ps = 0.f;
#pragma unroll
            for (int i = 0; i < 16; ++i) { const float p = __builtin_amdgcn_exp2f(s[i]); s[i] = p; ps += p; }
            lrun[qb] += ps;
            u32x4 p0, p1;
            p0.x = pk2(s[0], s[1]); p0.y = pk2(s[2], s[3]); p0.z = pk2(s[4], s[5]); p0.w = pk2(s[6], s[7]);
            p1.x = pk2(s[8], s[9]); p1.y = pk2(s[10], s[11]); p1.z = pk2(s[12], s[13]); p1.w = pk2(s[14], s[15]);
            const bf16x8 P0 = __builtin_bit_cast(bf16x8, p0), P1 = __builtin_bit_cast(bf16x8, p1);
#pragma unroll
            for (int db = 0; db < 2; ++db) { o[qb][db] = MFMA32(vf[db][0], P0, o[qb][db]); o[qb][db] = MFMA32(vf[db][1], P1, o[qb][db]); }
        }
    }
#pragma unroll
    for (int qb = 0; qb < NQB; ++qb) {
        const float lt = lrun[qb] + __shfl_xor(lrun[qb], 32);
        const float inv = 1.f / lt;
        bf16_t* orow = Op + (size_t)(32 * (qoff + qb) + r32) * D;
#pragma unroll
        for (int db = 0; db < 2; ++db)
#pragma unroll
            for (int g = 0; g < 4; ++g) {
                u32x2 w; w.x = pk2(o[qb][db][4 * g] * inv, o[qb][db][4 * g + 1] * inv); w.y = pk2(o[qb][db][4 * g + 2] * inv, o[qb][db][4 * g + 3] * inv);
                *(u32x2*)(orow + 32 * db + 8 * g + 4 * hi) = w;
            }
    }
}

DI void attn_wave_shared(const bf16_t* Qp, const Seg A, const Seg B, bf16_t* Op, int lane_, int wave, LAS unsigned char* ring) {
    int lane = lane_; asm volatile("" : "+v"(lane));
    const int r32 = lane & 31, hi = lane >> 5;
    const int nt = A.nt + B.nt;
    const bool isk = wave < 4;
    const int poff = (isk ? wave : wave - 4) * 512;
    const int loff = isk ? wave * 1024 : 4096 + (wave - 4) * 1024;
    const bf16_t* srcA = (isk ? A.k : A.v) + poff + lane * 8;
    const bf16_t* srcB = (isk ? B.k : B.v) + poff + lane * 8;
#define ISSUE_PIECE(tt) do { const int t_ = (tt); const bf16_t* src_ = (t_ < A.nt) ? srcA + (size_t)t_ * 2048 : srcB + (size_t)(t_ - A.nt) * 2048; \
        __builtin_amdgcn_global_load_lds((const unsigned*)src_, (LAS unsigned*)(ring + (t_ & 15) * 8192 + loff), 16, 0, 0); } while (0)
    bf16x8 qf[2][4];
#pragma unroll
    for (int qb = 0; qb < 2; ++qb)
#pragma unroll
        for (int kk = 0; kk < 4; ++kk) qf[qb][kk] = *(const bf16x8*)(Qp + qb * 2048 + kk * 512 + lane * 8);
    asm volatile("s_waitcnt vmcnt(0) lgkmcnt(0)" ::: "memory");
#pragma unroll
    for (int tt = 0; tt < 8; ++tt) ISSUE_PIECE(tt);
    f32x16 o[2][2];
#pragma unroll
    for (int a = 0; a < 2; ++a)
#pragma unroll
        for (int b = 0; b < 2; ++b)
#pragma unroll
            for (int i = 0; i < 16; ++i) o[a][b][i] = 0.f;
    float mrun[2] = {-1e30f, -1e30f}, lrun[2] = {0.f, 0.f};
#pragma nounroll
    for (int t = 0; t < nt; ++t) {
        if ((t & 7) == 0) {
            asm volatile("s_waitcnt vmcnt(0) lgkmcnt(0)\n\ts_barrier" ::: "memory");
            if (t + 8 < nt) {
#pragma unroll
                for (int tt = 0; tt < 8; ++tt) ISSUE_PIECE(t + 8 + tt);
            }
            if (((wave ^ (wave >> 2)) & 1) != 0) __builtin_amdgcn_s_sleep(19);
        }
        LAS unsigned char* slot = ring + (t & 15) * 8192;
        bf16x8 kf[4], vf[2][2];
#pragma unroll
        for (int kk = 0; kk < 4; ++kk) kf[kk] = *(const LAS bf16x8*)(slot + kk * 1024 + lane * 16);
#pragma unroll
        for (int db = 0; db < 2; ++db)
#pragma unroll
            for (int s2 = 0; s2 < 2; ++s2) vf[db][s2] = *(const LAS bf16x8*)(slot + 4096 + (db * 2 + s2) * 1024 + lane * 16);
        asm volatile("s_waitcnt lgkmcnt(0)" ::: "memory");
#pragma unroll
        for (int qb = 0; qb < 2; ++qb) {
            f32x16 s;
#pragma unroll
            for (int i = 0; i < 16; ++i) s[i] = 0.f;
#pragma unroll
            for (int kk = 0; kk < 4; ++kk) s = MFMA32(kf[kk], qf[qb][kk], s);
            float ps = 0.f;
#pragma unroll
            for (int i = 0; i < 16; ++i) { const float p = __builtin_amdgcn_exp2f(s[i]); s[i] = p; ps += p; }
            lrun[qb] += ps;
            u32x4 p0, p1;
            p0.x = pk2(s[0], s[1]); p0.y = pk2(s[2], s[3]); p0.z = pk2(s[4], s[5]); p0.w = pk2(s[6], s[7]);
            p1.x = pk2(s[8], s[9]); p1.y = pk2(s[10], s[11]); p1.z = pk2(s[12], s[13]); p1.w = pk2(s[14], s[15]);
            const bf16x8 P0 = __builtin_bit_cast(bf16x8, p0), P1 = __builtin_bit_cast(bf16x8, p1);
#pragma unroll
            for (int db = 0; db < 2; ++db) { o[qb][db] = MFMA32(vf[db][0], P0, o[qb][db]); o[qb][db] = MFMA32(vf[db][1], P1, o[qb][db]); }
        }
    }
#undef ISSUE_PIECE
#pragma unroll
    for (int qb = 0; qb < 2; ++qb) {
        const float lt = lrun[qb] + __shfl_xor(lrun[qb], 32);
        const float inv = 1.f / lt;
        bf16_t* orow = Op + (size_t)(32 * qb + r32) * D;
#pragma unroll
        for (int db = 0; db < 2; ++db)
#pragma unroll
            for (int g = 0; g < 4; ++g) {
                u32x2 w; w.x = pk2(o[qb][db][4 * g] * inv, o[qb][db][4 * g + 1] * inv); w.y = pk2(o[qb][db][4 * g + 2] * inv, o[qb][db][4 * g + 3] * inv);
                *(u32x2*)(orow + 32 * db + 8 * g + 4 * hi) = w;
            }
    }
    asm volatile("s_waitcnt vmcnt(0) lgkmcnt(0)\n\ts_barrier" ::: "memory");
}

struct AttnP { const bf16_t *Q, *K, *VT, *KCA, *VCA, *KCN, *VCN; bf16_t* ATT; const float* rpb; };
DI void attn_run_unit(int uid, int qsel, int l, const AttnP& P, int lane, LAS unsigned char* ring, LAS float* biasl, bool shared, int wave, LAS unsigned char* lds0) {
    const size_t QS = (size_t)MP * 768, KS = (size_t)MP * 512;
    Seg A, B{nullptr, nullptr, 0}; const bf16_t* Qp; bf16_t* Op; const float* rp = nullptr; int r = 0, rs = 0; bool na = false;
    if (uid < 1536) {
        const int qc = uid & 31, bh = uid >> 5, b = bh / 6, h = bh - 6 * b, kvh = h / 3;
        const int row0 = MP + b * 2048;
        A = Seg{P.K + KS + (size_t)(b * 8 + kvh) * 64 * 2048, P.VT + KS + (size_t)(b * 8 + kvh) * 64 * 2048, 64};
        B = Seg{P.KCA + (size_t)((b * 4 + l) * 2 + kvh) * 16384, P.VCA + (size_t)((b * 4 + l) * 2 + kvh) * 16384, 8};
        Qp = P.Q + QS + ((size_t)(b * 12 + h) * 64 + 2 * qc) * 2048; Op = P.ATT + (size_t)(row0 + qc * 64) * D + 256 + h * 64;
    } else if (uid < 3072) {
        const int u = uid - 1536, bh = u >> 5, b = bh / 6, h = bh - 6 * b;
        r = u & 31; rs = min(max(r - 4, 0), 24); na = true;
        const int row0 = MP + b * 2048;
        A = Seg{P.K + KS + ((size_t)(b * 8 + 2 + h) * 64 + 2 * rs) * 2048, P.VT + KS + ((size_t)(b * 8 + 2 + h) * 64 + 2 * rs) * 2048, 16};
        B = Seg{P.KCN + (size_t)((b * 4 + l) * 6 + h) * 16384, P.VCN + (size_t)((b * 4 + l) * 6 + h) * 16384, 8};
        Qp = P.Q + QS + ((size_t)(b * 12 + 6 + h) * 64 + 2 * r) * 2048; Op = P.ATT + (size_t)(row0 + r * 64) * D + 640 + h * 64;
        rp = P.rpb + (size_t)(l * 6 + h) * 15 * 31;
    } else {
        const int nah = uid >= 3840;
        const int u = uid - (nah ? 3840 : 3072), qc = u & 3, bh = u >> 2, b = bh / 6, h = bh - 6 * b, kh = nah ? 2 + h : h / 3;
        const int row0 = b * 256;
        A = Seg{P.K + (size_t)(b * 8 + kh) * 8 * 2048, P.VT + (size_t)(b * 8 + kh) * 8 * 2048, 8};
        Qp = P.Q + ((size_t)(b * 12 + (nah ? 6 : 0) + h) * 8 + 2 * qc) * 2048; Op = P.ATT + (size_t)(row0 + qc * 64) * D + (nah ? 640 : 256) + h * 64;
    }
    if (na) { if (qsel == 2) attn_wave<true, 2>(Qp, A, B, Op, rp, r, rs, lane, ring, biasl, 0); else attn_wave<true, 1>(Qp, A, B, Op, rp, r, rs, lane, ring, biasl, qsel); }
    else if (shared) attn_wave_shared(Qp, A, B, Op, lane, wave, lds0);
    else attn_wave<false, 2>(Qp, A, B, Op, rp, r, rs, lane, ring, biasl, 0);
}

struct Args {
    const float* in[25]; float* out; unsigned char* ws; int ph_lo, ph_hi;
};
#define XB_TMO      128
#define XB_XCNT(j)  (256  + 64 * (j))
#define XB_XSUB(j)  (1280 + 64 * (j))
#define XB_XGEN(j)  (2304 + 64 * (j))
#define XB_TOP      3328
#define XB_TOPGEN   3392
#define XCD_BAR_WORDS 3456
#define XB_SPIN_CAP (1u << 18)

__device__ __forceinline__ unsigned xb_ld(unsigned* p)              { return __hip_atomic_load(p, __ATOMIC_RELAXED, __HIP_MEMORY_SCOPE_AGENT); }
__device__ __forceinline__ unsigned xb_add(unsigned* p, unsigned v) { return __hip_atomic_fetch_add(p, v, __ATOMIC_RELAXED, __HIP_MEMORY_SCOPE_AGENT); }
__device__ __forceinline__ unsigned xb_xcc_id() { return (unsigned)__builtin_amdgcn_s_getreg((3 << 11) | 20) & 0xFu; }
#define XB_SPIN(cond, bar) do { unsigned _sp = 0; while (cond) { __builtin_amdgcn_s_sleep(1); \
    if ((++_sp & 255u) == 0u) { if (xb_ld(&(bar)[XB_TMO])) break; if (_sp > XB_SPIN_CAP) { atomicAdd(&(bar)[XB_TMO], 1u); break; } } } } while (0)

struct XcdBarrier {
    unsigned* bar; unsigned x;
    volatile LAS unsigned* st;
};

__device__ __forceinline__ XcdBarrier xcd_barrier_post(unsigned* bar, volatile LAS unsigned* st) {
    XcdBarrier b; b.bar = bar; b.x = xb_xcc_id(); b.st = st;
    if (threadIdx.x == 0) { const unsigned old_ = xb_add(&bar[XB_XCNT(b.x)], 1u); st[2] = old_; st[3] = b.x; }
    return b;
}
__device__ __forceinline__ void xcd_barrier_complete(unsigned* bar, unsigned x, unsigned& nloc, unsigned& nx) {
    const unsigned G = gridDim.x * gridDim.y * gridDim.z;
    unsigned sum, cnt, mine, sp = 0u;
    for (;;) {
        sum = 0u; cnt = 0u; mine = 0u;
#pragma unroll
        for (unsigned j = 0; j < 16; ++j) { const unsigned c = xb_ld(&bar[XB_XCNT(j)]); sum += c; cnt += (c > 0u) ? 1u : 0u; mine = (j == x) ? c : mine; }
        if (sum == G) break;
        __builtin_amdgcn_s_sleep(1);
        if ((++sp & 255u) == 0u) { if (xb_ld(&bar[XB_TMO])) break; if (sp > XB_SPIN_CAP) { atomicAdd(&bar[XB_TMO], 1u); break; } }
    }
    nloc = mine > 0u ? mine : 1u; nx = cnt > 0u ? cnt : 1u;
}

__device__ __forceinline__ void xcd_barrier(const XcdBarrier& b) {
    asm volatile("s_waitcnt vmcnt(0)" ::: "memory");
    __syncthreads();
    if (threadIdx.x == 0) {
        unsigned* bar = b.bar; asm volatile("" : "+v"(bar));
        __builtin_amdgcn_s_waitcnt(0);
        unsigned nloc = b.st[0], nx = b.st[1];
        if (nloc == 0u) { xcd_barrier_complete(bar, b.x, nloc, nx); b.st[0] = nloc; b.st[1] = nx; }
        const unsigned old = xb_add(&bar[XB_XSUB(b.x)], 1u);
        const unsigned gen = old / nloc;
        if (old + 1u == (gen + 1u) * nloc) {
            __builtin_amdgcn_fence(__ATOMIC_RELEASE, "agent");
            asm volatile("s_waitcnt vmcnt(0)" ::: "memory");
            const unsigned og = xb_add(&bar[XB_TOP], 1u);
            const unsigned tg = og / nx;
            if (og + 1u == (tg + 1u) * nx) xb_add(&bar[XB_TOPGEN], 1u);
            else XB_SPIN(xb_ld(&bar[XB_TOPGEN]) == tg, bar);
            __builtin_amdgcn_fence(__ATOMIC_ACQUIRE, "agent");
            xb_add(&bar[XB_XGEN(b.x)], 1u);
            asm volatile("s_waitcnt vmcnt(0)" ::: "memory");
        } else {
            XB_SPIN(xb_ld(&bar[XB_XGEN(b.x)]) == gen, bar);
            __builtin_amdgcn_fence(__ATOMIC_ACQUIRE, "agent");
            asm volatile("s_waitcnt vmcnt(0)" ::: "memory");
        }
    }
    __syncthreads();
}

typedef const __attribute__((address_space(4))) char* kargp_t;
DI const float* ldin(int i) { kargp_t kp = (kargp_t)__builtin_amdgcn_kernarg_segment_ptr(); asm volatile("" : "+s"(kp)); return (const float*)(*(const __attribute__((address_space(4))) unsigned long long*)(kp + 8 * i)); }
DI float* ldout() { return (float*)ldin(25); }
DI unsigned char* ldws() { return (unsigned char*)ldin(26); }
DI int opq_tid() { int t = threadIdx.x; asm volatile("" : "+v"(t)); return t; }

__global__ void __launch_bounds__(512, 2) fwd_kernel(Args a) {
    extern __shared__ __attribute__((aligned(16))) unsigned char lds[];
    cg::grid_group grid = cg::this_grid();
    const int G = gridDim.x, bx = blockIdx.x, NGW = G * 8;
    const int lo = a.ph_lo, hi = a.ph_hi;
#define IN(k) (lo <= (k) && (k) < hi)
    volatile LAS unsigned* MISC = (volatile LAS unsigned*)((LAS unsigned char*)lds + 146432);
    if (threadIdx.x < 16) MISC[threadIdx.x] = 0u;
    __syncthreads();
    XcdBarrier xbar; xbar.bar = (unsigned*)ldws(); xbar.x = 0; xbar.st = nullptr;
    if (hi - lo > 1) xbar = xcd_barrier_post((unsigned*)ldws(), MISC + 8);
    if (hi < 0) grid.sync();
#define SEAM(k) do { if (IN(k) && (k) + 1 < hi) xcd_barrier(xbar); } while (0)
#define WSP(T, off) ((T*)(ws + (off)))

    for (int sx_ = 0; sx_ < SYNCX; ++sx_) xcd_barrier(xbar);
    if (IN(0)) for (int rep_ = 0; rep_ < REP_P; ++rep_) {
        if (rep_) xcd_barrier(xbar);
        const int tid = opq_tid(), lane = tid & 63, wave = __builtin_amdgcn_readfirstlane(tid >> 6), gw = bx * 8 + wave;
        unsigned char* ws = ldws();
        {
            const float *cvec = ldin(6), *c_ctx = ldin(7), *ada_w = ldin(8), *ada_b = ldin(9);
            float* mod = WSP(float, WS_MOD);
            for (int u = bx; u < DEPTH * 96; u += G) {
                const int l = u / 96, nb = u - l * 96;
                gemv9_unit(ada_w + (size_t)l * D * 6144, 6144, nb * 64, c_ctx, cvec, D, true, ada_b + l * 6144, mod + (size_t)l * NMOD * 6144, 6144, (float*)lds, tid);
            }
        }
        {
            const float *w_in = ldin(12), *w1 = ldin(23);
            bf16_t *WIN = WSP(bf16_t, WS_WIN), *W1T = WSP(bf16_t, WS_W1);
            LAS float* scr = (LAS float*)((LAS unsigned char*)lds + wave * 17408);
            constexpr int I_IN = 16 * 36, I_1 = 16 * 64, I_L = I_IN + I_1;
            for (int it = gw; it < 1 * I_L; it += NGW) {
                const int l = it / I_L; int r = it - l * I_L;
                if (r < I_IN) transpose_item(w_in + (size_t)l * D * INW, D, INW, WIN + (size_t)l * INW * D, scr, r, lane);
                else transpose_item(w1 + (size_t)l * D * FF, D, FF, W1T + (size_t)l * FF * D, scr, r - I_IN, lane);
            }
        }
        {
            const float *cache_ak = ldin(2), *cache_av = ldin(3), *cache_nk = ldin(4), *cache_nv = ldin(5);
            bf16_t *KCA = WSP(bf16_t, WS_KCA), *VCA = WSP(bf16_t, WS_VCA), *KCN = WSP(bf16_t, WS_KCN), *VCN = WSP(bf16_t, WS_VCN);
            const int gt = bx * 512 + tid, NGT = G * 512;
            for (int e = gt; e < 8 * 4 * 256 * 8 * 8; e += NGT) {
                const int c8 = e & 7, hh = (e >> 3) & 7, key = (e >> 6) & 255, bl = e >> 14;
                const float* src; bf16_t* dst;
                if (hh < 2) { src = cache_ak + (((size_t)bl * 256 + key) * 2 + hh) * 64 + 8 * c8; dst = KCA + (((size_t)bl * 2 + hh) * 8 + (key >> 5)) * 2048 + (c8 * 32 + (key & 31)) * 8; }
                else { src = cache_nk + (((size_t)bl * 256 + key) * 6 + (hh - 2)) * 64 + 8 * c8; dst = KCN + (((size_t)bl * 6 + (hh - 2)) * 8 + (key >> 5)) * 2048 + (c8 * 32 + (key & 31)) * 8; }
                const f32x4 v0 = *(const f32x4*)src, v1 = *(const f32x4*)(src + 4);
                u32x4 o; o.x = pk2(v0.x, v0.y); o.y = pk2(v0.z, v0.w); o.z = pk2(v1.x, v1.y); o.w = pk2(v1.z, v1.w);
                *(u32x4*)dst = o;
            }
            for (int e = gt; e < 8 * 4 * 8 * 32 * 64; e += NGT) {
                const int d = e & 63, g = (e >> 6) & 31, hh = (e >> 11) & 7, bl = e >> 14;
                unsigned short q[8];
#pragma unroll
                for (int jj = 0; jj < 8; ++jj) {
                    const int p = 8 * g + jj, key = (p & ~31) + permkey(p & 31);
                    const float v = (hh < 2) ? cache_av[(((size_t)bl * 256 + key) * 2 + hh) * 64 + d] : cache_nv[(((size_t)bl * 256 + key) * 6 + (hh - 2)) * 64 + d];
                    q[jj] = (unsigned short)(pk2(v, 0.f) & 0xffffu);
                }
                u32x4 o; o.x = q[0] | ((unsigned)q[1] << 16); o.y = q[2] | ((unsigned)q[3] << 16); o.z = q[4] | ((unsigned)q[5] << 16); o.w = q[6] | ((unsigned)q[7] << 16);
                const int voff = (g >> 2) * 2048 + ((((d >> 5) * 2 + ((g >> 1) & 1)) * 2 + (g & 1)) * 32 + (d & 31)) * 8;
                bf16_t* dst = (hh < 2) ? VCA + ((size_t)bl * 2 + hh) * 16384 + voff : VCN + ((size_t)bl * 6 + (hh - 2)) * 16384 + voff;
                *(u32x4*)dst = o;
            }
        }
    }
    SEAM(0);
    if (IN(1)) for (int rep_ = 0; rep_ < REP_P; ++rep_) {
        if (rep_) xcd_barrier(xbar);
        const int tid = opq_tid(), lane = tid & 63, wave = __builtin_amdgcn_readfirstlane(tid >> 6), gw = bx * 8 + wave;
        unsigned char* ws = ldws();
        float* mod = WSP(float, WS_MOD);
        {
            const float *w_in = ldin(12), *w1 = ldin(23);
            float *bias1 = WSP(float, WS_BIAS1), *bias2 = WSP(float, WS_BIAS2);
            for (int u = bx; u < DEPTH * 100; u += G) {
                const int l = u / 100; int r = u - l * 100;
                const float* ml = mod + (size_t)l * NMOD * 6144;
                if (r < 36) gemv9_unit(w_in + (size_t)l * D * INW, INW, r * 64, ml, ml + 6144, 6144, false, nullptr, bias1 + (size_t)l * NMOD * INW, INW, (float*)lds, tid);
                else { r -= 36; gemv9_unit(w1 + (size_t)l * D * FF, FF, r * 64, ml + 3072, ml + 6144 + 3072, 6144, false, nullptr, bias2 + (size_t)l * NMOD * FF, FF, (float*)lds, tid); }
            }
        }
        {
            const float *w_out = ldin(22), *w2 = ldin(24);
            bf16_t *WOUT = WSP(bf16_t, WS_WOUT), *W2T = WSP(bf16_t, WS_W2);
            LAS float* scr = (LAS float*)((LAS unsigned char*)lds + wave * 17408);
            constexpr int I_OUT = 16 * 16, I_2 = 64 * 16, I_L = I_OUT + I_2;
            for (int it = gw; it < 1 * I_L; it += NGW) {
                const int l = it / I_L; int r = it - l * I_L;
                if (r < I_OUT) transpose_item(w_out + (size_t)l * D * D, D, D, WOUT + (size_t)l * D * D, scr, r, lane);
                else transpose_item(w2 + (size_t)l * FF * D, FF, D, W2T + (size_t)l * D * FF, scr, r - I_OUT, lane);
            }
        }
        {
            const float *x_prompt = ldin(0), *x_sample = ldin(1), *norm1_g = ldin(10);
            bf16_t* XG = WSP(bf16_t, WS_XG); float* ssq = WSP(float, WS_SSQ);
            for (int row = gw; row < M; row += NGW) {
                const float* xr = (row < MP) ? x_prompt + (size_t)row * D : x_sample + (size_t)(row - MP) * D;
                const float* scp = mod + (size_t)modidx(row) * 6144 + 1024;
                float s = 0.f;
#pragma unroll
                for (int j = 0; j < 4; ++j) {
                    const int c = 256 * j + 4 * lane;
                    const f32x4 v = *(const f32x4*)(xr + c);
                    s += (v.x * v.x + v.y * v.y) + (v.z * v.z + v.w * v.w);
                    const f32x4 y = v * (*(const f32x4*)(norm1_g + c)) * (*(const f32x4*)(scp + c) + 1.0f);
                    u32x2 w; w.x = pk2(y.x, y.y); w.y = pk2(y.z, y.w);
                    *(u32x2*)(XG + (size_t)row * D + c) = w;
                }
                s = wave_sum(s);
                if (lane < 16) ssq[(size_t)row * 16 + lane] = (lane == 0) ? s : 0.f;
            }
        }
    }
    SEAM(1);
#pragma nounroll
    for (int l_ = 0; l_ < DEPTH; ++l_) {
        int l = l_; asm volatile("" : "+s"(l));
        const int p0 = 2 + 6 * l;
        if (IN(p0)) for (int rep_ = 0; rep_ < REP_G1; ++rep_) {
            unsigned char* ws = ldws();
            pg8::Gemm g{WSP(bf16_t, WS_XG), WSP(bf16_t, WS_WIN) + (size_t)l * INW * D, M, INW, D, D}; pg8::StaticOrder S; S.init(M, INW, G, bx);
            EpiLin<0> E{WSP(bf16_t, WS_RAW), INW, WSP(float, WS_BIAS1) + (size_t)l * NMOD * INW, INW, WSP(float, WS_SSQ)};
            pg8::gemm_phase<EpiLin<0>, pg8::StaticOrder, true, true>((LAS unsigned char*)lds, g, S, E);
        }
        SEAM(p0);
        if (IN(p0 + 1)) for (int rep_ = 0; rep_ < REP_PREP; ++rep_) {
            const int tid = opq_tid();
            unsigned char* ws = ldws();
            for (int u = bx; u < 768; u += G) {
                if (u < 384) conv_unit(u, l, WSP(bf16_t, WS_RAW), WSP(bf16_t, WS_ATT), ldin(13), ldin(14), ldin(15), ldin(16), (float*)lds, tid);
                else { PrepP P{WSP(bf16_t, WS_RAW), WSP(bf16_t, WS_Q), WSP(bf16_t, WS_K), WSP(bf16_t, WS_VT), ldout(), ldin(17), ldin(18), ldin(19), ldin(20)}; qkv_unit(u - 384, l, P, (bf16_t*)lds, tid); }
            }
        }
        SEAM(p0 + 1);
        if (IN(p0 + 2)) for (int rep_ = 0; rep_ < REP_ATTN; ++rep_) {
            const int tid = opq_tid(), lane = tid & 63, wave = __builtin_amdgcn_readfirstlane(tid >> 6), gw = bx * 8 + wave;
            unsigned char* ws = ldws();
            AttnP P{WSP(bf16_t, WS_Q), WSP(bf16_t, WS_K), WSP(bf16_t, WS_VT), WSP(bf16_t, WS_KCA), WSP(bf16_t, WS_VCA), WSP(bf16_t, WS_KCN), WSP(bf16_t, WS_VCN), WSP(bf16_t, WS_ATT), ldin(21)};
            bool bal = (NGW == 2048) && (hi - lo > 1);
            int xcd = bx & 7, slot = bx >> 3;
            if (bal) {
                unsigned okc = 1u;
                for (unsigned j = 0; j < 16; ++j) okc &= (xb_ld(&xbar.bar[XB_XCNT(j)]) == (j < 8 ? 32u : 0u)) ? 1u : 0u;
                xcd = __builtin_amdgcn_readfirstlane((int)MISC[11]); slot = __builtin_amdgcn_readfirstlane((int)MISC[10]);
                bal = (__builtin_amdgcn_readfirstlane((int)okc) != 0) && xcd < 8 && slot < 32;
            }
            const int idx = slot * 8 + wave;
            const int nu = bal ? (slot < 24 ? (idx < 64 ? 3 : 2) : 2) : (4608 - gw + NGW - 1) / NGW;
            for (int k = 0; k < nu; ++k) {
#ifdef ATTN_PROBE
                if (rep_ == 1 && ((ATTN_PROBE == 1) ? (slot >= 24) : (ATTN_PROBE == 2) ? (slot < 24) : (slot >= 24 || k > 0))) break;
#endif
                int uid, qsel = 2; bool cshared = false;
                if (!bal) uid = gw + k * NGW;
                else if (slot < 24) {
                    if (k == 0) { uid = (xcd * 6 + (idx >> 5)) * 32 + (idx & 31); cshared = true; }
                    else if (idx >= 64 && idx < 128) uid = 1536 + xcd * 192 + 128 + (idx - 64);
                    else { const int p = (idx < 64) ? (k - 1) * 64 + idx : idx; const int pb = 4 * xcd + p / 48, r = p % 48, kind = r / 24, rr = r % 24; uid = (kind ? 3840 : 3072) + (pb * 6 + (rr >> 2)) * 4 + (rr & 3); }
                } else uid = 1536 + xcd * 192 + k * 64 + (slot - 24) * 8 + wave;
                attn_run_unit(uid, qsel, l, P, lane, (LAS unsigned char*)lds + wave * 16384, (LAS float*)((LAS unsigned char*)lds + 131072 + wave * 1920), cshared, wave, (LAS unsigned char*)lds);
            }
        }
        SEAM(p0 + 2);
        if (IN(p0 + 3)) {
            unsigned char* ws = ldws(); float* X = ldout();
            const float* ml = WSP(float, WS_MOD) + (size_t)l * NMOD * 6144;
            const bool split = false;
#pragma nounroll
            for (int rnd = 0; rnd < (split ? 2 : 1); ++rnd) {
                const int kh = (rnd == 1) ? (bx >> 7) : 0, koff = kh * (D / 2);
                pg8::Gemm g{WSP(bf16_t, WS_ATT) + koff, WSP(bf16_t, WS_WOUT) + (size_t)l * D * D + koff, M, D, D, (rnd == 1) ? D / 2 : D};
                RangeOrder S; S.init(M, D, G, bx); S.lo = 0; S.hi = split ? 256 : 384; S.fix = (rnd == 1) ? 256 + (bx & 127) : -1;
                unsigned* flag = (unsigned*)(ws + 16384) + (size_t)((l * 2 + 0) * 128 + (bx & 127)) * 64;
                f32x4* part = (f32x4*)(ws + WS_RAW) + (size_t)(bx & 127) * 16384;
                EpiRes E{l == 0 ? ldin(0) : X, l == 0 ? ldin(1) : X + (size_t)MP * D, X, ml + 2048, ldin(11) + l * D, ml + 4096, WSP(bf16_t, WS_XG), WSP(float, WS_SSQ), 1, (rnd == 1) ? 1 + kh : 0, part, flag};
                pg8::gemm_phase<EpiRes, RangeOrder, true, true>((LAS unsigned char*)lds, g, S, E);
                if (rnd == 1 && kh == 1) {
                    asm volatile("s_waitcnt vmcnt(0)" ::: "memory"); __syncthreads();
                    if (threadIdx.x == 0) { __builtin_amdgcn_fence(__ATOMIC_RELEASE, "agent"); asm volatile("s_waitcnt vmcnt(0)" ::: "memory"); __hip_atomic_store(flag, 1u, __ATOMIC_RELAXED, __HIP_MEMORY_SCOPE_AGENT); }
                }
            }
            SEAM(p0 + 3);
        }
        if (IN(p0 + 4)) for (int rep_ = 0; rep_ < REP_G3; ++rep_) {
            unsigned char* ws = ldws();
            pg8::Gemm g{WSP(bf16_t, WS_XG), WSP(bf16_t, WS_W1) + (size_t)l * FF * D, M, FF, D, D}; pg8::StaticOrder S; S.init(M, FF, G, bx);
            EpiLin<1> E{WSP(bf16_t, WS_H1), FF, WSP(float, WS_BIAS2) + (size_t)l * NMOD * FF, FF, WSP(float, WS_SSQ)};
            pg8::gemm_phase<EpiLin<1>, pg8::StaticOrder, true, true>((LAS unsigned char*)lds, g, S, E);
        }
        SEAM(p0 + 4);
        if (IN(p0 + 5)) {
            unsigned char* ws = ldws(); float* X = ldout();
            const float* ml = WSP(float, WS_MOD) + (size_t)l * NMOD * 6144;
            const int nx = (l + 1 < DEPTH) ? 1 : 0; const int ln = nx ? l + 1 : l;
            const bool split = false;
#pragma nounroll
            for (int rnd = 0; rnd < (split ? 2 : 1); ++rnd) {
                const int kh = (rnd == 1) ? (bx >> 7) : 0, koff = kh * (FF / 2);
                pg8::Gemm g{WSP(bf16_t, WS_H1) + koff, WSP(bf16_t, WS_W2) + (size_t)l * D * FF + koff, M, D, FF, (rnd == 1) ? FF / 2 : FF};
                RangeOrder S; S.init(M, D, G, bx); S.lo = 0; S.hi = split ? 256 : 384; S.fix = (rnd == 1) ? 256 + (bx & 127) : -1;
                unsigned* flag = (unsigned*)(ws + 16384) + (size_t)((l * 2 + 1) * 128 + (bx & 127)) * 64;
                f32x4* part = (f32x4*)(ws + WS_ATT) + (size_t)(bx & 127) * 16384;
                EpiRes E{X, X + (size_t)MP * D, X, ml + 5120, ldin(10) + ln * D, WSP(float, WS_MOD) + (size_t)ln * NMOD * 6144 + 1024, WSP(bf16_t, WS_XG), WSP(float, WS_SSQ), nx, (rnd == 1) ? 1 + kh : 0, part, flag};
                pg8::gemm_phase<EpiRes, RangeOrder, true, true>((LAS unsigned char*)lds, g, S, E);
                if (rnd == 1 && kh == 1) {
                    asm volatile("s_waitcnt vmcnt(0)" ::: "memory"); __syncthreads();
                    if (threadIdx.x == 0) { __builtin_amdgcn_fence(__ATOMIC_RELEASE, "agent"); asm volatile("s_waitcnt vmcnt(0)" ::: "memory"); __hip_atomic_store(flag, 1u, __ATOMIC_RELAXED, __HIP_MEMORY_SCOPE_AGENT); }
                }
            }
            if (l + 1 < DEPTH) {
                const int first = (G == 256) ? 128 : 0, nwg_t = G - first;
                if (bx >= first) {
                    const int tid = opq_tid(), lane = tid & 63, wave = __builtin_amdgcn_readfirstlane(tid >> 6);
                    const int l2 = l + 1;
                    const float *w_in = ldin(12), *w_out = ldin(22), *w1 = ldin(23), *w2 = ldin(24);
                    LAS float* scr = (LAS float*)((LAS unsigned char*)lds + wave * 17408);
                    constexpr int I_IN = 16 * 36, I_1 = 16 * 64, I_OUT = 16 * 16, I_2 = 64 * 16, I_L = I_IN + I_1 + I_OUT + I_2;
                    for (int it = (bx - first) * 8 + wave; it < I_L; it += nwg_t * 8) {
                        int r = it;
                        if (r < I_IN) { transpose_item(w_in + (size_t)l2 * D * INW, D, INW, WSP(bf16_t, WS_WIN) + (size_t)l2 * INW * D, scr, r, lane); continue; } r -= I_IN;
                        if (r < I_1) { transpose_item(w1 + (size_t)l2 * D * FF, D, FF, WSP(bf16_t, WS_W1) + (size_t)l2 * FF * D, scr, r, lane); continue; } r -= I_1;
                        if (r < I_OUT) { transpose_item(w_out + (size_t)l2 * D * D, D, D, WSP(bf16_t, WS_WOUT) + (size_t)l2 * D * D, scr, r, lane); continue; } r -= I_OUT;
                        transpose_item(w2 + (size_t)l2 * FF * D, FF, D, WSP(bf16_t, WS_W2) + (size_t)l2 * D * FF, scr, r, lane);
                    }
                }
            }
            SEAM(p0 + 5);
        }
    }
#undef IN
#undef SEAM
#undef WSP
}

extern "C" void kernel_launch(void* const* d_in, const int* in_sizes, int n_in, void* d_out, int out_size, void* d_ws, size_t ws_size, hipStream_t stream) {
    static int grid = 0;
    if (grid == 0) {
        if (n_in != 25 || ws_size < WS_END) { fprintf(stderr, "kernel_launch: need 25 inputs and >= %zu bytes of workspace; got %d, %zu\n", (size_t)WS_END, n_in, ws_size); grid = -1; return; }
        int dev = 0, cus = 0, per_cu = 0;
        hipGetDevice(&dev);
        hipDeviceGetAttribute(&cus, hipDeviceAttributeMultiprocessorCount, dev);
        if (hipFuncSetAttribute((const void*)fwd_kernel, hipFuncAttributeMaxDynamicSharedMemorySize, LDS_BYTES) != hipSuccess) { fprintf(stderr, "kernel_launch: hipFuncSetAttribute failed\n"); grid = -1; return; }
        if (hipOccupancyMaxActiveBlocksPerMultiprocessor(&per_cu, (const void*)fwd_kernel, 512, LDS_BYTES) != hipSuccess || per_cu < 1) { fprintf(stderr, "kernel_launch: occupancy query says %d\n", per_cu); per_cu = 1; }
        (void)hipGetLastError();
        grid = cus * per_cu;
    }
    if (grid < 0) return;
    if (hipMemsetAsync(d_ws, 0, 16384, stream) != hipSuccess) { fprintf(stderr, "kernel_launch: memset failed\n"); return; }
    Args a{};
    for (int i = 0; i < 25; ++i) a.in[i] = (const float*)d_in[i];
    a.out = (float*)d_out; a.ws = (unsigned char*)d_ws;
#if MK_SINGLE
    a.ph_lo = 0; a.ph_hi = NPH;
    void* args[] = {&a};
    hipError_t e = hipLaunchCooperativeKernel((const void*)fwd_kernel, dim3(grid), dim3(512), args, LDS_BYTES, stream);
    if (e != hipSuccess) fprintf(stderr, "cooperative launch failed: %s (grid %d)\n", hipGetErrorString(e), grid);
#else
    for (int ph = 0; ph < NPH; ++ph) {
        a.ph_lo = ph; a.ph_hi = ph + 1;
        hipLaunchKernelGGL(fwd_kernel, dim3(grid), dim3(512), LDS_BYTES, stream, a);
    }
#endif
}
```
